# Optimizing an MI355X kernel written in HIP

```python
import math
import jax, jax.numpy as jnp
from jax import lax
import numpy as np

D_MODEL = 2048
BATCH = 8
SEQ = 2048
DEPTH = 1
DEC_BATCH = 128
DEC_SEQ = 4
PAST_LEN = 8192
PAGE_SIZE = 128

ATTN_WIDTH = D_MODEL // 2
SSM_WIDTH = D_MODEL - ATTN_WIDTH
HEAD_DIM = 64
N_HEADS = ATTN_WIDTH // HEAD_DIM
N_KV_HEADS = 4
Q_PER_KV = N_HEADS // N_KV_HEADS
KV_WIDTH = N_KV_HEADS * HEAD_DIM
WINDOW = 128
BLOCK = 128
SSM_GROUP = 16
N_SSM_GROUPS = SSM_WIDTH // SSM_GROUP
STATE_DIM = 64
D_FF = 4 * D_MODEL
PROJ_WIDTH = ATTN_WIDTH + 2 * KV_WIDTH + SSM_WIDTH
EPS = 1e-6
NEG_INF = -1e30
DT_MIN = 1e-3
DT_MAX = 1e-1

kernel_name = 'hymba_swa_sink_s5_step'


def rmsnorm(x, g):
    xf = x.astype(jnp.float32)
    r = lax.rsqrt(jnp.mean(xf * xf, axis=-1, keepdims=True) + EPS)
    return (xf * r * g.astype(jnp.float32)).astype(x.dtype)


def alibi_slopes():
    h = jnp.arange(1, N_HEADS + 1, dtype=jnp.float32)
    return jnp.exp2(-8.0 * h / N_HEADS).reshape(N_KV_HEADS, Q_PER_KV)


def split_projection(z):
    n, t = z.shape[:2]
    o1 = ATTN_WIDTH
    o2 = o1 + KV_WIDTH
    o3 = o2 + KV_WIDTH
    q = z[..., :o1].reshape(n, t, N_KV_HEADS, Q_PER_KV, HEAD_DIM)
    k = z[..., o1:o2].reshape(n, t, N_KV_HEADS, HEAD_DIM)
    v = z[..., o2:o3].reshape(n, t, N_KV_HEADS, HEAD_DIM)
    u = z[..., o3:]
    return q, k, v, u


def band_probs(scores, delta, valid, slopes, sinks):
    s = scores - slopes[:, :, None, None] * delta.astype(jnp.float32)
    s = jnp.where(valid, s, NEG_INF)
    sink = sinks[:, :, None]
    m = jnp.maximum(jnp.max(s, axis=-1), sink)
    p = jnp.exp(s - m[..., None])
    denom = jnp.sum(p, axis=-1) + jnp.exp(sink - m)
    return p / denom[..., None]


def prompt_window_attention(q, k, v, slopes, sinks):
    b, s = q.shape[:2]
    nb = s // BLOCK
    qb = q.reshape(b, nb, BLOCK, N_KV_HEADS, Q_PER_KV, HEAD_DIM)
    pad = jnp.zeros((b, BLOCK, N_KV_HEADS, HEAD_DIM), k.dtype)
    kp = jnp.concatenate([pad, k], axis=1).reshape(b, nb + 1, BLOCK, N_KV_HEADS, HEAD_DIM)
    vp = jnp.concatenate([pad, v], axis=1).reshape(b, nb + 1, BLOCK, N_KV_HEADS, HEAD_DIM)
    kb = jnp.concatenate([kp[:, :-1], kp[:, 1:]], axis=2)
    vb = jnp.concatenate([vp[:, :-1], vp[:, 1:]], axis=2)
    scores = jnp.einsum('bnqkrd,bnskd->bnkrqs', qb, kb,
                        preferred_element_type=jnp.float32) * (HEAD_DIM ** -0.5)
    i = jnp.arange(BLOCK)[:, None]
    j = jnp.arange(2 * BLOCK)[None, :]
    delta = i + BLOCK - j
    key_pos = jnp.arange(nb)[:, None, None] * BLOCK - BLOCK + j[None]
    valid = (delta >= 0) & (delta <= WINDOW) & (key_pos >= 0)
    p = band_probs(scores, delta, valid[:, None, None], slopes, sinks)
    out = jnp.einsum('bnkrqs,bnskd->bnqkrd', p.astype(v.dtype), vb)
    return out.reshape(b, s, ATTN_WIDTH)


def sample_window_attention(q, k_new, v_new, cache_k, cache_v, slopes, sinks):
    n, t = q.shape[:2]
    k_all = jnp.concatenate([cache_k.astype(k_new.dtype), k_new], axis=1)
    v_all = jnp.concatenate([cache_v.astype(v_new.dtype), v_new], axis=1)
    scores = jnp.einsum('nqkrd,nskd->nkrqs', q, k_all,
                        preferred_element_type=jnp.float32) * (HEAD_DIM ** -0.5)
    i = jnp.arange(t)[:, None]
    j = jnp.arange(WINDOW + t)[None, :]
    delta = i + WINDOW - j
    valid = (delta >= 0) & (delta <= WINDOW)
    p = band_probs(scores, delta, valid, slopes, sinks)
    out = jnp.einsum('nkrqs,nskd->nqkrd', p.astype(v_all.dtype), v_all)
    return out.reshape(n, t, ATTN_WIDTH), k_all[:, -WINDOW:], v_all[:, -WINDOW:]


def ssm_discretize(A_re, A_im, log_dt, B_re, B_im):
    A = lax.complex(A_re.astype(jnp.float32), A_im.astype(jnp.float32))
    dt = jnp.exp(log_dt.astype(jnp.float32))[:, None]
    A_bar = jnp.exp(A * dt)
    B = lax.complex(B_re.astype(jnp.float32), B_im.astype(jnp.float32))
    B_bar = ((A_bar - 1.0) / A)[..., None] * B
    return A_bar, B_bar


def ssm_combine(e1, e2):
    a1, b1 = e1
    a2, b2 = e2
    return a1 * a2, a2 * b1 + b2


def ssm_mixer(u, h0_re, h0_im, A_bar, B_bar, C_re, C_im, D_skip):
    n, t = u.shape[:2]
    uf = u.astype(jnp.float32).reshape(n, t, N_SSM_GROUPS, SSM_GROUP)
    bu = jnp.einsum('ntgh,gph->ntgp', uf.astype(jnp.complex64), B_bar)
    h0 = lax.complex(h0_re.astype(jnp.float32), h0_im.astype(jnp.float32))
    bu = bu.at[:, 0].add(A_bar * h0)
    a = jnp.broadcast_to(A_bar, bu.shape)
    _, h = lax.associative_scan(ssm_combine, (a, bu), axis=1)
    C = lax.complex(C_re.astype(jnp.float32), C_im.astype(jnp.float32))
    y = jnp.real(jnp.einsum('ntgp,ghp->ntgh', h, C)) \
        + D_skip.astype(jnp.float32).reshape(N_SSM_GROUPS, SSM_GROUP) * uf
    h_last = h[:, -1]
    return y.reshape(n, t, SSM_WIDTH), jnp.real(h_last), jnp.imag(h_last)


def hybrid_layer(x, cache_k, cache_v, h0_re, h0_im, p):
    t = x.shape[1]
    z = rmsnorm(x, p['attn_norm_g']) @ p['w_in']
    q, k, v, u = split_projection(z)
    q = rmsnorm(q, p['q_norm_g'])
    k = rmsnorm(k, p['k_norm_g'])
    slopes = alibi_slopes()
    sinks = p['attn_sinks'].astype(jnp.float32).reshape(N_KV_HEADS, Q_PER_KV)
    if cache_k is None:
        attn = prompt_window_attention(q, k, v, slopes, sinks)
        new_k = k[:, t - WINDOW:]
        new_v = v[:, t - WINDOW:]
    else:
        attn, new_k, new_v = sample_window_attention(q, k, v, cache_k, cache_v, slopes, sinks)
    A_bar, B_bar = ssm_discretize(p['ssm_A_re'], p['ssm_A_im'], p['ssm_log_dt'],
                                  p['ssm_B_re'], p['ssm_B_im'])
    y_ssm, h_re, h_im = ssm_mixer(u, h0_re, h0_im, A_bar, B_bar,
                                  p['ssm_C_re'], p['ssm_C_im'], p['ssm_D'])
    g = jax.nn.gelu(y_ssm)
    ssm_out = (g * jax.nn.sigmoid(g @ p['w_glu'].astype(jnp.float32)
                                  + p['b_glu'].astype(jnp.float32))).astype(x.dtype)
    mix = jnp.concatenate([rmsnorm(attn, p['attn_out_g']),
                           rmsnorm(ssm_out, p['ssm_out_g'])], axis=-1)
    h = x + mix @ p['w_out']
    y = h + jnp.square(jax.nn.relu(rmsnorm(h, p['mlp_norm_g']) @ p['w_mlp_up'])) @ p['w_mlp_down']
    return y, new_k, new_v, h_re.astype(h0_re.dtype), h_im.astype(h0_im.dtype)


def setup_inputs(seed: int = 0) -> dict:
    key = jax.random.key(seed)
    ks = jax.random.split(key, 32)
    f32 = jnp.float32
    nrm = lambda k, shape, s: jax.random.normal(k, shape, f32) * s
    gain = lambda k, shape: 1.0 + 0.05 * jax.random.normal(k, shape, f32)
    L = DEPTH
    G, P, H = N_SSM_GROUPS, STATE_DIM, SSM_GROUP
    a_im_base = math.pi * jnp.arange(P, dtype=f32)
    return {
        'x_prompt': nrm(ks[0], (BATCH, SEQ, D_MODEL), 1.0),
        'x_sample': nrm(ks[1], (DEC_BATCH, DEC_SEQ, D_MODEL), 1.0),
        'cache_k': nrm(ks[2], (L, DEC_BATCH, WINDOW, N_KV_HEADS, HEAD_DIM), 1.0),
        'cache_v': nrm(ks[3], (L, DEC_BATCH, WINDOW, N_KV_HEADS, HEAD_DIM), 1.0),
        'state_ssm_re': nrm(ks[4], (L, DEC_BATCH, G, P), 0.3),
        'state_ssm_im': nrm(ks[5], (L, DEC_BATCH, G, P), 0.3),
        'attn_norm_g': gain(ks[6], (L, D_MODEL)),
        'w_in': nrm(ks[7], (L, D_MODEL, PROJ_WIDTH), D_MODEL ** -0.5),
        'q_norm_g': gain(ks[8], (L, HEAD_DIM)),
        'k_norm_g': gain(ks[9], (L, HEAD_DIM)),
        'attn_sinks': nrm(ks[10], (L, N_HEADS), 1.0),
        'ssm_A_re': -0.5 + 0.01 * jax.random.normal(ks[11], (L, G, P), f32),
        'ssm_A_im': a_im_base + 0.01 * jax.random.normal(ks[12], (L, G, P), f32),
        'ssm_log_dt': jax.random.uniform(ks[13], (L, G), f32, math.log(DT_MIN), math.log(DT_MAX)),
        'ssm_B_re': nrm(ks[14], (L, G, P, H), (2 * H) ** -0.5),
        'ssm_B_im': nrm(ks[15], (L, G, P, H), (2 * H) ** -0.5),
        'ssm_C_re': nrm(ks[16], (L, G, H, P), (2 * P) ** -0.5),
        'ssm_C_im': nrm(ks[17], (L, G, H, P), (2 * P) ** -0.5),
        'ssm_D': nrm(ks[18], (L, SSM_WIDTH), 1.0),
        'w_glu': nrm(ks[19], (L, SSM_WIDTH, SSM_WIDTH), SSM_WIDTH ** -0.5),
        'b_glu': nrm(ks[20], (L, SSM_WIDTH), 0.01),
        'attn_out_g': gain(ks[21], (L, ATTN_WIDTH)),
        'ssm_out_g': gain(ks[22], (L, SSM_WIDTH)),
        'w_out': nrm(ks[23], (L, D_MODEL, D_MODEL), D_MODEL ** -0.5),
        'mlp_norm_g': gain(ks[24], (L, D_MODEL)),
        'w_mlp_up': nrm(ks[25], (L, D_MODEL, D_FF), D_MODEL ** -0.5),
        'w_mlp_down': nrm(ks[26], (L, D_FF, D_MODEL), D_FF ** -0.5),
    }


def reference(x_prompt, x_sample, cache_k, cache_v, state_ssm_re, state_ssm_im,
              attn_norm_g, w_in, q_norm_g, k_norm_g, attn_sinks,
              ssm_A_re, ssm_A_im, ssm_log_dt, ssm_B_re, ssm_B_im, ssm_C_re, ssm_C_im, ssm_D,
              w_glu, b_glu, attn_out_g, ssm_out_g, w_out, mlp_norm_g, w_mlp_up, w_mlp_down):
    xp = x_prompt
    xs = x_sample
    zeros_state = jnp.zeros((x_prompt.shape[0], N_SSM_GROUPS, STATE_DIM), jnp.float32)
    nkp, nvp, nrp, nip = [], [], [], []
    nks, nvs, nrs, nis = [], [], [], []
    for l in range(DEPTH):
        p = dict(attn_norm_g=attn_norm_g[l], w_in=w_in[l], q_norm_g=q_norm_g[l],
                 k_norm_g=k_norm_g[l], attn_sinks=attn_sinks[l],
                 ssm_A_re=ssm_A_re[l], ssm_A_im=ssm_A_im[l], ssm_log_dt=ssm_log_dt[l],
                 ssm_B_re=ssm_B_re[l], ssm_B_im=ssm_B_im[l],
                 ssm_C_re=ssm_C_re[l], ssm_C_im=ssm_C_im[l], ssm_D=ssm_D[l],
                 w_glu=w_glu[l], b_glu=b_glu[l], attn_out_g=attn_out_g[l],
                 ssm_out_g=ssm_out_g[l], w_out=w_out[l], mlp_norm_g=mlp_norm_g[l],
                 w_mlp_up=w_mlp_up[l], w_mlp_down=w_mlp_down[l])
        xp, kp, vp, hrp, hip = hybrid_layer(xp, None, None, zeros_state, zeros_state, p)
        xs, ks_, vs_, hrs, his = hybrid_layer(xs, cache_k[l], cache_v[l],
                                              state_ssm_re[l], state_ssm_im[l], p)
        nkp.append(kp); nvp.append(vp); nrp.append(hrp); nip.append(hip)
        nks.append(ks_); nvs.append(vs_); nrs.append(hrs); nis.append(his)
    return (xp, xs,
            jnp.stack(nkp), jnp.stack(nvp), jnp.stack(nrp), jnp.stack(nip),
            jnp.stack(nks), jnp.stack(nvs), jnp.stack(nrs), jnp.stack(nis))
```

```cpp
#ifndef MK_PER_PHASE
#define MK_PER_PHASE 0
#endif
#include <hip/hip_runtime.h>
#include <hip/hip_cooperative_groups.h>
#include <cstdio>
#include <cstdint>
namespace cg = cooperative_groups;
namespace pg8 {
#define PG8_LAS __attribute__((address_space(3)))
typedef unsigned short bf16_t;
typedef short bf16x8 __attribute__((ext_vector_type(8)));
typedef float f32x4 __attribute__((ext_vector_type(4)));
typedef unsigned u32x4 __attribute__((ext_vector_type(4)));
constexpr int BM = 256, BK = 64, HALF = 128, HTB = HALF * BK * 2  , STAGE_BYTES = 8 * HTB, NXCD = 8, WGM = 8;

__host__ __device__ __forceinline__ int lds_byte(int r, int c) { const int st = (r >> 4) * 2 + (c >> 5), rr = r & 15, cc = c & 31, ob = rr * 64 + cc * 2; return st * 1024 + (ob ^ (((ob >> 9) & 1) << 5)); }
__host__ __device__ __forceinline__ void stage_rc(int b, int& R, int& C) { const int st = b / 1024, sb = b % 1024, swz = sb ^ (((sb >> 9) & 1) << 5); R = (st >> 1) * 16 + swz / 64; C = (st & 1) * 32 + (swz % 64) / 2; }
__host__ __device__ __forceinline__ int perm32(int rho) { const int n = rho >> 4, i = rho & 15; return 8 * (i >> 2) + 4 * n + (i & 3); }

struct Unit { int pm, pn, k0, nt; };
struct Gemm { const bf16_t* A; const bf16_t* Bt; int M, N, K; };

struct StaticOrder {
    int nM, nN, nwg, G, c, ntk;
    __host__ __device__ void init(int M, int N, int G_, int c_, int K) { nM = M / BM; nN = N / BM; nwg = nM * nN; G = G_; c = c_; ntk = K / BK; }
    __host__ __device__ bool next(int i, Unit& u) const {
        const long L = (long)i * G + c; if (L >= nwg) return false;
        int wgid = (int)L; { const int q = nwg / NXCD, r = nwg % NXCD, xcd = wgid % NXCD, off = wgid / NXCD; wgid = (xcd < r ? xcd * (q + 1) : r * (q + 1) + (xcd - r) * q) + off; }
        const int nig = WGM * nN, gid = wgid / nig, fm = gid * WGM, gsz = (nM - fm) < WGM ? (nM - fm) : WGM;
        u.pm = fm + ((wgid % nig) % gsz); u.pn = (wgid % nig) / gsz; u.k0 = 0; u.nt = ntk; return true;
    }
    __device__ __forceinline__ void a_ready(const Unit&) const {}
    __device__ __forceinline__ void done(const Unit&) const {}
};

__device__ __forceinline__ unsigned cvt_pk_bf16(float lo, float hi) { unsigned r; asm volatile("v_cvt_pk_bf16_f32 %0, %1, %2" : "=v"(r) : "v"(lo), "v"(hi)); return r; }
typedef float f32x2 __attribute__((ext_vector_type(2)));
__device__ __forceinline__ float bf_lo(unsigned w) { return __uint_as_float(w << 16); }
__device__ __forceinline__ float bf_hi(unsigned w) { return __uint_as_float(w & 0xffff0000u); }
template <int ACT> struct EpiStoreBf16 {
    static constexpr bool PERM = true, AFTER_DRAIN = false;
    bf16_t* O; int ldc;
    __device__ __forceinline__ void operator()(const f32x4 (&acc)[2][2][4][2], const Unit& u, int wr, int wc, int fr, int fq) const {
        const int row0 = u.pm * BM + wr * 64 + fr; const int col0 = u.pn * BM + wc * 32 + 8 * fq;
#pragma unroll
        for (int ai = 0; ai < 2; ++ai)
#pragma unroll
            for (int m = 0; m < 4; ++m) { bf16_t* rowp = O + (size_t)(row0 + ai * HALF + m * 16) * ldc + col0;
#pragma unroll
                for (int bj = 0; bj < 2; ++bj) { f32x4 v0 = acc[ai][bj][m][0], v1 = acc[ai][bj][m][1];
                    if (ACT == 2) {
#pragma unroll
                        for (int i = 0; i < 4; ++i) { const float a = fmaxf(v0[i], 0.f), b = fmaxf(v1[i], 0.f); v0[i] = a * a; v1[i] = b * b; } }
                    u32x4 w; w.x = cvt_pk_bf16(v0[0], v0[1]); w.y = cvt_pk_bf16(v0[2], v0[3]); w.z = cvt_pk_bf16(v1[0], v1[1]); w.w = cvt_pk_bf16(v1[2], v1[3]);
                    *(u32x4*)(rowp + bj * HALF) = w; } }
    }
};
struct EpiGlu {
    static constexpr bool PERM = true, AFTER_DRAIN = false;
    const bf16_t* Gm; bf16_t* O; const float* bias;
    __device__ __forceinline__ void operator()(const f32x4 (&acc)[2][2][4][2], const Unit& u, int wr, int wc, int fr, int fq) const {
        const int row0 = u.pm * BM + wr * 64 + fr; const int col0 = u.pn * BM + wc * 32 + 8 * fq;
#pragma unroll
        for (int bj = 0; bj < 2; ++bj) { const f32x4 b0 = *(const f32x4*)(bias + col0 + bj * HALF), b1 = *(const f32x4*)(bias + col0 + bj * HALF + 4);
#pragma unroll
            for (int ai = 0; ai < 2; ++ai)
#pragma unroll
                for (int m = 0; m < 4; ++m) { const size_t off = (size_t)(row0 + ai * HALF + m * 16) * 1024 + col0 + bj * HALF;
                    const u32x4 gw = *(const u32x4*)(Gm + off);
                    const f32x4 a0 = acc[ai][bj][m][0] + b0, a1 = acc[ai][bj][m][1] + b1;
                    float g[8] = {bf_lo(gw.x), bf_hi(gw.x), bf_lo(gw.y), bf_hi(gw.y), bf_lo(gw.z), bf_hi(gw.z), bf_lo(gw.w), bf_hi(gw.w)};
                    float o[8];
#pragma unroll
                    for (int i = 0; i < 4; ++i) { o[i] = g[i] / (1.f + __expf(-a0[i])); o[4 + i] = g[4 + i] / (1.f + __expf(-a1[i])); }
                    u32x4 w; w.x = cvt_pk_bf16(o[0], o[1]); w.y = cvt_pk_bf16(o[2], o[3]); w.z = cvt_pk_bf16(o[4], o[5]); w.w = cvt_pk_bf16(o[6], o[7]);
                    *(u32x4*)(O + off) = w; } }
    }
};
struct EpiHres {
    static constexpr bool PERM = false, AFTER_DRAIN = false;
    const float* xp; const float* xs; float* Y; bf16_t* HG; const float* gm; float* rowss;
    __device__ __forceinline__ void operator()(const f32x4 (&acc)[2][2][4][2], const Unit& u, int wr, int wc, int fr, int fq) const {
        typedef unsigned u32x2v __attribute__((ext_vector_type(2)));
        const int colb = u.pn * BM + wc * 32 + 4 * fq;
#pragma unroll
        for (int ai = 0; ai < 2; ++ai)
#pragma unroll
            for (int m = 0; m < 4; ++m) { const int row = u.pm * BM + ai * HALF + wr * 64 + m * 16 + fr;
                const float* xrow = row < 16384 ? xp + (size_t)row * 2048 : xs + (size_t)(row - 16384) * 2048;
                float ss = 0.f;
#pragma unroll
                for (int bj = 0; bj < 2; ++bj)
#pragma unroll
                    for (int n = 0; n < 2; ++n) { const int col = colb + bj * HALF + n * 16;
                        const f32x4 xv = *(const f32x4*)(xrow + col); const f32x4 gv = *(const f32x4*)(gm + col);
                        const f32x4 h = xv + acc[ai][bj][m][n];
                        *(f32x4*)(Y + (size_t)row * 2048 + col) = h;
                        ss += (h[0] * h[0] + h[1] * h[1]) + (h[2] * h[2] + h[3] * h[3]);
                        u32x2v w; w.x = cvt_pk_bf16(h[0] * gv[0], h[1] * gv[1]); w.y = cvt_pk_bf16(h[2] * gv[2], h[3] * gv[3]);
                        *(u32x2v*)(HG + (size_t)row * 2048 + col) = w; }
                ss += __shfl_xor(ss, 16); ss += __shfl_xor(ss, 32);
                if (fq == 0) unsafeAtomicAdd(rowss + row, ss); }
    }
};
struct EpiDown {
    static constexpr bool PERM = false, AFTER_DRAIN = false;
    float* Y; const float* rowss;
    __device__ __forceinline__ void operator()(const f32x4 (&acc)[2][2][4][2], const Unit& u, int wr, int wc, int fr, int fq) const {
        const int colb = u.pn * BM + wc * 32 + 4 * fq;
#pragma unroll
        for (int ai = 0; ai < 2; ++ai)
#pragma unroll
            for (int m = 0; m < 4; ++m) { const int row = u.pm * BM + ai * HALF + wr * 64 + m * 16 + fr;
                const float ssr = __hip_atomic_load(rowss + row, __ATOMIC_RELAXED, __HIP_MEMORY_SCOPE_AGENT);
                const float r2 = 1.0f / (ssr * (1.0f / 2048.0f) + 1e-6f);
#pragma unroll
                for (int bj = 0; bj < 2; ++bj)
#pragma unroll
                    for (int n = 0; n < 2; ++n) { float* p = Y + (size_t)row * 2048 + colb + bj * HALF + n * 16; const f32x4 h = *(const f32x4*)p; *(f32x4*)p = h + acc[ai][bj][m][n] * r2; } }
    }
};
struct EpiPartial {
    static constexpr bool PERM = false, AFTER_DRAIN = false;
    float* P; int kper;
    __device__ __forceinline__ void operator()(const f32x4 (&acc)[2][2][4][2], const Unit& u, int wr, int wc, int fr, int fq) const {
        const int colb = u.pn * BM + wc * 32 + 4 * fq; float* base = P + (size_t)(u.k0 / kper) * (512 * 2048);
#pragma unroll
        for (int ai = 0; ai < 2; ++ai)
#pragma unroll
            for (int m = 0; m < 4; ++m) { const int row = (u.pm - 64) * BM + ai * HALF + wr * 64 + m * 16 + fr;
#pragma unroll
                for (int bj = 0; bj < 2; ++bj)
#pragma unroll
                    for (int n = 0; n < 2; ++n) *(f32x4*)(base + (size_t)row * 2048 + colb + bj * HALF + n * 16) = acc[ai][bj][m][n]; }
    }
};
template <int NN  , int NS  , int NTK  > struct SampleSplitOrder {
    int G, c;
    __device__ __forceinline__ void init(int G_, int c_) { G = G_; c = c_; }
    __device__ __forceinline__ bool next(int i, Unit& u) const {
        const int item = i * G + c; if (item >= 2 * NN * NS) return false;
        const int t = item / NS, s = item % NS; u.pm = 64 + t / NN; u.pn = t % NN; u.nt = NTK / NS; u.k0 = s * (NTK / NS) * BK; return true;
    }
    __device__ __forceinline__ void a_ready(const Unit&) const {}
    __device__ __forceinline__ void done(const Unit&) const {}
};

template <class Epi, class Sched, bool ALIGN_EPI = false, bool SP2 = false>
__device__ __forceinline__ void gemm_phase(PG8_LAS unsigned char* lds, const Gemm g, const Sched& S, const Epi& E) {
    int tid_ = threadIdx.x; asm volatile("" : "+v"(tid_));
    const int tid = tid_, wid = __builtin_amdgcn_readfirstlane(tid >> 6), lane = tid & 63, wr = wid >> 2, wc = wid & 3, fr = lane & 15, fq = lane >> 4;
    const int K = g.K; int nt;
    unsigned voffA[2], voffB[2];
#pragma unroll
    for (int i = 0; i < 2; ++i) { int R, C; stage_rc(tid * 16 + i * 8192, R, C); const int Rb = Epi::PERM ? ((R & ~31) + perm32(R & 31)) : R;
        voffA[i] = (unsigned)(R * K + C) * 2u; voffB[i] = (unsigned)(Rb * K + C) * 2u; }
    const size_t kstep = (size_t)(BK * 2);
    const size_t hstep = (size_t)HALF * K * 2;
    const size_t tstep = 2 * hstep;
    const unsigned ldsw = (unsigned)wid * 1024u;
    const int aoff = lds_byte(wr * 64 + fr, fq * 8), boff = lds_byte(wc * 32 + fr, fq * 8);
#define PG8_SA(b, h) (((b) * 2 + (h)) * HTB)
#define PG8_SB(b, h) ((4 + (b) * 2 + (h)) * HTB)
#define PG8_STAGE(bufoff, gbase, voff) do { _Pragma("unroll") for (int _i = 0; _i < 2; ++_i) \
        __builtin_amdgcn_global_load_lds((const unsigned*)((const char*)(gbase) + (voff)[_i]), (PG8_LAS unsigned*)(lds + (bufoff) + ldsw + _i * 8192), 16, 0, 0); } while (0)
#define PG8_LDA(dst, b, h) do { _Pragma("unroll") for (int m = 0; m < 4; ++m) _Pragma("unroll") for (int k = 0; k < 2; ++k) dst[m][k] = *(const PG8_LAS bf16x8*)(lds + PG8_SA(b, h) + aoff + m * 2048 + k * 1024); } while (0)
#define PG8_LDB(dst, b, h) do { _Pragma("unroll") for (int n = 0; n < 2; ++n) _Pragma("unroll") for (int k = 0; k < 2; ++k) dst[n][k] = *(const PG8_LAS bf16x8*)(lds + PG8_SB(b, h) + boff + n * 2048 + k * 1024); } while (0)
#define PG8_MMA(ai, bj, At, Bt) do { __builtin_amdgcn_s_setprio(1); _Pragma("unroll") for (int m = 0; m < 4; ++m) _Pragma("unroll") for (int n = 0; n < 2; ++n) _Pragma("unroll") for (int k = 0; k < 2; ++k) \
        acc[ai][bj][m][n] = __builtin_amdgcn_mfma_f32_16x16x32_bf16(Bt[n][k], At[m][k], acc[ai][bj][m][n], 0, 0, 0); __builtin_amdgcn_s_setprio(0); } while (0)
#define PG8_WAIT_V(n) asm volatile("s_waitcnt vmcnt(" #n ")" ::: "memory")
#define PG8_WAIT_L(n) asm volatile("s_waitcnt lgkmcnt(" #n ")" ::: "memory")
#define PG8_BAR __builtin_amdgcn_s_barrier()
#define PG8_SCHED __builtin_amdgcn_sched_barrier(0)
    Unit cur, nxt; int ui = 0;
    if (!S.next(0, cur)) return;
    nt = cur.nt;
    f32x4 acc[2][2][4][2];
#pragma unroll
    for (int a = 0; a < 2; ++a)
#pragma unroll
        for (int b = 0; b < 2; ++b)
#pragma unroll
            for (int m = 0; m < 4; ++m)
#pragma unroll
                for (int n = 0; n < 2; ++n) acc[a][b][m][n] = (f32x4){0.f, 0.f, 0.f, 0.f};
    bf16x8 At[4][2], B0[2][2], B1[2][2];
    const char* cA = (const char*)g.A + (size_t)cur.pm * tstep + (size_t)cur.k0 * 2; const char* cB = (const char*)g.Bt + (size_t)cur.pn * tstep + (size_t)cur.k0 * 2;
    S.a_ready(cur);
    if constexpr (SP2) {
        PG8_STAGE(PG8_SB(0, 0), cB, voffB); PG8_STAGE(PG8_SB(0, 1), cB + hstep, voffB); PG8_STAGE(PG8_SA(0, 0), cA, voffA); PG8_STAGE(PG8_SA(0, 1), cA + hstep, voffA);
        if (wr == 1) PG8_BAR;
        PG8_WAIT_V(2); PG8_BAR;
        PG8_STAGE(PG8_SB(1, 0), cB + kstep, voffB); PG8_STAGE(PG8_SA(1, 0), cA + kstep, voffA); PG8_STAGE(PG8_SB(1, 1), cB + hstep + kstep, voffB);
        PG8_WAIT_V(6); PG8_BAR;
    } else {
        PG8_STAGE(PG8_SB(0, 0), cB, voffB); PG8_STAGE(PG8_SA(0, 0), cA, voffA); PG8_STAGE(PG8_SB(0, 1), cB + hstep, voffB); PG8_STAGE(PG8_SA(0, 1), cA + hstep, voffA);
        if (wr == 1) PG8_BAR;
        PG8_WAIT_V(4); PG8_BAR;
        PG8_STAGE(PG8_SB(1, 0), cB + kstep, voffB); PG8_STAGE(PG8_SA(1, 0), cA + kstep, voffA); PG8_STAGE(PG8_SB(1, 1), cB + hstep + kstep, voffB);
        PG8_WAIT_V(6); PG8_BAR;
    }
    for (;;) {
        const bool has_next = S.next(ui + 1, nxt);
        const char* nA = has_next ? (const char*)g.A + (size_t)nxt.pm * tstep + (size_t)nxt.k0 * 2 : cA; const char* nB = has_next ? (const char*)g.Bt + (size_t)nxt.pn * tstep + (size_t)nxt.k0 * 2 : cB;
        for (int t = 0; t < nt; t += 2) {
            const bool last = (t == nt - 2);
            const char* a1 = cA + (size_t)(t + 1) * kstep;
            const char* a2 = last ? nA : cA + (size_t)(t + 2) * kstep; const char* b2 = last ? nB : cB + (size_t)(t + 2) * kstep;
            const char* a3 = a2 + kstep; const char* b3 = b2 + kstep;
            if (last && has_next) S.a_ready(nxt);
            if constexpr (SP2) {
            PG8_LDB(B0, 0, 0); PG8_LDB(B1, 0, 1); PG8_SCHED; PG8_LDA(At, 0, 0); PG8_STAGE(PG8_SA(1, 1), a1 + hstep, voffA);
            PG8_WAIT_V(8); PG8_WAIT_L(0); PG8_BAR; PG8_MMA(0, 0, At, B0); PG8_MMA(0, 1, At, B1); PG8_BAR; PG8_SCHED;
            PG8_LDA(At, 0, 1); PG8_STAGE(PG8_SB(0, 0), b2, voffB); PG8_STAGE(PG8_SB(0, 1), b2 + hstep, voffB); PG8_STAGE(PG8_SA(0, 0), a2, voffA);
            PG8_WAIT_V(8); PG8_WAIT_L(0); PG8_BAR; PG8_MMA(1, 0, At, B0); PG8_MMA(1, 1, At, B1); PG8_BAR; PG8_SCHED;
            PG8_LDB(B0, 1, 0); PG8_LDB(B1, 1, 1); PG8_SCHED; PG8_LDA(At, 1, 0); PG8_STAGE(PG8_SA(0, 1), a2 + hstep, voffA);
            PG8_WAIT_V(8); PG8_WAIT_L(0); PG8_BAR; PG8_MMA(0, 0, At, B0); PG8_MMA(0, 1, At, B1); PG8_BAR; PG8_SCHED;
            PG8_LDA(At, 1, 1); PG8_STAGE(PG8_SB(1, 0), b3, voffB); PG8_STAGE(PG8_SB(1, 1), b3 + hstep, voffB); PG8_STAGE(PG8_SA(1, 0), a3, voffA);
            PG8_WAIT_V(8); PG8_WAIT_L(0); PG8_BAR; PG8_MMA(1, 0, At, B0); PG8_MMA(1, 1, At, B1); PG8_BAR; PG8_SCHED;
            } else {
            PG8_LDB(B0, 0, 0); PG8_SCHED; PG8_LDA(At, 0, 0); PG8_STAGE(PG8_SA(1, 1), a1 + hstep, voffA);
            PG8_WAIT_L(8); PG8_BAR; PG8_WAIT_L(0); PG8_MMA(0, 0, At, B0); PG8_BAR; PG8_SCHED;
            PG8_LDB(B1, 0, 1); PG8_STAGE(PG8_SB(0, 0), b2, voffB);
            PG8_BAR; PG8_WAIT_L(0); PG8_MMA(0, 1, At, B1); PG8_BAR;
            PG8_LDA(At, 0, 1); PG8_STAGE(PG8_SA(0, 0), a2, voffA);
            PG8_BAR; PG8_WAIT_L(0); PG8_MMA(1, 0, At, B0); PG8_BAR; PG8_SCHED;
            PG8_STAGE(PG8_SB(0, 1), b2 + hstep, voffB);
            PG8_WAIT_V(6); PG8_BAR; PG8_MMA(1, 1, At, B1); PG8_BAR;
            PG8_LDB(B0, 1, 0); PG8_SCHED; PG8_LDA(At, 1, 0); PG8_STAGE(PG8_SA(0, 1), a2 + hstep, voffA);
            PG8_WAIT_L(8); PG8_BAR; PG8_WAIT_L(0); PG8_MMA(0, 0, At, B0); PG8_BAR; PG8_SCHED;
            PG8_LDB(B1, 1, 1); PG8_STAGE(PG8_SB(1, 0), b3, voffB);
            PG8_BAR; PG8_WAIT_L(0); PG8_MMA(0, 1, At, B1); PG8_BAR;
            PG8_LDA(At, 1, 1); PG8_STAGE(PG8_SA(1, 0), a3, voffA);
            PG8_BAR; PG8_WAIT_L(0); PG8_MMA(1, 0, At, B0); PG8_BAR; PG8_SCHED;
            PG8_STAGE(PG8_SB(1, 1), b3 + hstep, voffB);
            PG8_WAIT_V(6); PG8_BAR; PG8_MMA(1, 1, At, B1); PG8_BAR;
            }
        }
        if constexpr (ALIGN_EPI) { if (wr == 0) PG8_BAR; }
        if constexpr (!Epi::AFTER_DRAIN) { E(acc, cur, wr, wc, fr, fq); S.done(cur); }
        if (!has_next) break;
#pragma unroll
        for (int a = 0; a < 2; ++a)
#pragma unroll
            for (int b = 0; b < 2; ++b)
#pragma unroll
                for (int m = 0; m < 4; ++m)
#pragma unroll
                    for (int n = 0; n < 2; ++n) acc[a][b][m][n] = (f32x4){0.f, 0.f, 0.f, 0.f};
        cur = nxt; cA = nA; cB = nB; ++ui; nt = cur.nt;
        if constexpr (ALIGN_EPI) { if (wr == 1) PG8_BAR; }
    }
    PG8_WAIT_V(0);
    if constexpr (!ALIGN_EPI) { if (wr == 0) PG8_BAR; }
    PG8_BAR;
    if constexpr (Epi::AFTER_DRAIN) { E.fused(acc, cur, wr, wc, fr, fq, lds, wid, lane); S.done(cur); }
#undef PG8_SA
#undef PG8_SB
#undef PG8_STAGE
#undef PG8_LDA
#undef PG8_LDB
#undef PG8_MMA
#undef PG8_WAIT_V
#undef PG8_WAIT_L
#undef PG8_BAR
#undef PG8_SCHED
}
}

#define LAS __attribute__((address_space(3)))
typedef unsigned short bf16;
typedef unsigned v4u __attribute__((ext_vector_type(4)));
typedef unsigned v2u __attribute__((ext_vector_type(2)));
typedef float f32x4 __attribute__((ext_vector_type(4)));
typedef float f32x16 __attribute__((ext_vector_type(16)));
typedef float f32x2 __attribute__((ext_vector_type(2)));
typedef short bf16x8 __attribute__((ext_vector_type(8)));

#ifndef MK_PER_PHASE
#define MK_PER_PHASE 0
#endif
constexpr int NPHASE = 9;
constexpr int NWAVES = 8, NTHR = 512;
constexpr int MP = 16384, MS = 512, MT = MP + MS;
constexpr int DM = 2048, PW = 2560, AW = 1024, SWD = 1024, FF = 8192;
constexpr float EPSN = 1e-6f, LOG2E = 1.4426950408889634f;
constexpr int LDS_PHASE = 152576;
constexpr int LDS_BYTES = LDS_PHASE + 64;

constexpr size_t MiB = 1u << 20;
constexpr size_t WS_CTL = 0, CTL_ZERO_BYTES = 128 * 1024, WS_BAR = 96 * 1024;
constexpr size_t WS_WIN = 1 * MiB, WS_WGLU = 11 * MiB, WS_WOUT = 13 * MiB, WS_WUP = 21 * MiB, WS_WDN = 53 * MiB;
constexpr size_t WS_WSF = 85 * MiB, WS_WHF = 89 * MiB, WS_TF = 93 * MiB, WS_LAM = 94 * MiB + 512 * 1024, WS_LAM16 = WS_LAM + 32768, WS_BBAR = WS_LAM + 65536;
constexpr size_t WS_HG = 96 * MiB;
constexpr size_t WS_PART = WS_HG;
constexpr size_t WS_ACT = 162 * MiB;
constexpr size_t WS_XN = 162 * MiB, WS_Z = 228 * MiB, WS_ATT = 311 * MiB, WS_G = 344 * MiB, WS_SO = 377 * MiB, WS_MIX = 410 * MiB, WS_END = 476 * MiB;

constexpr size_t O_Y = 0, O_KP = (size_t)MT * DM, O_VP = O_KP + 262144, O_RP = O_VP + 262144, O_IP = O_RP + 32768, O_KS = O_IP + 32768,
                 O_VS = O_KS + 4194304, O_RS = O_VS + 4194304, O_IS = O_RS + 524288, O_END = O_IS + 524288;

struct Args { const float* in[27]; float* out; unsigned char* ws; int ph_lo, ph_hi; };
enum { I_XP = 0, I_XS, I_CK, I_CV, I_SR, I_SI, I_ANG, I_WIN, I_QG, I_KG, I_SINK, I_ARE, I_AIM, I_LDT, I_BRE, I_BIM, I_CRE, I_CIM, I_D, I_WGLU, I_BGLU,
       I_AOG, I_SOG, I_WOUT, I_MNG, I_WUP, I_WDN };

__device__ __forceinline__ unsigned pk2(float lo, float hi) { unsigned r; asm("v_cvt_pk_bf16_f32 %0, %1, %2" : "=v"(r) : "v"(lo), "v"(hi)); return r; }
__device__ __forceinline__ unsigned f2bf(float f) { return pk2(f, 0.f) & 0xffffu; }
__device__ __forceinline__ float bflo(unsigned w) { return __uint_as_float(w << 16); }
__device__ __forceinline__ float bfhi(unsigned w) { return __uint_as_float(w & 0xffff0000u); }
__device__ __forceinline__ float wave_sum(float v) {
#pragma unroll
    for (int o = 1; o < 64; o <<= 1) v += __shfl_xor(v, o);
    return v;
}
__device__ __forceinline__ int crow(int r, int hi) { return (r & 3) + 8 * (r >> 2) + 4 * hi; }
__device__ __forceinline__ float gelu_tanh(float y) { const float z = 1.5957691216057308f * (y + 0.044715f * y * y * y); return y / (1.f + __expf(-z)); }

__device__ __forceinline__ void p0_transpose_item(const float* W, int K, int N, bf16* WT, LAS float* scr, int item, int lane) {
    const int nblk = N / 32, kb = item / nblk, nb = item % nblk, k0 = 64 * kb, n0 = 32 * nb;
    f32x4 v[8];
#pragma unroll
    for (int i = 0; i < 8; ++i) v[i] = *(const f32x4*)(W + (size_t)(k0 + 8 * i + (lane >> 3)) * N + n0 + 4 * (lane & 7));
#pragma unroll
    for (int i = 0; i < 8; ++i) { LAS float* d = scr + (8 * i + (lane >> 3)) * 33 + 4 * (lane & 7); d[0] = v[i].x; d[1] = v[i].y; d[2] = v[i].z; d[3] = v[i].w; }
    asm volatile("s_waitcnt lgkmcnt(0)" ::: "memory");
    const int c = lane & 7;
#pragma unroll
    for (int j = 0; j < 4; ++j) { const int n = (lane >> 3) + 8 * j; const LAS float* s = scr + (8 * c) * 33 + n;
        v4u o; o.x = pk2(s[0 * 33], s[1 * 33]); o.y = pk2(s[2 * 33], s[3 * 33]); o.z = pk2(s[4 * 33], s[5 * 33]); o.w = pk2(s[6 * 33], s[7 * 33]);
        *(v4u*)(WT + (size_t)(n0 + n) * K + k0 + 8 * c) = o; }
    asm volatile("s_waitcnt lgkmcnt(0)" ::: "memory");
}
struct cpx { float re, im; };
__device__ __forceinline__ cpx cmul(cpx a, cpx b) { return {a.re * b.re - a.im * b.im, a.re * b.im + a.im * b.re}; }
__device__ __forceinline__ cpx lam_pow(float a, float th, int n) { const float e = expf((float)n * a), x = (float)n * th; return {e * cosf(x), e * sinf(x)}; }
__device__ __forceinline__ cpx zoh_coef(float are, float aim, float dt) {
    const float a = dt * are, th = dt * aim, em1 = expm1f(a), s = sinf(th), c = cosf(th), sh = sinf(0.5f * th);
    const float nr = em1 * c - 2.f * sh * sh, ni = (em1 + 1.f) * s, den = are * are + aim * aim;
    return {(nr * are + ni * aim) / den, (ni * are - nr * aim) / den};
}

__device__ __forceinline__ void p0_prologue(const Args& A, LAS unsigned char* lds, int vcu, int G, int tid, int wave, int lane) {
    unsigned char* ws = A.ws;
    LAS float* scr = (LAS float*)(lds + wave * 8448);
    const int gw = vcu * NWAVES + wave, NGW = G * NWAVES;
    constexpr int I_1 = (DM / 64) * (PW / 32);
    for (int it = gw; it < I_1; it += NGW) p0_transpose_item(A.in[I_WIN], DM, PW, (bf16*)(ws + WS_WIN), scr, it, lane);
    {
        f32x4 gv[8];
#pragma unroll
        for (int j = 0; j < 8; ++j) gv[j] = ((const f32x4*)A.in[I_ANG])[lane + 64 * j];
        bf16* XN = (bf16*)(ws + WS_XN);
        for (int m = gw; m < MT; m += NGW) {
            const float* xrow = m < MP ? A.in[I_XP] + (size_t)m * DM : A.in[I_XS] + (size_t)(m - MP) * DM;
            f32x4 v[8]; float s = 0.f;
#pragma unroll
            for (int j = 0; j < 8; ++j) { v[j] = ((const f32x4*)xrow)[lane + 64 * j]; s += (v[j].x * v[j].x + v[j].y * v[j].y) + (v[j].z * v[j].z + v[j].w * v[j].w); }
            const float r = rsqrtf(wave_sum(s) * (1.f / DM) + EPSN);
            v2u* o8 = (v2u*)(XN + (size_t)m * DM) + lane;
#pragma unroll
            for (int j = 0; j < 8; ++j) { v2u w; w.x = pk2(v[j].x * r * gv[j].x, v[j].y * r * gv[j].y); w.y = pk2(v[j].z * r * gv[j].z, v[j].w * r * gv[j].w); o8[64 * j] = w; }
        }
    }
    const float* Are = A.in[I_ARE]; const float* Aim = A.in[I_AIM]; const float* Ldt = A.in[I_LDT];
    const float* Bre = A.in[I_BRE]; const float* Bim = A.in[I_BIM]; const float* Cre = A.in[I_CRE]; const float* Cim = A.in[I_CIM];
    const int gt = vcu * NTHR + tid, NT = G * NTHR;
    for (int idx = gt; idx < 4096; idx += NT) {
        const int g = idx >> 6, p = idx & 63; const float dt = expf(Ldt[g]), are = Are[idx], aim = Aim[idx];
        const cpx l1 = lam_pow(dt * are, dt * aim, 1), l16 = lam_pow(dt * are, dt * aim, 16), cf = zoh_coef(are, aim, dt);
        ((float2*)(ws + WS_LAM))[idx] = make_float2(l1.re, l1.im); ((float2*)(ws + WS_LAM16))[idx] = make_float2(l16.re, l16.im);
#pragma unroll 4
        for (int ch = 0; ch < 16; ++ch) { const cpx b = cmul(cf, cpx{Bre[idx * 16 + ch], Bim[idx * 16 + ch]}); ((float2*)(ws + WS_BBAR))[(g * 16 + ch) * 64 + p] = make_float2(b.re, b.im); }
    }
    for (int idx = gt; idx < 64 * 4 * 16 * 64; idx += NT) {
        const int l = idx & 63, s = (idx >> 6) & 15, rt = (idx >> 10) & 3, g = idx >> 12, r32 = l & 31, hi = l >> 5;
        const int m = 32 * rt + r32, p = m & 63, part = m >> 6, gp = g * 64 + p; const float dt = expf(Ldt[g]), are = Are[gp], aim = Aim[gp];
        const cpx w = cmul(lam_pow(dt * are, dt * aim, 15 - s), zoh_coef(are, aim, dt));
        float v[8];
#pragma unroll
        for (int j = 0; j < 8; ++j) { const int ch = 8 * hi + j; const float br = Bre[gp * 16 + ch], bi = Bim[gp * 16 + ch]; v[j] = part ? (w.re * bi + w.im * br) : (w.re * br - w.im * bi); }
        v4u o; o.x = pk2(v[0], v[1]); o.y = pk2(v[2], v[3]); o.z = pk2(v[4], v[5]); o.w = pk2(v[6], v[7]);
        ((v4u*)(ws + WS_WSF))[idx] = o;
    }
    for (int idx = gt; idx < 64 * 8 * 8 * 64; idx += NT) {
        const int l = idx & 63, kb = (idx >> 6) & 7, tt = (idx >> 9) & 7, g = idx >> 12, r32 = l & 31, hi = l >> 5;
        const int ti = r32 >> 4, chp = r32 & 15, tl = 2 * tt + ti; const float dt = expf(Ldt[g]);
        float v[8];
#pragma unroll
        for (int jp = 0; jp < 4; ++jp) { const int p = 8 * kb + 4 * hi + jp, gp = g * 64 + p;
            const cpx w = cmul(cpx{Cre[(g * 16 + chp) * 64 + p], Cim[(g * 16 + chp) * 64 + p]}, lam_pow(dt * Are[gp], dt * Aim[gp], tl + 1));
            v[2 * jp] = w.re; v[2 * jp + 1] = -w.im; }
        v4u o; o.x = pk2(v[0], v[1]); o.y = pk2(v[2], v[3]); o.z = pk2(v[4], v[5]); o.w = pk2(v[6], v[7]);
        ((v4u*)(ws + WS_WHF))[idx] = o;
    }
    __syncthreads();
    for (int g2 = vcu; g2 < 32; g2 += G) {
        LAS f32x2* pw = (LAS f32x2*)lds;
        LAS f32x2* cf = (LAS f32x2*)(lds + 16384);
        if (tid < 128) { const int gs = tid >> 6, p = tid & 63, gp = (2 * g2 + gs) * 64 + p; const float dt = expf(Ldt[2 * g2 + gs]), are = Are[gp], aim = Aim[gp];
            const cpx c1 = zoh_coef(are, aim, dt); cf[gs * 64 + p] = f32x2{c1.re, c1.im};
#pragma unroll 1
            for (int lag = 0; lag < 16; ++lag) { const cpx w = lam_pow(dt * are, dt * aim, lag); pw[(gs * 16 + lag) * 64 + p] = f32x2{w.re, w.im}; } }
        __syncthreads();
        {
            const int gs = tid >> 8, chp = (tid >> 4) & 15, ch = tid & 15, g = 2 * g2 + gs;
            float acc[16];
#pragma unroll
            for (int l = 0; l < 16; ++l) acc[l] = 0.f;
            for (int p = 0; p < 64; ++p) { const f32x2 c2 = cf[gs * 64 + p];
                const cpx q = cmul(cmul(cpx{Cre[(g * 16 + chp) * 64 + p], Cim[(g * 16 + chp) * 64 + p]}, cpx{c2.x, c2.y}), cpx{Bre[(g * 64 + p) * 16 + ch], Bim[(g * 64 + p) * 16 + ch]});
#pragma unroll
                for (int l = 0; l < 16; ++l) { const f32x2 w = pw[(gs * 16 + l) * 64 + p]; acc[l] += q.re * w.x - q.im * w.y; } }
            bf16* TF = (bf16*)(ws + WS_TF) + (size_t)g * 17 * 512;
            const int hi2 = ch >> 3, j = ch & 7;
#pragma unroll
            for (int l = 0; l < 16; ++l) { const unsigned short v = (unsigned short)f2bf(acc[l]);
                TF[(l * 64 + 32 * hi2 + 16 + chp) * 8 + j] = v;
                if (l < 15) TF[((l + 1) * 64 + 32 * hi2 + chp) * 8 + j] = v; }
            TF[(0 * 64 + 32 * hi2 + chp) * 8 + j] = 0;
            TF[(16 * 64 + 32 * hi2 + chp) * 8 + j] = 0; TF[(16 * 64 + 32 * hi2 + 16 + chp) * 8 + j] = 0;
        }
        __syncthreads();
    }
}

constexpr int KLS = 72, VTS = 264;
constexpr int LDS_K = 0, LDS_VT = 256 * KLS * 2;

__device__ __forceinline__ void attn_qtile(const LAS bf16* Kl, const LAS bf16* Vt, int kt0, const bf16x8 (&qf)[4], int iq, float slope2, float sink2, int jmin,
                                           f32x16 (&o)[2], float& inv_denom, int r32, int hi) {
    f32x16 S[5];
#pragma unroll
    for (int t5 = 0; t5 < 5; ++t5) {
        S[t5] = f32x16{};
#pragma unroll
        for (int d0 = 0; d0 < 4; ++d0) { const bf16x8 kf = *(const LAS bf16x8*)(Kl + (32 * (kt0 + t5) + r32) * KLS + 16 * d0 + 8 * hi); S[t5] = __builtin_amdgcn_mfma_f32_32x32x16_bf16(kf, qf[d0], S[t5], 0, 0, 0); }
    }
    float mx = sink2;
#pragma unroll
    for (int t5 = 0; t5 < 5; ++t5)
#pragma unroll
        for (int r = 0; r < 16; ++r) { const int j = 32 * (kt0 + t5) + crow(r, hi), delta = iq + 128 - j; const bool valid = (delta >= 0) && (delta <= 128) && (j >= jmin);
            const float s = valid ? S[t5][r] - slope2 * (float)delta : -1e30f; S[t5][r] = s; mx = fmaxf(mx, s); }
    mx = fmaxf(mx, __shfl_xor(mx, 32));
    float sum = 0.f;
#pragma unroll
    for (int t5 = 0; t5 < 5; ++t5)
#pragma unroll
        for (int r = 0; r < 16; ++r) { const float p = __builtin_amdgcn_exp2f(S[t5][r] - mx); sum += p; S[t5][r] = p; }
    sum += __shfl_xor(sum, 32);
    inv_denom = 1.0f / (sum + __builtin_amdgcn_exp2f(sink2 - mx));
    o[0] = f32x16{}; o[1] = f32x16{};
#pragma unroll
    for (int t5 = 0; t5 < 5; ++t5)
#pragma unroll
        for (int s2 = 0; s2 < 2; ++s2) {
            v4u pw; pw.x = pk2(S[t5][8 * s2 + 0], S[t5][8 * s2 + 1]); pw.y = pk2(S[t5][8 * s2 + 2], S[t5][8 * s2 + 3]); pw.z = pk2(S[t5][8 * s2 + 4], S[t5][8 * s2 + 5]); pw.w = pk2(S[t5][8 * s2 + 6], S[t5][8 * s2 + 7]);
            const bf16x8 pf = __builtin_bit_cast(bf16x8, pw);
#pragma unroll
            for (int dt = 0; dt < 2; ++dt) { const LAS bf16* vr = Vt + (32 * dt + r32) * VTS + 32 * (kt0 + t5) + 16 * s2 + 4 * hi;
                const v2u lo = *(const LAS v2u*)vr, hh = *(const LAS v2u*)(vr + 8); v4u vw; vw.x = lo.x; vw.y = lo.y; vw.z = hh.x; vw.w = hh.y;
                o[dt] = __builtin_amdgcn_mfma_f32_32x32x16_bf16(__builtin_bit_cast(bf16x8, vw), pf, o[dt], 0, 0, 0); }
        }
}
__device__ __forceinline__ void attn_qtile_fast(const LAS bf16* Kl, const LAS bf16* Vt, int kt0, const bf16x8 (&qf)[4], int iq, float slope2, float sink2,
                                                f32x16 (&o)[2], float& inv_denom, int r32, int hi) {
    f32x16 S[5];
    const float sbase = slope2 * (float)(4 * hi);
#pragma unroll
    for (int t5 = 0; t5 < 5; ++t5) {
        S[t5] = f32x16{};
#pragma unroll
        for (int d0 = 0; d0 < 4; ++d0) { const bf16x8 kf = *(const LAS bf16x8*)(Kl + (32 * (kt0 + t5) + r32) * KLS + 16 * d0 + 8 * hi); S[t5] = __builtin_amdgcn_mfma_f32_32x32x16_bf16(kf, qf[d0], S[t5], 0, 0, 0); }
    }
    const int D0 = iq + 128 - 32 * kt0 - 4 * hi, lo = D0 - 128;
    const float sinkp = sink2 + slope2 * (float)(iq + 128 - 32 * kt0);
    float m0 = -1e30f;
#pragma unroll
    for (int t5 = 0; t5 < 5; ++t5)
#pragma unroll
        for (int r = 0; r < 16; ++r) { const int off = 32 * t5 + (r & 3) + 8 * (r >> 2);
            float s = fmaf(slope2, (float)off, S[t5][r]);
            if (t5 == 0) s = (off >= lo) ? s : -1e30f;
            if (t5 == 4) s = (off <= D0) ? s : -1e30f;
            S[t5][r] = s; m0 = fmaxf(m0, s); }
    const float mloc = m0 + sbase;
    const float mx = fmaxf(sinkp, fmaxf(mloc, __shfl_xor(mloc, 32))), mxl = mx - sbase;
    float sum = 0.f;
#pragma unroll
    for (int t5 = 0; t5 < 5; ++t5)
#pragma unroll
        for (int r = 0; r < 16; ++r) { const float p = __builtin_amdgcn_exp2f(S[t5][r] - mxl); sum += p; S[t5][r] = p; }
    sum += __shfl_xor(sum, 32);
    inv_denom = 1.0f / (sum + __builtin_amdgcn_exp2f(sinkp - mx));
    o[0] = f32x16{}; o[1] = f32x16{};
#pragma unroll
    for (int t5 = 0; t5 < 5; ++t5)
#pragma unroll
        for (int s2 = 0; s2 < 2; ++s2) {
            v4u pw; pw.x = pk2(S[t5][8 * s2 + 0], S[t5][8 * s2 + 1]); pw.y = pk2(S[t5][8 * s2 + 2], S[t5][8 * s2 + 3]); pw.z = pk2(S[t5][8 * s2 + 4], S[t5][8 * s2 + 5]); pw.w = pk2(S[t5][8 * s2 + 6], S[t5][8 * s2 + 7]);
            const bf16x8 pf = __builtin_bit_cast(bf16x8, pw);
#pragma unroll
            for (int dt = 0; dt < 2; ++dt) { const LAS bf16* vr = Vt + (32 * dt + r32) * VTS + 32 * (kt0 + t5) + 16 * s2 + 4 * hi;
                const v2u lo2 = *(const LAS v2u*)vr, hh = *(const LAS v2u*)(vr + 8); v4u vw; vw.x = lo2.x; vw.y = lo2.y; vw.z = hh.x; vw.w = hh.y;
                o[dt] = __builtin_amdgcn_mfma_f32_32x32x16_bf16(__builtin_bit_cast(bf16x8, vw), pf, o[dt], 0, 0, 0); }
        }
}
__device__ __forceinline__ void stage_kv_from_z(const bf16* zrow, int kvh, int half, bool valid, LAS bf16* Kl, LAS bf16* Vt, int row, const float* gk, float* outk, float* outv) {
    v4u kw[4], vw[4];
#pragma unroll
    for (int i = 0; i < 4; ++i) { kw[i] = v4u{0u, 0u, 0u, 0u}; vw[i] = v4u{0u, 0u, 0u, 0u}; }
    if (valid) {
#pragma unroll
        for (int i = 0; i < 4; ++i) { kw[i] = *(const v4u*)(zrow + 1024 + kvh * 64 + 32 * half + 8 * i); vw[i] = *(const v4u*)(zrow + 1280 + kvh * 64 + 32 * half + 8 * i); }
    }
    float kf[32]; float ss = 0.f;
#pragma unroll
    for (int i = 0; i < 4; ++i) { kf[8 * i + 0] = bflo(kw[i].x); kf[8 * i + 1] = bfhi(kw[i].x); kf[8 * i + 2] = bflo(kw[i].y); kf[8 * i + 3] = bfhi(kw[i].y);
        kf[8 * i + 4] = bflo(kw[i].z); kf[8 * i + 5] = bfhi(kw[i].z); kf[8 * i + 6] = bflo(kw[i].w); kf[8 * i + 7] = bfhi(kw[i].w); }
#pragma unroll
    for (int i = 0; i < 32; ++i) ss += kf[i] * kf[i];
    ss += __shfl_xor(ss, 1);
    const float rk = rsqrtf(ss * (1.f / 64.f) + EPSN);
#pragma unroll
    for (int i = 0; i < 32; ++i) kf[i] = kf[i] * rk * gk[32 * half + i];
#pragma unroll
    for (int i = 0; i < 4; ++i) { v4u w; w.x = pk2(kf[8 * i], kf[8 * i + 1]); w.y = pk2(kf[8 * i + 2], kf[8 * i + 3]); w.z = pk2(kf[8 * i + 4], kf[8 * i + 5]); w.w = pk2(kf[8 * i + 6], kf[8 * i + 7]);
        *(LAS v4u*)(Kl + row * KLS + 32 * half + 8 * i) = w; }
#pragma unroll
    for (int i = 0; i < 4; ++i) { const unsigned ww[4] = {vw[i].x, vw[i].y, vw[i].z, vw[i].w};
#pragma unroll
        for (int q = 0; q < 4; ++q) { Vt[(32 * half + 8 * i + 2 * q) * VTS + row] = (bf16)(ww[q] & 0xffffu); Vt[(32 * half + 8 * i + 2 * q + 1) * VTS + row] = (bf16)(ww[q] >> 16); } }
    if (outk) {
#pragma unroll
        for (int i = 0; i < 8; ++i) ((f32x4*)(outk + 32 * half))[i] = f32x4{kf[4 * i], kf[4 * i + 1], kf[4 * i + 2], kf[4 * i + 3]};
#pragma unroll
        for (int i = 0; i < 4; ++i) { ((f32x4*)(outv + 32 * half))[2 * i] = f32x4{bflo(vw[i].x), bfhi(vw[i].x), bflo(vw[i].y), bfhi(vw[i].y)};
            ((f32x4*)(outv + 32 * half))[2 * i + 1] = f32x4{bflo(vw[i].z), bfhi(vw[i].z), bflo(vw[i].w), bfhi(vw[i].w)}; }
    }
}
__device__ __forceinline__ void load_q_raw(const bf16* zrow, int h, int hi, v4u (&qw)[4]) {
#pragma unroll
    for (int d0 = 0; d0 < 4; ++d0) qw[d0] = *(const v4u*)(zrow + h * 64 + 16 * d0 + 8 * hi);
}
__device__ __forceinline__ void finish_qfrags(const v4u (&qw)[4], const float* gq, bf16x8 (&qf)[4], int hi) {
    float ss = 0.f;
#pragma unroll
    for (int d0 = 0; d0 < 4; ++d0) {
        const float a0 = bflo(qw[d0].x), a1 = bfhi(qw[d0].x), a2 = bflo(qw[d0].y), a3 = bfhi(qw[d0].y), a4 = bflo(qw[d0].z), a5 = bfhi(qw[d0].z), a6 = bflo(qw[d0].w), a7 = bfhi(qw[d0].w);
        ss += (a0 * a0 + a1 * a1) + (a2 * a2 + a3 * a3) + (a4 * a4 + a5 * a5) + (a6 * a6 + a7 * a7); }
    ss += __shfl_xor(ss, 32);
    const float rq = rsqrtf(ss * (1.f / 64.f) + EPSN) * (0.125f * LOG2E);
#pragma unroll
    for (int d0 = 0; d0 < 4; ++d0) { const float* g = gq + 16 * d0 + 8 * hi; v4u w;
        w.x = pk2(bflo(qw[d0].x) * rq * g[0], bfhi(qw[d0].x) * rq * g[1]); w.y = pk2(bflo(qw[d0].y) * rq * g[2], bfhi(qw[d0].y) * rq * g[3]);
        w.z = pk2(bflo(qw[d0].z) * rq * g[4], bfhi(qw[d0].z) * rq * g[5]); w.w = pk2(bflo(qw[d0].w) * rq * g[6], bfhi(qw[d0].w) * rq * g[7]);
        qf[d0] = __builtin_bit_cast(bf16x8, w); }
}
__device__ __forceinline__ void load_qfrags(const bf16* zrow, int h, const float* gq, bf16x8 (&qf)[4], int hi) { v4u qw[4]; load_q_raw(zrow, h, hi, qw); finish_qfrags(qw, gq, qf, hi); }
__device__ __forceinline__ void store_attn_out(bf16* orow  , const f32x16 (&o)[2], float inv, int hi) {
#pragma unroll
    for (int dt = 0; dt < 2; ++dt)
#pragma unroll
        for (int r4 = 0; r4 < 4; ++r4) { v2u w; w.x = pk2(o[dt][4 * r4] * inv, o[dt][4 * r4 + 1] * inv); w.y = pk2(o[dt][4 * r4 + 2] * inv, o[dt][4 * r4 + 3] * inv);
            *(v2u*)(orow + 32 * dt + 8 * r4 + 4 * hi) = w; }
}

__device__ __forceinline__ void attn_prompt_unit(const Args& A, LAS unsigned char* lds, int b, int kvh, int qb, int tid, int wave, int lane) {
    LAS bf16* Kl = (LAS bf16*)(lds + LDS_K); LAS bf16* Vt = (LAS bf16*)(lds + LDS_VT);
    const bf16* Z = (const bf16*)(A.ws + WS_Z); bf16* ATT = (bf16*)(A.ws + WS_ATT);
    const int r32 = lane & 31, hi = lane >> 5;
    const int h = kvh * 4 + (wave >> 1);
    const int tok0 = b * 2048 + qb * 128 + 64 * (wave & 1) + r32;
    v4u qw0[4], qw1[4];
    load_q_raw(Z + (size_t)tok0 * PW, h, hi, qw0); load_q_raw(Z + (size_t)(tok0 + 32) * PW, h, hi, qw1);
    {
        const int row = tid >> 1, half = tid & 1, tok = (qb - 1) * 128 + row; const bool valid = tok >= 0;
        const bf16* zrow = Z + (size_t)(b * 2048 + (valid ? tok : 0)) * PW;
        float* outk = nullptr; float* outv = nullptr;
        if (qb == 15 && row >= 128) { const size_t o = ((size_t)(b * 128 + row - 128) * 4 + kvh) * 64; outk = A.out + O_KP + o; outv = A.out + O_VP + o; }
        stage_kv_from_z(zrow, kvh, half, valid, Kl, Vt, row, A.in[I_KG], outk, outv);
    }
    __syncthreads();
    const float slope2 = exp2f(-0.5f * (float)(h + 1)) * LOG2E, sink2 = A.in[I_SINK][h] * LOG2E;
#pragma unroll 1
    for (int jj = 0; jj < 2; ++jj) {
        const int jq = 2 * (wave & 1) + jj, tok = tok0 + 32 * jj;
        v4u qs[4];
#pragma unroll
        for (int d0 = 0; d0 < 4; ++d0) qs[d0] = jj ? qw1[d0] : qw0[d0];
        bf16x8 qf[4]; finish_qfrags(qs, A.in[I_QG], qf, hi);
        f32x16 o[2]; float inv;
        if (qb == 0) attn_qtile(Kl, Vt, jq, qf, 32 * jq + r32, slope2, sink2, 128, o, inv, r32, hi);
        else attn_qtile_fast(Kl, Vt, jq, qf, 32 * jq + r32, slope2, sink2, o, inv, r32, hi);
        store_attn_out(ATT + (size_t)tok * AW + h * 64, o, inv, hi);
    }
    __syncthreads();
}
__device__ __forceinline__ void attn_sample_unit(const Args& A, LAS unsigned char* lds, int n, int kvh, int tid, int wave, int lane) {
    LAS bf16* Kl = (LAS bf16*)(lds + LDS_K); LAS bf16* Vt = (LAS bf16*)(lds + LDS_VT);
    const bf16* Z = (const bf16*)(A.ws + WS_Z); bf16* ATT = (bf16*)(A.ws + WS_ATT);
    const int r32 = lane & 31, hi = lane >> 5;
    {
        const int row = tid >> 2, qt = tid & 3; const size_t src = ((size_t)(n * 128 + row) * 4 + kvh) * 64 + 16 * qt;
        f32x4 kv[4], vv[4];
#pragma unroll
        for (int i = 0; i < 4; ++i) { kv[i] = ((const f32x4*)(A.in[I_CK] + src))[i]; vv[i] = ((const f32x4*)(A.in[I_CV] + src))[i]; }
#pragma unroll
        for (int i = 0; i < 2; ++i) { v4u w; w.x = pk2(kv[2 * i].x, kv[2 * i].y); w.y = pk2(kv[2 * i].z, kv[2 * i].w); w.z = pk2(kv[2 * i + 1].x, kv[2 * i + 1].y); w.w = pk2(kv[2 * i + 1].z, kv[2 * i + 1].w);
            *(LAS v4u*)(Kl + row * KLS + 16 * qt + 8 * i) = w; }
#pragma unroll
        for (int i = 0; i < 4; ++i) { Vt[(16 * qt + 4 * i + 0) * VTS + row] = (bf16)f2bf(vv[i].x); Vt[(16 * qt + 4 * i + 1) * VTS + row] = (bf16)f2bf(vv[i].y);
            Vt[(16 * qt + 4 * i + 2) * VTS + row] = (bf16)f2bf(vv[i].z); Vt[(16 * qt + 4 * i + 3) * VTS + row] = (bf16)f2bf(vv[i].w); }
        if (row >= 4) { const size_t dst = ((size_t)(n * 128 + row - 4) * 4 + kvh) * 64 + 16 * qt;
#pragma unroll
            for (int i = 0; i < 4; ++i) { ((f32x4*)(A.out + O_KS + dst))[i] = kv[i]; ((f32x4*)(A.out + O_VS + dst))[i] = vv[i]; } }
        for (int idx = tid; idx < 28 * 64; idx += NTHR) { const int r = 132 + (idx >> 6), c = idx & 63; Kl[r * KLS + c] = 0; Vt[c * VTS + r] = 0; }
        if (tid < 8) {
            const int t = tid >> 1, half = tid & 1; const size_t o = ((size_t)(n * 128 + 124 + t) * 4 + kvh) * 64;
            stage_kv_from_z(Z + (size_t)(MP + 4 * n + t) * PW, kvh, half, true, Kl, Vt, 128 + t, A.in[I_KG], A.out + O_KS + o, A.out + O_VS + o);
        }
    }
    __syncthreads();
    if (wave == 0) {
        const int t = r32 & 3, rr = (r32 >> 2) & 3, h = kvh * 4 + rr, tok = MP + 4 * n + t;
        const float slope2 = exp2f(-0.5f * (float)(h + 1)) * LOG2E, sink2 = A.in[I_SINK][h] * LOG2E;
        bf16x8 qf[4]; load_qfrags(Z + (size_t)tok * PW, h, A.in[I_QG], qf, hi);
        f32x16 o[2]; float inv;
        attn_qtile_fast(Kl, Vt, 0, qf, t, slope2, sink2, o, inv, r32, hi);
        if (r32 < 16) store_attn_out(ATT + (size_t)tok * AW + h * 64, o, inv, hi);
    }
    __syncthreads();
}

constexpr int US = 264, ES = 132;
constexpr int LDS_U = 0, LDS_E = 128 * US * 2, LDS_TF = LDS_E + 128 * ES * 4, LDS_SSM_END = LDS_TF + 17 * 1024;
__device__ __forceinline__ void ssm_prompt_unit(const Args& A, LAS unsigned char* lds, int b, int g, int tid, int wave, int lane) {
    LAS bf16* U = (LAS bf16*)(lds + LDS_U); LAS float* E = (LAS float*)(lds + LDS_E); LAS unsigned char* TFl = lds + LDS_TF;
    const int r32 = lane & 31, hi = lane >> 5, w4 = wave & 3, ctp = wave >> 2;
    const bf16* Zu = (const bf16*)(A.ws + WS_Z) + (size_t)(b * 2048) * PW + 1536 + 16 * g;
    {
        v4u uv[8], tv[3];
#pragma unroll
        for (int i = 0; i < 8; ++i) { const int q = tid + 512 * i, t = q >> 1, h = q & 1; uv[i] = *(const v4u*)(Zu + (size_t)t * PW + 8 * h); }
        const v4u* tfg = (const v4u*)(A.ws + WS_TF) + (size_t)g * 17 * 64;
#pragma unroll
        for (int i = 0; i < 3; ++i) { const int q = tid + 512 * i; tv[i] = q < 17 * 64 ? tfg[q] : v4u{0u, 0u, 0u, 0u}; }
#pragma unroll
        for (int i = 0; i < 8; ++i) { const int q = tid + 512 * i, t = q >> 1, h = q & 1; *(LAS v4u*)(U + (t >> 4) * US + (t & 15) * 16 + 8 * h) = uv[i]; }
#pragma unroll
        for (int i = 0; i < 3; ++i) { const int q = tid + 512 * i; if (q < 17 * 64) *(LAS v4u*)(TFl + q * 16) = tv[i]; }
    }
    bf16x8 wf[16];
    {   const bf16x8* wsf = (const bf16x8*)(A.ws + WS_WSF) + (size_t)((g * 4 + w4) * 16) * 64 + lane;
#pragma unroll
        for (int s = 0; s < 16; ++s) wf[s] = wsf[s * 64]; }
    __syncthreads();
    const LAS bf16* u0p = U + (32 * (2 * ctp) + r32) * US + 8 * hi; const LAS bf16* u1p = U + (32 * (2 * ctp + 1) + r32) * US + 8 * hi;
    {
        f32x16 e0 = f32x16{}, e1 = f32x16{};
#pragma unroll
        for (int s = 0; s < 16; ++s) { const bf16x8 u0 = *(const LAS bf16x8*)(u0p + s * 16), u1 = *(const LAS bf16x8*)(u1p + s * 16);
            e0 = __builtin_amdgcn_mfma_f32_32x32x16_bf16(wf[s], u0, e0, 0, 0, 0); e1 = __builtin_amdgcn_mfma_f32_32x32x16_bf16(wf[s], u1, e1, 0, 0, 0); }
#pragma unroll
        for (int r = 0; r < 16; ++r) { const int m = 32 * w4 + crow(r, hi); E[(32 * (2 * ctp) + r32) * ES + m] = e0[r]; E[(32 * (2 * ctp + 1) + r32) * ES + m] = e1[r]; }
    }
    const int ttA = w4, ttB = 7 - w4;
    asm volatile("" ::: "memory");
    bf16x8 whA[8], whB[8];
    {   const bf16x8* pa = (const bf16x8*)(A.ws + WS_WHF) + (size_t)((g * 8 + ttA) * 8) * 64 + lane; const bf16x8* pb = (const bf16x8*)(A.ws + WS_WHF) + (size_t)((g * 8 + ttB) * 8) * 64 + lane;
#pragma unroll
        for (int kb = 0; kb < 8; ++kb) { whA[kb] = pa[kb * 64]; whB[kb] = pb[kb * 64]; } }
    __syncthreads();
    if (wave == 0) {
        const float2 l16 = ((const float2*)(A.ws + WS_LAM16))[g * 64 + lane];
        float hr = 0.f, hm = 0.f;
#pragma unroll 8
        for (int c = 0; c < 128; ++c) { const float er = E[c * ES + lane], ei = E[c * ES + 64 + lane];
            E[c * ES + lane] = __uint_as_float(pk2(hr, hm));
            const float nr = l16.x * hr - l16.y * hm + er, ni = l16.x * hm + l16.y * hr + ei; hr = nr; hm = ni; }
        A.out[O_RP + (size_t)(b * 64 + g) * 64 + lane] = hr; A.out[O_IP + (size_t)(b * 64 + g) * 64 + lane] = hm;
    }
    __syncthreads();
    {
        f32x16 aA0 = f32x16{}, aA1 = f32x16{}, aB0 = f32x16{}, aB1 = f32x16{};
        const LAS unsigned char* tfl = TFl + lane * 16;
#pragma unroll 4
        for (int s = 0; s < 16; ++s) {
            if (s <= 2 * ttB + 1) {
                const bf16x8 u0 = *(const LAS bf16x8*)(u0p + s * 16), u1 = *(const LAS bf16x8*)(u1p + s * 16);
                const bf16x8 tB = *(const LAS bf16x8*)(tfl + (2 * ttB - s + 1) * 1024);
                aB0 = __builtin_amdgcn_mfma_f32_32x32x16_bf16(tB, u0, aB0, 0, 0, 0); aB1 = __builtin_amdgcn_mfma_f32_32x32x16_bf16(tB, u1, aB1, 0, 0, 0);
                if (s <= 2 * ttA + 1) { const bf16x8 tA = *(const LAS bf16x8*)(tfl + (2 * ttA - s + 1) * 1024);
                    aA0 = __builtin_amdgcn_mfma_f32_32x32x16_bf16(tA, u0, aA0, 0, 0, 0); aA1 = __builtin_amdgcn_mfma_f32_32x32x16_bf16(tA, u1, aA1, 0, 0, 0); }
            }
        }
        const LAS bf16* h0p = (const LAS bf16*)(E + (32 * (2 * ctp) + r32) * ES) + 8 * hi; const LAS bf16* h1p = (const LAS bf16*)(E + (32 * (2 * ctp + 1) + r32) * ES) + 8 * hi;
#pragma unroll
        for (int kb = 0; kb < 8; ++kb) {
            const bf16x8 h0 = *(const LAS bf16x8*)(h0p + 16 * kb), h1 = *(const LAS bf16x8*)(h1p + 16 * kb);
            aA0 = __builtin_amdgcn_mfma_f32_32x32x16_bf16(whA[kb], h0, aA0, 0, 0, 0); aA1 = __builtin_amdgcn_mfma_f32_32x32x16_bf16(whA[kb], h1, aA1, 0, 0, 0);
            aB0 = __builtin_amdgcn_mfma_f32_32x32x16_bf16(whB[kb], h0, aB0, 0, 0, 0); aB1 = __builtin_amdgcn_mfma_f32_32x32x16_bf16(whB[kb], h1, aB1, 0, 0, 0);
        }
        bf16* Gm = (bf16*)(A.ws + WS_G);
        const float* Dk = A.in[I_D] + 16 * g;
#define SSM_EPI(acc, tt, ct) do { _Pragma("unroll") for (int r4 = 0; r4 < 4; ++r4) { const int ti = r4 >> 1, ch0 = 8 * (r4 & 1) + 4 * hi, cc = 32 * (ct) + r32, tok = 16 * cc + 2 * (tt) + ti; \
            const v2u uw = *(const LAS v2u*)(U + cc * US + (2 * (tt) + ti) * 16 + ch0); const f32x4 dv = *(const f32x4*)(Dk + ch0); \
            const float y0 = acc[4 * r4 + 0] + dv.x * bflo(uw.x), y1 = acc[4 * r4 + 1] + dv.y * bfhi(uw.x), y2 = acc[4 * r4 + 2] + dv.z * bflo(uw.y), y3 = acc[4 * r4 + 3] + dv.w * bfhi(uw.y); \
            v2u w; w.x = pk2(gelu_tanh(y0), gelu_tanh(y1)); w.y = pk2(gelu_tanh(y2), gelu_tanh(y3)); \
            *(v2u*)(Gm + (size_t)(b * 2048 + tok) * SWD + 16 * g + ch0) = w; } } while (0)
        SSM_EPI(aA0, ttA, 2 * ctp); SSM_EPI(aA1, ttA, 2 * ctp + 1); SSM_EPI(aB0, ttB, 2 * ctp); SSM_EPI(aB1, ttB, 2 * ctp + 1);
#undef SSM_EPI
    }
    __syncthreads();
}
__device__ __forceinline__ void ssm_sample_wave(const Args& A, LAS unsigned char* lds, int gw  , int ngw, int wave, int lane) {
    LAS float* Cr = (LAS float*)(lds + wave * 8192); LAS float* Ci = Cr + 1024; LAS float* hs = (LAS float*)(lds + 65536 + wave * 2048);
    const bf16* Z = (const bf16*)(A.ws + WS_Z);
    const int tl = lane >> 4, cl = lane & 15;
    for (int g = gw & 63; g < 64; g += 64) {
        {   const f32x4* cre = (const f32x4*)(A.in[I_CRE] + (size_t)g * 1024); const f32x4* cim = (const f32x4*)(A.in[I_CIM] + (size_t)g * 1024);
#pragma unroll
            for (int i = 0; i < 4; ++i) { const int q4 = lane + 64 * i, chp = q4 >> 4, p0 = (q4 & 15) * 4; const f32x4 a = cre[q4], c = cim[q4];
                Cr[(p0 + 0) * 16 + chp] = a.x; Cr[(p0 + 1) * 16 + chp] = a.y; Cr[(p0 + 2) * 16 + chp] = a.z; Cr[(p0 + 3) * 16 + chp] = a.w;
                Ci[(p0 + 0) * 16 + chp] = c.x; Ci[(p0 + 1) * 16 + chp] = c.y; Ci[(p0 + 2) * 16 + chp] = c.z; Ci[(p0 + 3) * 16 + chp] = c.w; } }
        const float2 lam = ((const float2*)(A.ws + WS_LAM))[g * 64 + lane];
        float2 bb[16];
#pragma unroll
        for (int ch = 0; ch < 16; ++ch) bb[ch] = ((const float2*)(A.ws + WS_BBAR))[(g * 16 + ch) * 64 + lane];
        const float dsk = A.in[I_D][16 * g + cl];
        for (int n = gw >> 6; n < 128; n += ngw >> 6) {
            float hr = A.in[I_SR][(size_t)(n * 64 + g) * 64 + lane], hm = A.in[I_SI][(size_t)(n * 64 + g) * 64 + lane];
            const unsigned short ub = Z[(size_t)(MP + 4 * n + tl) * PW + 1536 + 16 * g + cl];
            const float uval = __uint_as_float((unsigned)ub << 16);
#pragma unroll
            for (int t = 0; t < 4; ++t) {
                float br = 0.f, bi = 0.f;
#pragma unroll
                for (int ch = 0; ch < 16; ++ch) { const float u = __shfl(uval, t * 16 + ch); br += bb[ch].x * u; bi += bb[ch].y * u; }
                const float nr = lam.x * hr - lam.y * hm + br, ni = lam.x * hm + lam.y * hr + bi; hr = nr; hm = ni;
                hs[(t * 2 + 0) * 64 + lane] = hr; hs[(t * 2 + 1) * 64 + lane] = hm;
            }
            A.out[O_RS + (size_t)(n * 64 + g) * 64 + lane] = hr; A.out[O_IS + (size_t)(n * 64 + g) * 64 + lane] = hm;
            float y = 0.f;
#pragma unroll 4
            for (int p = 0; p < 64; p += 4) { const f32x4 h4 = *(const LAS f32x4*)(hs + (tl * 2 + 0) * 64 + p), g4 = *(const LAS f32x4*)(hs + (tl * 2 + 1) * 64 + p);
                y += (Cr[(p + 0) * 16 + cl] * h4.x - Ci[(p + 0) * 16 + cl] * g4.x) + (Cr[(p + 1) * 16 + cl] * h4.y - Ci[(p + 1) * 16 + cl] * g4.y)
                   + (Cr[(p + 2) * 16 + cl] * h4.z - Ci[(p + 2) * 16 + cl] * g4.z) + (Cr[(p + 3) * 16 + cl] * h4.w - Ci[(p + 3) * 16 + cl] * g4.w); }
            y += dsk * uval;
            ((bf16*)(A.ws + WS_G))[(size_t)(MP + 4 * n + tl) * SWD + 16 * g + cl] = (bf16)f2bf(gelu_tanh(y));
        }
    }
}

__device__ __forceinline__ void convert_two(const float* W1, int K1, int N1, bf16* T1, const float* W2, int K2, int N2, bf16* T2, LAS unsigned char* lds, int w, int nw, int wave, int lane) {
    LAS float* scr = (LAS float*)(lds + wave * 8448);
    const int i1 = (K1 / 64) * (N1 / 32), i2 = (K2 / 64) * (N2 / 32);
    for (int it = w * NWAVES + wave; it < i1 + i2; it += nw * NWAVES) {
        if (it < i1) p0_transpose_item(W1, K1, N1, T1, scr, it, lane); else p0_transpose_item(W2, K2, N2, T2, scr, it - i1, lane);
    }
}
#define XB_TMO      128
#define XB_XCNT(j)  (256  + 64 * (j))
#define XB_XSUB(j)  (1280 + 64 * (j))
#define XB_XGEN(j)  (2304 + 64 * (j))
#define XB_TOP      3328
#define XB_TOPGEN   3392
#define XCD_BAR_WORDS 3456
#define XB_SPIN_CAP (1u << 18)

__device__ __forceinline__ unsigned xb_ld(unsigned* p)              { return __hip_atomic_load(p, __ATOMIC_RELAXED, __HIP_MEMORY_SCOPE_AGENT); }
__device__ __forceinline__ unsigned xb_add(unsigned* p, unsigned v) { return __hip_atomic_fetch_add(p, v, __ATOMIC_RELAXED, __HIP_MEMORY_SCOPE_AGENT); }
__device__ __forceinline__ unsigned xb_xcc_id() { return (unsigned)__builtin_amdgcn_s_getreg((3 << 11) | 20) & 0xFu; }
#define XB_SPIN(cond, bar) do { unsigned _sp = 0; while (cond) { __builtin_amdgcn_s_sleep(1); \
    if ((++_sp & 255u) == 0u) { if (xb_ld(&(bar)[XB_TMO])) break; if (_sp > XB_SPIN_CAP) { atomicAdd(&(bar)[XB_TMO], 1u); break; } } } } while (0)

struct XcdBarrier {
    unsigned* bar; unsigned x;
    volatile LAS unsigned* st;
};

__device__ __forceinline__ XcdBarrier xcd_barrier_post(unsigned* bar, volatile LAS unsigned* st) {
    XcdBarrier b; b.bar = bar; b.x = xb_xcc_id(); b.st = st;
    if (threadIdx.x == 0) (void)xb_add(&bar[XB_XCNT(b.x)], 1u);
    return b;
}
__device__ __forceinline__ void xcd_barrier_complete(unsigned* bar, unsigned x, unsigned& nloc, unsigned& nx) {
    const unsigned G = gridDim.x * gridDim.y * gridDim.z;
    unsigned sum, cnt, mine, sp = 0u;
    for (;;) {
        sum = 0u; cnt = 0u; mine = 0u;
#pragma unroll
        for (unsigned j = 0; j < 16; ++j) { const unsigned c = xb_ld(&bar[XB_XCNT(j)]); sum += c; cnt += (c > 0u) ? 1u : 0u; mine = (j == x) ? c : mine; }
        if (sum == G) break;
        __builtin_amdgcn_s_sleep(1);
        if ((++sp & 255u) == 0u) { if (xb_ld(&bar[XB_TMO])) break; if (sp > XB_SPIN_CAP) { atomicAdd(&bar[XB_TMO], 1u); break; } }
    }
    nloc = mine > 0u ? mine : 1u; nx = cnt > 0u ? cnt : 1u;
}

__device__ __forceinline__ void xcd_barrier(const XcdBarrier& b) {
    asm volatile("s_waitcnt vmcnt(0)" ::: "memory");
    __syncthreads();
    if (threadIdx.x == 0) {
        unsigned* bar = b.bar;
        __builtin_amdgcn_s_waitcnt(0);
        unsigned nloc = b.st[0], nx = b.st[1];
        if (nloc == 0u) { xcd_barrier_complete(bar, b.x, nloc, nx); b.st[0] = nloc; b.st[1] = nx; }
        const unsigned old = xb_add(&bar[XB_XSUB(b.x)], 1u);
        const unsigned gen = old / nloc;
        if (old + 1u == (gen + 1u) * nloc) {
            __builtin_amdgcn_fence(__ATOMIC_RELEASE, "agent");
            asm volatile("s_waitcnt vmcnt(0)" ::: "memory");
            const unsigned og = xb_add(&bar[XB_TOP], 1u);
            const unsigned tg = og / nx;
            if (og + 1u == (tg + 1u) * nx) xb_add(&bar[XB_TOPGEN], 1u);
            else XB_SPIN(xb_ld(&bar[XB_TOPGEN]) == tg, bar);
            __builtin_amdgcn_fence(__ATOMIC_ACQUIRE, "agent");
            xb_add(&bar[XB_XGEN(b.x)], 1u);
            asm volatile("s_waitcnt vmcnt(0)" ::: "memory");
        } else {
            XB_SPIN(xb_ld(&bar[XB_XGEN(b.x)]) == gen, bar);
            __builtin_amdgcn_fence(__ATOMIC_ACQUIRE, "agent");
            asm volatile("s_waitcnt vmcnt(0)" ::: "memory");
        }
    }
    __syncthreads();
}

template <int LO, int HI> __device__ __forceinline__ void fwd_body(const Args& A) {
    extern __shared__ __attribute__((aligned(16))) unsigned char lds_raw[];
    LAS unsigned char* lds = (LAS unsigned char*)lds_raw;
    const int tid = threadIdx.x, lane = tid & 63, wave = __builtin_amdgcn_readfirstlane(tid >> 6);
    const int G = gridDim.x, bx = blockIdx.x, vcu = (G % 8 == 0) ? (bx % 8) * (G / 8) + bx / 8 : bx;
    unsigned char* ws = A.ws;
#define IN(k) (LO <= (k) && (k) < HI)
    volatile LAS unsigned* bst = (volatile LAS unsigned*)(lds + LDS_PHASE);
    if (tid == 0) { bst[0] = 0u; bst[1] = 0u; }
    __syncthreads();
    XcdBarrier bar; bar.bar = (unsigned*)(ws + WS_BAR); bar.x = 0; bar.st = bst;
    if (HI - LO > 1) bar = xcd_barrier_post((unsigned*)(ws + WS_BAR), bst);
#define SEAM(k) do { if (IN(k) && IN((k) + 1)) { if ((k) == 0) cg::this_grid().sync(); else xcd_barrier(bar); } } while (0)
    using namespace pg8;
#ifdef PROBE_P0
    if (IN(0)) { const int nrep = A.ph_hi > 100 ? 1 : 2; for (int rep = 0; rep < nrep; ++rep) { p0_prologue(A, lds, vcu, G, tid, wave, lane); __syncthreads(); if (rep + 1 < nrep) xcd_barrier(bar); } }
#else
    if (IN(0)) { p0_prologue(A, lds, vcu, G, tid, wave, lane); __syncthreads(); }
#endif
    SEAM(0);
    if (IN(1)) { Gemm g{(const bf16_t*)(ws + WS_XN), (const bf16_t*)(ws + WS_WIN), MT, PW, DM}; StaticOrder S; S.init(MT, PW, G, bx, DM);
        EpiStoreBf16<0> E{(bf16_t*)(ws + WS_Z), PW};
        gemm_phase<EpiStoreBf16<0>, StaticOrder, true, true>(lds, g, S, E);
        { const int nfull = (MT / 256) * (PW / 256) - 2 * G;
          if (G == 256 && bx >= nfull) convert_two(A.in[I_WGLU], SWD, SWD, (bf16*)(ws + WS_WGLU), A.in[I_WOUT], DM, DM, (bf16*)(ws + WS_WOUT), lds, bx - nfull, G - nfull, wave, lane);
          else if (G != 256) convert_two(A.in[I_WGLU], SWD, SWD, (bf16*)(ws + WS_WGLU), A.in[I_WOUT], DM, DM, (bf16*)(ws + WS_WOUT), lds, bx, G, wave, lane); } }
    SEAM(1);
    if (IN(2)) {
#ifdef PROBE_P2
      const int nrep2 = A.ph_hi > 100 ? 1 : 2;
      for (int rep = 0; rep < nrep2; ++rep) {
        if (rep) xcd_barrier(bar);
#else
      {
#endif
#ifndef SKIP_AP
        for (int u = vcu; u < 512; u += G) { int t_ = threadIdx.x; asm volatile("" : "+v"(t_)); const int l_ = t_ & 63, w_ = __builtin_amdgcn_readfirstlane(t_ >> 6); attn_prompt_unit(A, lds, u >> 6, (u >> 4) & 3, u & 15, t_, w_, l_); }
#endif
#ifndef SKIP_SP
        for (int u = vcu; u < 512; u += G) { int t_ = threadIdx.x; asm volatile("" : "+v"(t_)); const int l_ = t_ & 63, w_ = __builtin_amdgcn_readfirstlane(t_ >> 6); ssm_prompt_unit(A, lds, u >> 6, u & 63, t_, w_, l_); }
#endif
#ifndef SKIP_AS
        for (int u = vcu; u < 512; u += G) { int t_ = threadIdx.x; asm volatile("" : "+v"(t_)); const int l_ = t_ & 63, w_ = __builtin_amdgcn_readfirstlane(t_ >> 6); attn_sample_unit(A, lds, u >> 2, u & 3, t_, w_, l_); }
#endif
#ifndef SKIP_SS
        { int t_ = threadIdx.x; asm volatile("" : "+v"(t_)); const int l_ = t_ & 63, w_ = __builtin_amdgcn_readfirstlane(t_ >> 6);
          if ((G * NWAVES) % 64 == 0) ssm_sample_wave(A, lds, vcu * NWAVES + w_, G * NWAVES, w_, l_); }
#endif
        __syncthreads();
      }
    }
    SEAM(2);
    if (IN(3)) { Gemm g{(const bf16_t*)(ws + WS_G), (const bf16_t*)(ws + WS_WGLU), MT, SWD, SWD}; StaticOrder S; S.init(MT, SWD, G, bx, SWD);
        EpiGlu E{(const bf16_t*)(ws + WS_G), (bf16_t*)(ws + WS_SO), A.in[I_BGLU]};
        gemm_phase<EpiGlu, StaticOrder, true, true>(lds, g, S, E); }
    SEAM(3);
    if (IN(4)) {
        const bf16* ATT = (const bf16*)(ws + WS_ATT); const bf16* SO = (const bf16*)(ws + WS_SO); bf16* MIX = (bf16*)(ws + WS_MIX);
        for (int m = vcu * NWAVES + wave; m < MT; m += G * NWAVES) {
#pragma unroll
            for (int part = 0; part < 2; ++part) {
                const bf16* src = (part ? SO : ATT) + (size_t)m * 1024; const float* gn = A.in[part ? I_SOG : I_AOG];
                v4u w[2]; float f[16]; float ss = 0.f;
#pragma unroll
                for (int j = 0; j < 2; ++j) { w[j] = *(const v4u*)(src + 512 * j + 8 * lane);
                    f[8 * j + 0] = bflo(w[j].x); f[8 * j + 1] = bfhi(w[j].x); f[8 * j + 2] = bflo(w[j].y); f[8 * j + 3] = bfhi(w[j].y);
                    f[8 * j + 4] = bflo(w[j].z); f[8 * j + 5] = bfhi(w[j].z); f[8 * j + 6] = bflo(w[j].w); f[8 * j + 7] = bfhi(w[j].w); }
#pragma unroll
                for (int i = 0; i < 16; ++i) ss += f[i] * f[i];
                const float r = rsqrtf(wave_sum(ss) * (1.f / 1024.f) + EPSN);
#pragma unroll
                for (int j = 0; j < 2; ++j) { const f32x4 g0 = *(const f32x4*)(gn + 512 * j + 8 * lane), g1 = *(const f32x4*)(gn + 512 * j + 8 * lane + 4);
                    v4u o; o.x = pk2(f[8 * j + 0] * r * g0.x, f[8 * j + 1] * r * g0.y); o.y = pk2(f[8 * j + 2] * r * g0.z, f[8 * j + 3] * r * g0.w);
                    o.z = pk2(f[8 * j + 4] * r * g1.x, f[8 * j + 5] * r * g1.y); o.w = pk2(f[8 * j + 6] * r * g1.z, f[8 * j + 7] * r * g1.w);
                    *(v4u*)(MIX + (size_t)m * 2048 + 1024 * part + 512 * j + 8 * lane) = o; }
            }
        }
    }
    SEAM(4);
    if (IN(5)) { Gemm g{(const bf16_t*)(ws + WS_MIX), (const bf16_t*)(ws + WS_WOUT), MT, DM, DM}; StaticOrder S; S.init(MT, DM, G, bx, DM);
        EpiHres E{A.in[I_XP], A.in[I_XS], A.out + O_Y, (bf16_t*)(ws + WS_HG), A.in[I_MNG], (float*)(ws + WS_CTL)};
        gemm_phase<EpiHres, StaticOrder, true, true>(lds, g, S, E);
        { const int nfull = (MT / 256) * (DM / 256) - 2 * G;
          if (G == 256 && bx >= nfull) convert_two(A.in[I_WUP], DM, FF, (bf16*)(ws + WS_WUP), A.in[I_WDN], FF, DM, (bf16*)(ws + WS_WDN), lds, bx - nfull, G - nfull, wave, lane);
          else if (G != 256) convert_two(A.in[I_WUP], DM, FF, (bf16*)(ws + WS_WUP), A.in[I_WDN], FF, DM, (bf16*)(ws + WS_WDN), lds, bx, G, wave, lane); } }
    SEAM(5);
    if (IN(6)) { Gemm g{(const bf16_t*)(ws + WS_HG), (const bf16_t*)(ws + WS_WUP), MT, FF, DM}; StaticOrder S; S.init(MT, FF, G, bx, DM);
        EpiStoreBf16<2> E{(bf16_t*)(ws + WS_ACT), FF};
        gemm_phase<EpiStoreBf16<2>, StaticOrder, true, true>(lds, g, S, E); }
    SEAM(6);
    if (IN(7)) { Gemm g{(const bf16_t*)(ws + WS_ACT), (const bf16_t*)(ws + WS_WDN), MT, DM, FF};
        { StaticOrder S; S.init(MP, DM, G, bx, FF); EpiDown E{A.out + O_Y, (const float*)(ws + WS_CTL)};
          gemm_phase<EpiDown, StaticOrder, true, true>(lds, g, S, E); }
        { SampleSplitOrder<8, 16, 128> S; S.init(G, bx); EpiPartial E{(float*)(ws + WS_PART), 512};
          gemm_phase<EpiPartial, SampleSplitOrder<8, 16, 128>, true, true>(lds, g, S, E); } }
    SEAM(7);
    if (IN(8)) {
        const float* P = (const float*)(ws + WS_PART); const float* rowss = (const float*)(ws + WS_CTL); float* Y = A.out + O_Y + (size_t)MP * DM;
        for (int idx = vcu * NTHR + tid; idx < 512 * 512; idx += G * NTHR) {
            const int row = idx >> 9, c4 = idx & 511;
            f32x4 s = f32x4{0.f, 0.f, 0.f, 0.f};
#pragma unroll
            for (int k = 0; k < 16; ++k) s += ((const f32x4*)(P + (size_t)k * (512 * 2048)))[idx];
            const float ssr = __hip_atomic_load(rowss + MP + row, __ATOMIC_RELAXED, __HIP_MEMORY_SCOPE_AGENT);
            const float r2 = 1.0f / (ssr * (1.0f / 2048.0f) + 1e-6f);
            f32x4* y = (f32x4*)(Y + (size_t)row * DM) + c4; *y = *y + s * r2;
        }
    }
#undef IN
#undef SEAM
}
template <int LO, int HI> __global__ void __launch_bounds__(NTHR, 2) fwd_t(Args A) { fwd_body<LO, HI>(A); }

extern "C" void kernel_launch(void* const* d_in, const int* in_sizes, int n_in, void* d_out, int out_size, void* d_ws, size_t ws_size, hipStream_t stream) {
    static int grid = 0;
    if (grid == 0) {
        if (n_in != 27 || out_size != (int)O_END || ws_size < WS_END) { fprintf(stderr, "kernel_launch: unexpected shapes: n_in %d out %d ws %zu (need %zu)\n", n_in, out_size, ws_size, (size_t)WS_END); grid = -1; return; }
        int dev = 0, cus = 0, per_cu = 0;
        if (hipGetDevice(&dev) != hipSuccess || hipDeviceGetAttribute(&cus, hipDeviceAttributeMultiprocessorCount, dev) != hipSuccess) { grid = -1; return; }
#if MK_PER_PHASE
        const void* fns[NPHASE] = {(const void*)fwd_t<0, 1>, (const void*)fwd_t<1, 2>, (const void*)fwd_t<2, 3>, (const void*)fwd_t<3, 4>, (const void*)fwd_t<4, 5>, (const void*)fwd_t<5, 6>, (const void*)fwd_t<6, 7>, (const void*)fwd_t<7, 8>, (const void*)fwd_t<8, 9>};
        for (int i = 0; i < NPHASE; ++i) if (hipFuncSetAttribute(fns[i], hipFuncAttributeMaxDynamicSharedMemorySize, LDS_BYTES) != hipSuccess) { fprintf(stderr, "kernel_launch: hipFuncSetAttribute failed\n"); grid = -1; return; }
#else
        if (hipFuncSetAttribute((const void*)fwd_t<0, NPHASE>, hipFuncAttributeMaxDynamicSharedMemorySize, LDS_BYTES) != hipSuccess) { fprintf(stderr, "kernel_launch: hipFuncSetAttribute failed\n"); grid = -1; return; }
        if (hipOccupancyMaxActiveBlocksPerMultiprocessor(&per_cu, (const void*)fwd_t<0, NPHASE>, NTHR, LDS_BYTES) != hipSuccess || per_cu < 1) { fprintf(stderr, "kernel_launch: occupancy query says %d\n", per_cu); per_cu = 1; }
#endif
        (void)hipGetLastError();
        grid = cus;
    }
    if (grid < 0) return;
    (void)hipMemsetAsync((char*)d_ws + WS_CTL, 0, CTL_ZERO_BYTES, stream);
    Args a{};
    for (int i = 0; i < 27; ++i) a.in[i] = (const float*)d_in[i];
    a.out = (float*)d_out; a.ws = (unsigned char*)d_ws;
#if MK_PER_PHASE
    hipLaunchKernelGGL((fwd_t<0, 1>), dim3(grid), dim3(NTHR), LDS_BYTES, stream, a);
#if defined(DUP_PHASE)
    if (DUP_PHASE == 0) hipLaunchKernelGGL((fwd_t<0, 1>), dim3(grid), dim3(NTHR), LDS_BYTES, stream, a);
#endif
    hipLaunchKernelGGL((fwd_t<1, 2>), dim3(grid), dim3(NTHR), LDS_BYTES, stream, a);
#if defined(DUP_PHASE)
    if (DUP_PHASE == 1) hipLaunchKernelGGL((fwd_t<1, 2>), dim3(grid), dim3(NTHR), LDS_BYTES, stream, a);
#endif
    hipLaunchKernelGGL((fwd_t<2, 3>), dim3(grid), dim3(NTHR), LDS_BYTES, stream, a);
#if defined(DUP_PHASE)
    if (DUP_PHASE == 2) hipLaunchKernelGGL((fwd_t<2, 3>), dim3(grid), dim3(NTHR), LDS_BYTES, stream, a);
#endif
    hipLaunchKernelGGL((fwd_t<3, 4>), dim3(grid), dim3(NTHR), LDS_BYTES, stream, a);
#if defined(DUP_PHASE)
    if (DUP_PHASE == 3) hipLaunchKernelGGL((fwd_t<3, 4>), dim3(grid), dim3(NTHR), LDS_BYTES, stream, a);
#endif
    hipLaunchKernelGGL((fwd_t<4, 5>), dim3(grid), dim3(NTHR), LDS_BYTES, stream, a);
#if defined(DUP_PHASE)
    if (DUP_PHASE == 4) hipLaunchKernelGGL((fwd_t<4, 5>), dim3(grid), dim3(NTHR), LDS_BYTES, stream, a);
#endif
    hipLaunchKernelGGL((fwd_t<5, 6>), dim3(grid), dim3(NTHR), LDS_BYTES, stream, a);
#if defined(DUP_PHASE)
    if (DUP_PHASE == 5) hipLaunchKernelGGL((fwd_t<5, 6>), dim3(grid), dim3(NTHR), LDS_BYTES, stream, a);
#endif
    hipLaunchKernelGGL((fwd_t<6, 7>), dim3(grid), dim3(NTHR), LDS_BYTES, stream, a);
#if defined(DUP_PHASE)
    if (DUP_PHASE == 6) hipLaunchKernelGGL((fwd_t<6, 7>), dim3(grid), dim3(NTHR), LDS_BYTES, stream, a);
#endif
    hipLaunchKernelGGL((fwd_t<7, 8>), dim3(grid), dim3(NTHR), LDS_BYTES, stream, a);
#if defined(DUP_PHASE)
    if (DUP_PHASE == 7) hipLaunchKernelGGL((fwd_t<7, 8>), dim3(grid), dim3(NTHR), LDS_BYTES, stream, a);
#endif
    hipLaunchKernelGGL((fwd_t<8, 9>), dim3(grid), dim3(NTHR), LDS_BYTES, stream, a);
#if defined(DUP_PHASE)
    if (DUP_PHASE == 8) hipLaunchKernelGGL((fwd_t<8, 9>), dim3(grid), dim3(NTHR), LDS_BYTES, stream, a);
#endif
#else
    a.ph_lo = 0; a.ph_hi = NPHASE;
    void* kargs[] = {&a};
    hipError_t e = hipLaunchCooperativeKernel((const void*)fwd_t<0, NPHASE>, dim3(grid), dim3(NTHR), kargs, LDS_BYTES, stream);
    if (e != hipSuccess) fprintf(stderr, "cooperative launch failed: %s (grid %d)\n", hipGetErrorString(e), grid);
#endif
}
```

```cpp
#ifndef MK_PER_PHASE
#define MK_PER_PHASE 0
#endif
#include <hip/hip_runtime.h>
#include <hip/hip_cooperative_groups.h>
#include <cstdio>
#include <cstdint>
namespace cg = cooperative_groups;
namespace pg8 {
#define PG8_LAS __attribute__((address_space(3)))
typedef unsigned short bf16_t;
typedef short bf16x8 __attribute__((ext_vector_type(8)));
typedef float f32x4 __attribute__((ext_vector_type(4)));
typedef unsigned u32x4 __attribute__((ext_vector_type(4)));
constexpr int BM = 256, BK = 64, HALF = 128, HTB = HALF * BK * 2  , STAGE_BYTES = 8 * HTB, NXCD = 8, WGM = 8;

__host__ __device__ __forceinline__ int lds_byte(int r, int c) { const int st = (r >> 4) * 2 + (c >> 5), rr = r & 15, cc = c & 31, ob = rr * 64 + cc * 2; return st * 1024 + (ob ^ (((ob >> 9) & 1) << 5)); }
__host__ __device__ __forceinline__ void stage_rc(int b, int& R, int& C) { const int st = b / 1024, sb = b % 1024, swz = sb ^ (((sb >> 9) & 1) << 5); R = (st >> 1) * 16 + swz / 64; C = (st & 1) * 32 + (swz % 64) / 2; }
__host__ __device__ __forceinline__ int perm32(int rho) { const int n = rho >> 4, i = rho & 15; return 8 * (i >> 2) + 4 * n + (i & 3); }

struct Unit { int pm, pn, k0, nt, cont; };
struct Gemm { const bf16_t* A; const bf16_t* Bt; int M, N, K; };

struct StaticOrder {
    int nM, nN, nwg, G, c, ntk;
    __host__ __device__ void init(int M, int N, int G_, int c_, int K) { nM = M / BM; nN = N / BM; nwg = nM * nN; G = G_; c = c_; ntk = K / BK; }
    __host__ __device__ bool next(int i, Unit& u) const {
        const long L = (long)i * G + c; if (L >= nwg) return false;
        int wgid = (int)L; { const int q = nwg / NXCD, r = nwg % NXCD, xcd = wgid % NXCD, off = wgid / NXCD; wgid = (xcd < r ? xcd * (q + 1) : r * (q + 1) + (xcd - r) * q) + off; }
        const int nig = WGM * nN, gid = wgid / nig, fm = gid * WGM, gsz = (nM - fm) < WGM ? (nM - fm) : WGM;
        u.pm = fm + ((wgid % nig) % gsz); u.pn = (wgid % nig) / gsz; u.k0 = 0; u.nt = ntk; u.cont = 0; return true;
    }
    __device__ __forceinline__ void a_ready(const Unit&) const {}
    __device__ __forceinline__ void done(const Unit&) const {}
};

__device__ __forceinline__ unsigned cvt_pk_bf16(float lo, float hi) { unsigned r; asm volatile("v_cvt_pk_bf16_f32 %0, %1, %2" : "=v"(r) : "v"(lo), "v"(hi)); return r; }
typedef float f32x2 __attribute__((ext_vector_type(2)));
__device__ __forceinline__ float bf_lo(unsigned w) { return __uint_as_float(w << 16); }
__device__ __forceinline__ float bf_hi(unsigned w) { return __uint_as_float(w & 0xffff0000u); }
template <int ACT> struct EpiStoreBf16 {
    static constexpr bool PERM = true, AFTER_DRAIN = false, MIDK = false;
    bf16_t* O; int ldc;
    __device__ __forceinline__ void operator()(const f32x4 (&acc)[2][2][4][2], const Unit& u, int wr, int wc, int fr, int fq) const {
        const int row0 = u.pm * BM + wr * 64 + fr; const int col0 = u.pn * BM + wc * 32 + 8 * fq;
#pragma unroll
        for (int ai = 0; ai < 2; ++ai)
#pragma unroll
            for (int m = 0; m < 4; ++m) { bf16_t* rowp = O + (size_t)(row0 + ai * HALF + m * 16) * ldc + col0;
#pragma unroll
                for (int bj = 0; bj < 2; ++bj) { f32x4 v0 = acc[ai][bj][m][0], v1 = acc[ai][bj][m][1];
                    if (ACT == 2) {
#pragma unroll
                        for (int i = 0; i < 4; ++i) { const float a = fmaxf(v0[i], 0.f), b = fmaxf(v1[i], 0.f); v0[i] = a * a; v1[i] = b * b; } }
                    u32x4 w; w.x = cvt_pk_bf16(v0[0], v0[1]); w.y = cvt_pk_bf16(v0[2], v0[3]); w.z = cvt_pk_bf16(v1[0], v1[1]); w.w = cvt_pk_bf16(v1[2], v1[3]);
                    *(u32x4*)(rowp + bj * HALF) = w; } }
    }
};
struct EpiGlu {
    static constexpr bool PERM = true, AFTER_DRAIN = false, MIDK = false;
    const bf16_t* Gm; bf16_t* O; const float* bias; float* rowss;
    __device__ __forceinline__ void operator()(const f32x4 (&acc)[2][2][4][2], const Unit& u, int wr, int wc, int fr, int fq) const {
        const int row0 = u.pm * BM + wr * 64 + fr; const int col0 = u.pn * BM + wc * 32 + 8 * fq;
        float ssq[8];
#pragma unroll
        for (int i = 0; i < 8; ++i) ssq[i] = 0.f;
#pragma unroll
        for (int bj = 0; bj < 2; ++bj) { const f32x4 b0 = *(const f32x4*)(bias + col0 + bj * HALF), b1 = *(const f32x4*)(bias + col0 + bj * HALF + 4);
#pragma unroll
            for (int ai = 0; ai < 2; ++ai)
#pragma unroll
                for (int m = 0; m < 4; ++m) { const size_t row = (size_t)(row0 + ai * HALF + m * 16); const int col = col0 + bj * HALF;
                    const u32x4 gw = *(const u32x4*)(Gm + row * 1024 + col);
                    const f32x4 a0 = acc[ai][bj][m][0] + b0, a1 = acc[ai][bj][m][1] + b1;
                    float g[8] = {bf_lo(gw.x), bf_hi(gw.x), bf_lo(gw.y), bf_hi(gw.y), bf_lo(gw.z), bf_hi(gw.z), bf_lo(gw.w), bf_hi(gw.w)};
                    float o[8]; float sq = 0.f;
#pragma unroll
                    for (int i = 0; i < 4; ++i) { o[i] = g[i] / (1.f + __expf(-a0[i])); o[4 + i] = g[4 + i] / (1.f + __expf(-a1[i])); }
#pragma unroll
                    for (int i = 0; i < 8; ++i) sq += o[i] * o[i];
                    ssq[ai * 4 + m] += sq;
                    u32x4 w; w.x = cvt_pk_bf16(o[0], o[1]); w.y = cvt_pk_bf16(o[2], o[3]); w.z = cvt_pk_bf16(o[4], o[5]); w.w = cvt_pk_bf16(o[6], o[7]);
                    *(u32x4*)(O + row * 2048 + 1024 + col) = w; } }
#pragma unroll
        for (int ai = 0; ai < 2; ++ai)
#pragma unroll
            for (int m = 0; m < 4; ++m) { float v = ssq[ai * 4 + m]; v += __shfl_xor(v, 16); v += __shfl_xor(v, 32);
                if (fq == 0) unsafeAtomicAdd(rowss + row0 + ai * HALF + m * 16, v); }
    }
};
struct EpiHres {
    static constexpr bool PERM = false, AFTER_DRAIN = false, MIDK = true;
    const float* xp; const float* xs; float* Y; bf16_t* HG; const float* gm; float* rowss; const float* ssa; const float* sss;
    __device__ __forceinline__ float rnorm(const float* p, int row) const { return rsqrtf(__hip_atomic_load(p + row, __ATOMIC_RELAXED, __HIP_MEMORY_SCOPE_AGENT) * (1.0f / 1024.0f) + 1e-6f); }
    __device__ __forceinline__ void midk(f32x4 (&acc)[2][2][4][2], const Unit& u, int wr, int fr) const {
        int br = u.pm * BM + wr * 64 + fr; asm volatile("" : "+v"(br) :: "memory");
        const float* pa = ssa + br; const float* ps = sss + br;
#pragma unroll
        for (int ai = 0; ai < 2; ++ai)
#pragma unroll
            for (int m = 0; m < 4; ++m) { const int o = ai * HALF + m * 16;
                const float va = __hip_atomic_load(pa + o, __ATOMIC_RELAXED, __HIP_MEMORY_SCOPE_AGENT), vs = __hip_atomic_load(ps + o, __ATOMIC_RELAXED, __HIP_MEMORY_SCOPE_AGENT);
                const float ratio = rsqrtf(va * (1.0f / 1024.0f) + 1e-6f) * sqrtf(vs * (1.0f / 1024.0f) + 1e-6f);
#pragma unroll
                for (int bj = 0; bj < 2; ++bj)
#pragma unroll
                    for (int n = 0; n < 2; ++n) acc[ai][bj][m][n] *= ratio; }
    }
    __device__ __forceinline__ void operator()(const f32x4 (&acc)[2][2][4][2], const Unit& u, int wr, int wc, int fr, int fq) const {
        typedef unsigned u32x2v __attribute__((ext_vector_type(2)));
        const int colb = u.pn * BM + wc * 32 + 4 * fq;
#pragma unroll
        for (int ai = 0; ai < 2; ++ai)
#pragma unroll
            for (int m = 0; m < 4; ++m) { const int row = u.pm * BM + ai * HALF + wr * 64 + m * 16 + fr;
                const float* xrow = row < 16384 ? xp + (size_t)row * 2048 : xs + (size_t)(row - 16384) * 2048;
                const float rs = rnorm(sss, row);
                float ss = 0.f;
#pragma unroll
                for (int bj = 0; bj < 2; ++bj)
#pragma unroll
                    for (int n = 0; n < 2; ++n) { const int col = colb + bj * HALF + n * 16;
                        const f32x4 xv = *(const f32x4*)(xrow + col); const f32x4 gv = *(const f32x4*)(gm + col);
                        const f32x4 h = xv + acc[ai][bj][m][n] * rs;
                        *(f32x4*)(Y + (size_t)row * 2048 + col) = h;
                        ss += (h[0] * h[0] + h[1] * h[1]) + (h[2] * h[2] + h[3] * h[3]);
                        u32x2v w; w.x = cvt_pk_bf16(h[0] * gv[0], h[1] * gv[1]); w.y = cvt_pk_bf16(h[2] * gv[2], h[3] * gv[3]);
                        *(u32x2v*)(HG + (size_t)row * 2048 + col) = w; }
                ss += __shfl_xor(ss, 16); ss += __shfl_xor(ss, 32);
                if (fq == 0) unsafeAtomicAdd(rowss + row, ss);
                asm volatile("" ::: "memory"); }
    }
};
struct EpiDown {
    static constexpr bool PERM = false, AFTER_DRAIN = false, MIDK = false;
    float* Y; const float* rowss;
    __device__ __forceinline__ void operator()(const f32x4 (&acc)[2][2][4][2], const Unit& u, int wr, int wc, int fr, int fq) const {
        const int colb = u.pn * BM + wc * 32 + 4 * fq;
#pragma unroll
        for (int ai = 0; ai < 2; ++ai)
#pragma unroll
            for (int m = 0; m < 4; ++m) { const int row = u.pm * BM + ai * HALF + wr * 64 + m * 16 + fr;
                const float ssr = __hip_atomic_load(rowss + row, __ATOMIC_RELAXED, __HIP_MEMORY_SCOPE_AGENT);
                const float r2 = 1.0f / (ssr * (1.0f / 2048.0f) + 1e-6f);
#pragma unroll
                for (int bj = 0; bj < 2; ++bj)
#pragma unroll
                    for (int n = 0; n < 2; ++n) { float* p = Y + (size_t)row * 2048 + colb + bj * HALF + n * 16; const f32x4 h = *(const f32x4*)p; *(f32x4*)p = h + acc[ai][bj][m][n] * r2; } }
    }
};
struct EpiPartial {
    static constexpr bool PERM = false, AFTER_DRAIN = false, MIDK = false;
    float* P; int kper;
    __device__ __forceinline__ void operator()(const f32x4 (&acc)[2][2][4][2], const Unit& u, int wr, int wc, int fr, int fq) const {
        const int colb = u.pn * BM + wc * 32 + 4 * fq; float* base = P + (size_t)(u.k0 / kper) * (512 * 2048);
#pragma unroll
        for (int ai = 0; ai < 2; ++ai)
#pragma unroll
            for (int m = 0; m < 4; ++m) { const int row = (u.pm - 64) * BM + ai * HALF + wr * 64 + m * 16 + fr;
#pragma unroll
                for (int bj = 0; bj < 2; ++bj)
#pragma unroll
                    for (int n = 0; n < 2; ++n) *(f32x4*)(base + (size_t)row * 2048 + colb + bj * HALF + n * 16) = acc[ai][bj][m][n]; }
    }
};
template <int NN  , int NS  , int NTK  > struct SampleSplitOrder {
    int G, c;
    __device__ __forceinline__ void init(int G_, int c_) { G = G_; c = c_; }
    __device__ __forceinline__ bool next(int i, Unit& u) const {
        const int item = i * G + c; if (item >= 2 * NN * NS) return false;
        const int t = item / NS, s = item % NS; u.pm = 64 + t / NN; u.pn = t % NN; u.nt = NTK / NS; u.k0 = s * (NTK / NS) * BK; u.cont = 0; return true;
    }
    __device__ __forceinline__ void a_ready(const Unit&) const {}
    __device__ __forceinline__ void done(const Unit&) const {}
};

struct HalfKOrder {
    StaticOrder base;
    __device__ __forceinline__ void init(int M, int N, int G_, int c_, int K) { base.init(M, N, G_, c_, K); }
    __device__ __forceinline__ bool next(int i, Unit& u) const {
        if (!base.next(i >> 1, u)) return false;
        u.nt = base.ntk >> 1; u.k0 = (i & 1) * u.nt * BK; u.cont = (i & 1) ^ 1; return true;
    }
    __device__ __forceinline__ void a_ready(const Unit&) const {}
    __device__ __forceinline__ void done(const Unit&) const {}
};

template <class Epi, class Sched, bool ALIGN_EPI = false, bool SP2 = false>
__device__ __forceinline__ void gemm_phase(PG8_LAS unsigned char* lds, const Gemm g, const Sched& S, const Epi& E) {
    int tid_ = threadIdx.x; asm volatile("" : "+v"(tid_));
    const int tid = tid_, wid = __builtin_amdgcn_readfirstlane(tid >> 6), lane = tid & 63, wr = wid >> 2, wc = wid & 3, fr = lane & 15, fq = lane >> 4;
    const int K = g.K; int nt;
    unsigned voffA[2], voffB[2];
#pragma unroll
    for (int i = 0; i < 2; ++i) { int R, C; stage_rc(tid * 16 + i * 8192, R, C); const int Rb = Epi::PERM ? ((R & ~31) + perm32(R & 31)) : R;
        voffA[i] = (unsigned)(R * K + C) * 2u; voffB[i] = (unsigned)(Rb * K + C) * 2u; }
    const size_t kstep = (size_t)(BK * 2);
    const size_t hstep = (size_t)HALF * K * 2;
    const size_t tstep = 2 * hstep;
    const unsigned ldsw = (unsigned)wid * 1024u;
    const int aoff = lds_byte(wr * 64 + fr, fq * 8), boff = lds_byte(wc * 32 + fr, fq * 8);
#define PG8_SA(b, h) (((b) * 2 + (h)) * HTB)
#define PG8_SB(b, h) ((4 + (b) * 2 + (h)) * HTB)
#define PG8_STAGE(bufoff, gbase, voff) do { _Pragma("unroll") for (int _i = 0; _i < 2; ++_i) \
        __builtin_amdgcn_global_load_lds((const unsigned*)((const char*)(gbase) + (voff)[_i]), (PG8_LAS unsigned*)(lds + (bufoff) + ldsw + _i * 8192), 16, 0, 0); } while (0)
#define PG8_LDA(dst, b, h) do { _Pragma("unroll") for (int m = 0; m < 4; ++m) _Pragma("unroll") for (int k = 0; k < 2; ++k) dst[m][k] = *(const PG8_LAS bf16x8*)(lds + PG8_SA(b, h) + aoff + m * 2048 + k * 1024); } while (0)
#define PG8_LDB(dst, b, h) do { _Pragma("unroll") for (int n = 0; n < 2; ++n) _Pragma("unroll") for (int k = 0; k < 2; ++k) dst[n][k] = *(const PG8_LAS bf16x8*)(lds + PG8_SB(b, h) + boff + n * 2048 + k * 1024); } while (0)
#define PG8_MMA(ai, bj, At, Bt) do { __builtin_amdgcn_s_setprio(1); _Pragma("unroll") for (int m = 0; m < 4; ++m) _Pragma("unroll") for (int n = 0; n < 2; ++n) _Pragma("unroll") for (int k = 0; k < 2; ++k) \
        acc[ai][bj][m][n] = __builtin_amdgcn_mfma_f32_16x16x32_bf16(Bt[n][k], At[m][k], acc[ai][bj][m][n], 0, 0, 0); __builtin_amdgcn_s_setprio(0); } while (0)
#define PG8_WAIT_V(n) asm volatile("s_waitcnt vmcnt(" #n ")" ::: "memory")
#define PG8_WAIT_L(n) asm volatile("s_waitcnt lgkmcnt(" #n ")" ::: "memory")
#define PG8_BAR __builtin_amdgcn_s_barrier()
#define PG8_SCHED __builtin_amdgcn_sched_barrier(0)
    Unit cur, nxt; int ui = 0;
    if (!S.next(0, cur)) return;
    nt = cur.nt;
    f32x4 acc[2][2][4][2];
#pragma unroll
    for (int a = 0; a < 2; ++a)
#pragma unroll
        for (int b = 0; b < 2; ++b)
#pragma unroll
            for (int m = 0; m < 4; ++m)
#pragma unroll
                for (int n = 0; n < 2; ++n) acc[a][b][m][n] = (f32x4){0.f, 0.f, 0.f, 0.f};
    bf16x8 At[4][2], B0[2][2], B1[2][2];
    const char* cA = (const char*)g.A + (size_t)cur.pm * tstep + (size_t)cur.k0 * 2; const char* cB = (const char*)g.Bt + (size_t)cur.pn * tstep + (size_t)cur.k0 * 2;
    S.a_ready(cur);
    if constexpr (SP2) {
        PG8_STAGE(PG8_SB(0, 0), cB, voffB); PG8_STAGE(PG8_SB(0, 1), cB + hstep, voffB); PG8_STAGE(PG8_SA(0, 0), cA, voffA); PG8_STAGE(PG8_SA(0, 1), cA + hstep, voffA);
        if (wr == 1) PG8_BAR;
        PG8_WAIT_V(2); PG8_BAR;
        PG8_STAGE(PG8_SB(1, 0), cB + kstep, voffB); PG8_STAGE(PG8_SA(1, 0), cA + kstep, voffA); PG8_STAGE(PG8_SB(1, 1), cB + hstep + kstep, voffB);
        PG8_WAIT_V(6); PG8_BAR;
    } else {
        PG8_STAGE(PG8_SB(0, 0), cB, voffB); PG8_STAGE(PG8_SA(0, 0), cA, voffA); PG8_STAGE(PG8_SB(0, 1), cB + hstep, voffB); PG8_STAGE(PG8_SA(0, 1), cA + hstep, voffA);
        if (wr == 1) PG8_BAR;
        PG8_WAIT_V(4); PG8_BAR;
        PG8_STAGE(PG8_SB(1, 0), cB + kstep, voffB); PG8_STAGE(PG8_SA(1, 0), cA + kstep, voffA); PG8_STAGE(PG8_SB(1, 1), cB + hstep + kstep, voffB);
        PG8_WAIT_V(6); PG8_BAR;
    }
    for (;;) {
        const bool has_next = S.next(ui + 1, nxt);
        const char* nA = has_next ? (const char*)g.A + (size_t)nxt.pm * tstep + (size_t)nxt.k0 * 2 : cA; const char* nB = has_next ? (const char*)g.Bt + (size_t)nxt.pn * tstep + (size_t)nxt.k0 * 2 : cB;
        for (int t = 0; t < nt; t += 2) {
            if constexpr (Epi::MIDK) { if (t == (nt >> 1)) E.midk(acc, cur, wr, fr); }
            const bool last = (t == nt - 2);
            const char* a1 = cA + (size_t)(t + 1) * kstep;
            const char* a2 = last ? nA : cA + (size_t)(t + 2) * kstep; const char* b2 = last ? nB : cB + (size_t)(t + 2) * kstep;
            const char* a3 = a2 + kstep; const char* b3 = b2 + kstep;
            if (last && has_next) S.a_ready(nxt);
            if constexpr (SP2) {
            PG8_LDB(B0, 0, 0); PG8_LDB(B1, 0, 1); PG8_SCHED; PG8_LDA(At, 0, 0); PG8_STAGE(PG8_SA(1, 1), a1 + hstep, voffA);
            PG8_WAIT_V(8); PG8_WAIT_L(0); PG8_BAR; PG8_MMA(0, 0, At, B0); PG8_MMA(0, 1, At, B1); PG8_BAR; PG8_SCHED;
            PG8_LDA(At, 0, 1); PG8_STAGE(PG8_SB(0, 0), b2, voffB); PG8_STAGE(PG8_SB(0, 1), b2 + hstep, voffB); PG8_STAGE(PG8_SA(0, 0), a2, voffA);
            PG8_WAIT_V(8); PG8_WAIT_L(0); PG8_BAR; PG8_MMA(1, 0, At, B0); PG8_MMA(1, 1, At, B1); PG8_BAR; PG8_SCHED;
            PG8_LDB(B0, 1, 0); PG8_LDB(B1, 1, 1); PG8_SCHED; PG8_LDA(At, 1, 0); PG8_STAGE(PG8_SA(0, 1), a2 + hstep, voffA);
            PG8_WAIT_V(8); PG8_WAIT_L(0); PG8_BAR; PG8_MMA(0, 0, At, B0); PG8_MMA(0, 1, At, B1); PG8_BAR; PG8_SCHED;
            PG8_LDA(At, 1, 1); PG8_STAGE(PG8_SB(1, 0), b3, voffB); PG8_STAGE(PG8_SB(1, 1), b3 + hstep, voffB); PG8_STAGE(PG8_SA(1, 0), a3, voffA);
            PG8_WAIT_V(8); PG8_WAIT_L(0); PG8_BAR; PG8_MMA(1, 0, At, B0); PG8_MMA(1, 1, At, B1); PG8_BAR; PG8_SCHED;
            } else {
            PG8_LDB(B0, 0, 0); PG8_SCHED; PG8_LDA(At, 0, 0); PG8_STAGE(PG8_SA(1, 1), a1 + hstep, voffA);
            PG8_WAIT_L(8); PG8_BAR; PG8_WAIT_L(0); PG8_MMA(0, 0, At, B0); PG8_BAR; PG8_SCHED;
            PG8_LDB(B1, 0, 1); PG8_STAGE(PG8_SB(0, 0), b2, voffB);
            PG8_BAR; PG8_WAIT_L(0); PG8_MMA(0, 1, At, B1); PG8_BAR;
            PG8_LDA(At, 0, 1); PG8_STAGE(PG8_SA(0, 0), a2, voffA);
            PG8_BAR; PG8_WAIT_L(0); PG8_MMA(1, 0, At, B0); PG8_BAR; PG8_SCHED;
            PG8_STAGE(PG8_SB(0, 1), b2 + hstep, voffB);
            PG8_WAIT_V(6); PG8_BAR; PG8_MMA(1, 1, At, B1); PG8_BAR;
            PG8_LDB(B0, 1, 0); PG8_SCHED; PG8_LDA(At, 1, 0); PG8_STAGE(PG8_SA(0, 1), a2 + hstep, voffA);
            PG8_WAIT_L(8); PG8_BAR; PG8_WAIT_L(0); PG8_MMA(0, 0, At, B0); PG8_BAR; PG8_SCHED;
            PG8_LDB(B1, 1, 1); PG8_STAGE(PG8_SB(1, 0), b3, voffB);
            PG8_BAR; PG8_WAIT_L(0); PG8_MMA(0, 1, At, B1); PG8_BAR;
            PG8_LDA(At, 1, 1); PG8_STAGE(PG8_SA(1, 0), a3, voffA);
            PG8_BAR; PG8_WAIT_L(0); PG8_MMA(1, 0, At, B0); PG8_BAR; PG8_SCHED;
            PG8_STAGE(PG8_SB(1, 1), b3 + hstep, voffB);
            PG8_WAIT_V(6); PG8_BAR; PG8_MMA(1, 1, At, B1); PG8_BAR;
            }
        }
        if constexpr (ALIGN_EPI) { if (wr == 0) PG8_BAR; }
        if constexpr (!Epi::AFTER_DRAIN) { E(acc, cur, wr, wc, fr, fq); S.done(cur); }
        if (!has_next) break;
#pragma unroll
        for (int a = 0; a < 2; ++a)
#pragma unroll
            for (int b = 0; b < 2; ++b)
#pragma unroll
                for (int m = 0; m < 4; ++m)
#pragma unroll
                    for (int n = 0; n < 2; ++n) acc[a][b][m][n] = (f32x4){0.f, 0.f, 0.f, 0.f};
        cur = nxt; cA = nA; cB = nB; ++ui; nt = cur.nt;
        if constexpr (ALIGN_EPI) { if (wr == 1) PG8_BAR; }
    }
    PG8_WAIT_V(0);
    if constexpr (!ALIGN_EPI) { if (wr == 0) PG8_BAR; }
    PG8_BAR;
    if constexpr (Epi::AFTER_DRAIN) { E.fused(acc, cur, wr, wc, fr, fq, lds, wid, lane); S.done(cur); }
#undef PG8_SA
#undef PG8_SB
#undef PG8_STAGE
#undef PG8_LDA
#undef PG8_LDB
#undef PG8_MMA
#undef PG8_WAIT_V
#undef PG8_WAIT_L
#undef PG8_BAR
#undef PG8_SCHED
}
}

#define LAS __attribute__((address_space(3)))
typedef unsigned short bf16;
typedef unsigned v4u __attribute__((ext_vector_type(4)));
typedef unsigned v2u __attribute__((ext_vector_type(2)));
typedef float f32x4 __attribute__((ext_vector_type(4)));
typedef float f32x16 __attribute__((ext_vector_type(16)));
typedef float f32x2 __attribute__((ext_vector_type(2)));
typedef short bf16x8 __attribute__((ext_vector_type(8)));

#ifndef MK_PER_PHASE
#define MK_PER_PHASE 0
#endif
constexpr int NPHASE = 9;
constexpr int NWAVES = 8, NTHR = 512;
constexpr int MP = 16384, MS = 512, MT = MP + MS;
constexpr int DM = 2048, PW = 2560, AW = 1024, SWD = 1024, FF = 8192;
constexpr float EPSN = 1e-6f, LOG2E = 1.4426950408889634f;
constexpr int LDS_PHASE = 152576;
constexpr int LDS_BYTES = LDS_PHASE + 64;

constexpr size_t MiB = 1u << 20;
constexpr size_t WS_CTL = 0, CTL_ZERO_BYTES = 272 * 1024, WS_BAR = 96 * 1024, WS_SSA = 128 * 1024, WS_SSS = 200 * 1024;
constexpr size_t WS_WIN = 1 * MiB, WS_WGLU = 11 * MiB, WS_WOUT = 13 * MiB, WS_WUP = 21 * MiB, WS_WDN = 53 * MiB;
constexpr size_t WS_WSF = 85 * MiB, WS_WHF = 89 * MiB, WS_TF = 93 * MiB, WS_LAM = 94 * MiB + 512 * 1024, WS_LAM16 = WS_LAM + 32768, WS_BBAR = WS_LAM + 65536;
constexpr size_t WS_HG = 96 * MiB;
constexpr size_t WS_PART = WS_HG;
constexpr size_t WS_ACT = 162 * MiB;
constexpr size_t WS_XN = 162 * MiB, WS_Z = 228 * MiB, WS_ATT = 311 * MiB, WS_G = 344 * MiB, WS_SO = 377 * MiB, WS_MIX = 410 * MiB, WS_END = 476 * MiB;

constexpr size_t O_Y = 0, O_KP = (size_t)MT * DM, O_VP = O_KP + 262144, O_RP = O_VP + 262144, O_IP = O_RP + 32768, O_KS = O_IP + 32768,
                 O_VS = O_KS + 4194304, O_RS = O_VS + 4194304, O_IS = O_RS + 524288, O_END = O_IS + 524288;

struct Args { const float* in[27]; float* out; unsigned char* ws; int ph_lo, ph_hi; };
enum { I_XP = 0, I_XS, I_CK, I_CV, I_SR, I_SI, I_ANG, I_WIN, I_QG, I_KG, I_SINK, I_ARE, I_AIM, I_LDT, I_BRE, I_BIM, I_CRE, I_CIM, I_D, I_WGLU, I_BGLU,
       I_AOG, I_SOG, I_WOUT, I_MNG, I_WUP, I_WDN };

__device__ __forceinline__ unsigned pk2(float lo, float hi) { unsigned r; asm("v_cvt_pk_bf16_f32 %0, %1, %2" : "=v"(r) : "v"(lo), "v"(hi)); return r; }
__device__ __forceinline__ unsigned f2bf(float f) { return pk2(f, 0.f) & 0xffffu; }
__device__ __forceinline__ float bflo(unsigned w) { return __uint_as_float(w << 16); }
__device__ __forceinline__ float bfhi(unsigned w) { return __uint_as_float(w & 0xffff0000u); }
__device__ __forceinline__ float wave_sum(float v) {
#pragma unroll
    for (int o = 1; o < 64; o <<= 1) v += __shfl_xor(v, o);
    return v;
}
__device__ __forceinline__ int crow(int r, int hi) { return (r & 3) + 8 * (r >> 2) + 4 * hi; }
__device__ __forceinline__ float gelu_tanh(float y) { const float z = 1.5957691216057308f * (y + 0.044715f * y * y * y); return y / (1.f + __expf(-z)); }

__device__ __forceinline__ void p0_transpose_item(const float* W, int K, int N, bf16* WT, LAS float* scr, int item, int lane, const float* g0 = nullptr, const float* g1 = nullptr) {
    const int nblk = N / 32, kb = item / nblk, nb = item % nblk, k0 = 64 * kb, n0 = 32 * nb;
    f32x4 v[8];
#pragma unroll
    for (int i = 0; i < 8; ++i) v[i] = *(const f32x4*)(W + (size_t)(k0 + 8 * i + (lane >> 3)) * N + n0 + 4 * (lane & 7));
#pragma unroll
    for (int i = 0; i < 8; ++i) { LAS float* d = scr + (8 * i + (lane >> 3)) * 33 + 4 * (lane & 7); float gs = 1.f; if (g0) { const int k = k0 + 8 * i + (lane >> 3); gs = k < (K >> 1) ? g0[k] : g1[k - (K >> 1)]; }
        d[0] = v[i].x * gs; d[1] = v[i].y * gs; d[2] = v[i].z * gs; d[3] = v[i].w * gs; }
    asm volatile("s_waitcnt lgkmcnt(0)" ::: "memory");
    const int c = lane & 7;
#pragma unroll
    for (int j = 0; j < 4; ++j) { const int n = (lane >> 3) + 8 * j; const LAS float* s = scr + (8 * c) * 33 + n;
        v4u o; o.x = pk2(s[0 * 33], s[1 * 33]); o.y = pk2(s[2 * 33], s[3 * 33]); o.z = pk2(s[4 * 33], s[5 * 33]); o.w = pk2(s[6 * 33], s[7 * 33]);
        *(v4u*)(WT + (size_t)(n0 + n) * K + k0 + 8 * c) = o; }
    asm volatile("s_waitcnt lgkmcnt(0)" ::: "memory");
}
struct cpx { float re, im; };
__device__ __forceinline__ cpx cmul(cpx a, cpx b) { return {a.re * b.re - a.im * b.im, a.re * b.im + a.im * b.re}; }
__device__ __forceinline__ cpx lam_pow(float a, float th, int n) { const float e = expf((float)n * a), x = (float)n * th; return {e * cosf(x), e * sinf(x)}; }
__device__ __forceinline__ cpx zoh_coef(float are, float aim, float dt) {
    const float a = dt * are, th = dt * aim, em1 = expm1f(a), s = sinf(th), c = cosf(th), sh = sinf(0.5f * th);
    const float nr = em1 * c - 2.f * sh * sh, ni = (em1 + 1.f) * s, den = are * are + aim * aim;
    return {(nr * are + ni * aim) / den, (ni * are - nr * aim) / den};
}

__device__ __forceinline__ void p0_prologue(const Args& A, LAS unsigned char* lds, int vcu, int G, int tid, int wave, int lane) {
    unsigned char* ws = A.ws;
    LAS float* scr = (LAS float*)(lds + wave * 8448);
    const int gw = vcu * NWAVES + wave, NGW = G * NWAVES;
    constexpr int I_1 = (DM / 64) * (PW / 32);
    for (int it = gw; it < I_1; it += NGW) p0_transpose_item(A.in[I_WIN], DM, PW, (bf16*)(ws + WS_WIN), scr, it, lane);
    {
        f32x4 gv[8];
#pragma unroll
        for (int j = 0; j < 8; ++j) gv[j] = ((const f32x4*)A.in[I_ANG])[lane + 64 * j];
        bf16* XN = (bf16*)(ws + WS_XN);
        for (int m = gw; m < MT; m += NGW) {
            const float* xrow = m < MP ? A.in[I_XP] + (size_t)m * DM : A.in[I_XS] + (size_t)(m - MP) * DM;
            f32x4 v[8]; float s = 0.f;
#pragma unroll
            for (int j = 0; j < 8; ++j) { v[j] = ((const f32x4*)xrow)[lane + 64 * j]; s += (v[j].x * v[j].x + v[j].y * v[j].y) + (v[j].z * v[j].z + v[j].w * v[j].w); }
            const float r = rsqrtf(wave_sum(s) * (1.f / DM) + EPSN);
            v2u* o8 = (v2u*)(XN + (size_t)m * DM) + lane;
#pragma unroll
            for (int j = 0; j < 8; ++j) { v2u w; w.x = pk2(v[j].x * r * gv[j].x, v[j].y * r * gv[j].y); w.y = pk2(v[j].z * r * gv[j].z, v[j].w * r * gv[j].w); o8[64 * j] = w; }
        }
    }
    const float* Are = A.in[I_ARE]; const float* Aim = A.in[I_AIM]; const float* Ldt = A.in[I_LDT];
    const float* Bre = A.in[I_BRE]; const float* Bim = A.in[I_BIM]; const float* Cre = A.in[I_CRE]; const float* Cim = A.in[I_CIM];
    const int gt = vcu * NTHR + tid, NT = G * NTHR;
    for (int idx = gt; idx < 4096; idx += NT) {
        const int g = idx >> 6, p = idx & 63; const float dt = expf(Ldt[g]), are = Are[idx], aim = Aim[idx];
        const cpx l1 = lam_pow(dt * are, dt * aim, 1), l16 = lam_pow(dt * are, dt * aim, 16), cf = zoh_coef(are, aim, dt);
        ((float2*)(ws + WS_LAM))[idx] = make_float2(l1.re, l1.im); ((float2*)(ws + WS_LAM16))[idx] = make_float2(l16.re, l16.im);
#pragma unroll 4
        for (int ch = 0; ch < 16; ++ch) { const cpx b = cmul(cf, cpx{Bre[idx * 16 + ch], Bim[idx * 16 + ch]}); ((float2*)(ws + WS_BBAR))[(g * 16 + ch) * 64 + p] = make_float2(b.re, b.im); }
    }
    for (int idx = gt; idx < 64 * 4 * 16 * 64; idx += NT) {
        const int l = idx & 63, s = (idx >> 6) & 15, rt = (idx >> 10) & 3, g = idx >> 12, r32 = l & 31, hi = l >> 5;
        const int m = 32 * rt + r32, p = m & 63, part = m >> 6, gp = g * 64 + p; const float dt = expf(Ldt[g]), are = Are[gp], aim = Aim[gp];
        const cpx w = cmul(lam_pow(dt * are, dt * aim, 15 - s), zoh_coef(are, aim, dt));
        float v[8];
#pragma unroll
        for (int j = 0; j < 8; ++j) { const int ch = 8 * hi + j; const float br = Bre[gp * 16 + ch], bi = Bim[gp * 16 + ch]; v[j] = part ? (w.re * bi + w.im * br) : (w.re * br - w.im * bi); }
        v4u o; o.x = pk2(v[0], v[1]); o.y = pk2(v[2], v[3]); o.z = pk2(v[4], v[5]); o.w = pk2(v[6], v[7]);
        ((v4u*)(ws + WS_WSF))[idx] = o;
    }
    for (int idx = gt; idx < 64 * 8 * 8 * 64; idx += NT) {
        const int l = idx & 63, kb = (idx >> 6) & 7, tt = (idx >> 9) & 7, g = idx >> 12, r32 = l & 31, hi = l >> 5;
        const int ti = r32 >> 4, chp = r32 & 15, tl = 2 * tt + ti; const float dt = expf(Ldt[g]);
        float v[8];
#pragma unroll
        for (int jp = 0; jp < 4; ++jp) { const int p = 8 * kb + 4 * hi + jp, gp = g * 64 + p;
            const cpx w = cmul(cpx{Cre[(g * 16 + chp) * 64 + p], Cim[(g * 16 + chp) * 64 + p]}, lam_pow(dt * Are[gp], dt * Aim[gp], tl + 1));
            v[2 * jp] = w.re; v[2 * jp + 1] = -w.im; }
        v4u o; o.x = pk2(v[0], v[1]); o.y = pk2(v[2], v[3]); o.z = pk2(v[4], v[5]); o.w = pk2(v[6], v[7]);
        ((v4u*)(ws + WS_WHF))[idx] = o;
    }
    __syncthreads();
    for (int g2 = vcu; g2 < 32; g2 += G) {
        LAS f32x2* pw = (LAS f32x2*)lds;
        LAS f32x2* cf = (LAS f32x2*)(lds + 16384);
        if (tid < 128) { const int gs = tid >> 6, p = tid & 63, gp = (2 * g2 + gs) * 64 + p; const float dt = expf(Ldt[2 * g2 + gs]), are = Are[gp], aim = Aim[gp];
            const cpx c1 = zoh_coef(are, aim, dt); cf[gs * 64 + p] = f32x2{c1.re, c1.im};
#pragma unroll 1
            for (int lag = 0; lag < 16; ++lag) { const cpx w = lam_pow(dt * are, dt * aim, lag); pw[(gs * 16 + lag) * 64 + p] = f32x2{w.re, w.im}; } }
        __syncthreads();
        {
            const int gs = tid >> 8, chp = (tid >> 4) & 15, ch = tid & 15, g = 2 * g2 + gs;
            float acc[16];
#pragma unroll
            for (int l = 0; l < 16; ++l) acc[l] = 0.f;
            for (int p = 0; p < 64; ++p) { const f32x2 c2 = cf[gs * 64 + p];
                const cpx q = cmul(cmul(cpx{Cre[(g * 16 + chp) * 64 + p], Cim[(g * 16 + chp) * 64 + p]}, cpx{c2.x, c2.y}), cpx{Bre[(g * 64 + p) * 16 + ch], Bim[(g * 64 + p) * 16 + ch]});
#pragma unroll
                for (int l = 0; l < 16; ++l) { const f32x2 w = pw[(gs * 16 + l) * 64 + p]; acc[l] += q.re * w.x - q.im * w.y; } }
            bf16* TF = (bf16*)(ws + WS_TF) + (size_t)g * 17 * 512;
            const int hi2 = ch >> 3, j = ch & 7;
#pragma unroll
            for (int l = 0; l < 16; ++l) { const unsigned short v = (unsigned short)f2bf(acc[l]);
                TF[(l * 64 + 32 * hi2 + 16 + chp) * 8 + j] = v;
                if (l < 15) TF[((l + 1) * 64 + 32 * hi2 + chp) * 8 + j] = v; }
            TF[(0 * 64 + 32 * hi2 + chp) * 8 + j] = 0;
            TF[(16 * 64 + 32 * hi2 + chp) * 8 + j] = 0; TF[(16 * 64 + 32 * hi2 + 16 + chp) * 8 + j] = 0;
        }
        __syncthreads();
    }
}

constexpr int KLS = 72, VTS = 264;
constexpr int LDS_K = 0, LDS_VT = 256 * KLS * 2;

__device__ __forceinline__ void attn_qtile(const LAS bf16* Kl, const LAS bf16* Vt, int kt0, const bf16x8 (&qf)[4], int iq, float slope2, float sink2, int jmin,
                                           f32x16 (&o)[2], float& inv_denom, int r32, int hi) {
    f32x16 S[5];
#pragma unroll
    for (int t5 = 0; t5 < 5; ++t5) {
        S[t5] = f32x16{};
#pragma unroll
        for (int d0 = 0; d0 < 4; ++d0) { const bf16x8 kf = *(const LAS bf16x8*)(Kl + (32 * (kt0 + t5) + r32) * KLS + 16 * d0 + 8 * hi); S[t5] = __builtin_amdgcn_mfma_f32_32x32x16_bf16(kf, qf[d0], S[t5], 0, 0, 0); }
    }
    float mx = sink2;
#pragma unroll
    for (int t5 = 0; t5 < 5; ++t5)
#pragma unroll
        for (int r = 0; r < 16; ++r) { const int j = 32 * (kt0 + t5) + crow(r, hi), delta = iq + 128 - j; const bool valid = (delta >= 0) && (delta <= 128) && (j >= jmin);
            const float s = valid ? S[t5][r] - slope2 * (float)delta : -1e30f; S[t5][r] = s; mx = fmaxf(mx, s); }
    mx = fmaxf(mx, __shfl_xor(mx, 32));
    float sum = 0.f;
#pragma unroll
    for (int t5 = 0; t5 < 5; ++t5)
#pragma unroll
        for (int r = 0; r < 16; ++r) { const float p = __builtin_amdgcn_exp2f(S[t5][r] - mx); sum += p; S[t5][r] = p; }
    sum += __shfl_xor(sum, 32);
    inv_denom = 1.0f / (sum + __builtin_amdgcn_exp2f(sink2 - mx));
    o[0] = f32x16{}; o[1] = f32x16{};
#pragma unroll
    for (int t5 = 0; t5 < 5; ++t5)
#pragma unroll
        for (int s2 = 0; s2 < 2; ++s2) {
            v4u pw; pw.x = pk2(S[t5][8 * s2 + 0], S[t5][8 * s2 + 1]); pw.y = pk2(S[t5][8 * s2 + 2], S[t5][8 * s2 + 3]); pw.z = pk2(S[t5][8 * s2 + 4], S[t5][8 * s2 + 5]); pw.w = pk2(S[t5][8 * s2 + 6], S[t5][8 * s2 + 7]);
            const bf16x8 pf = __builtin_bit_cast(bf16x8, pw);
#pragma unroll
            for (int dt = 0; dt < 2; ++dt) { const LAS bf16* vr = Vt + (32 * dt + r32) * VTS + 32 * (kt0 + t5) + 16 * s2 + 4 * hi;
                const v2u lo = *(const LAS v2u*)vr, hh = *(const LAS v2u*)(vr + 8); v4u vw; vw.x = lo.x; vw.y = lo.y; vw.z = hh.x; vw.w = hh.y;
                o[dt] = __builtin_amdgcn_mfma_f32_32x32x16_bf16(__builtin_bit_cast(bf16x8, vw), pf, o[dt], 0, 0, 0); }
        }
}
__device__ __forceinline__ void attn_qtile_fast(const LAS bf16* Kl, const LAS bf16* Vt, int kt0, const bf16x8 (&qf)[4], int iq, float slope2, float sink2,
                                                f32x16 (&o)[2], float& inv_denom, int r32, int hi) {
    f32x16 S[5];
    const float sbase = slope2 * (float)(4 * hi);
#pragma unroll
    for (int t5 = 0; t5 < 5; ++t5) {
        S[t5] = f32x16{};
#pragma unroll
        for (int d0 = 0; d0 < 4; ++d0) { const bf16x8 kf = *(const LAS bf16x8*)(Kl + (32 * (kt0 + t5) + r32) * KLS + 16 * d0 + 8 * hi); S[t5] = __builtin_amdgcn_mfma_f32_32x32x16_bf16(kf, qf[d0], S[t5], 0, 0, 0); }
    }
    const int D0 = iq + 128 - 32 * kt0 - 4 * hi, lo = D0 - 128;
    const float sinkp = sink2 + slope2 * (float)(iq + 128 - 32 * kt0);
    float m0 = -1e30f;
#pragma unroll
    for (int t5 = 0; t5 < 5; ++t5)
#pragma unroll
        for (int r = 0; r < 16; ++r) { const int off = 32 * t5 + (r & 3) + 8 * (r >> 2);
            float s = fmaf(slope2, (float)off, S[t5][r]);
            if (t5 == 0) s = (off >= lo) ? s : -1e30f;
            if (t5 == 4) s = (off <= D0) ? s : -1e30f;
            S[t5][r] = s; m0 = fmaxf(m0, s); }
    const float mloc = m0 + sbase;
    const float mx = fmaxf(sinkp, fmaxf(mloc, __shfl_xor(mloc, 32))), mxl = mx - sbase;
    float sum = 0.f;
#pragma unroll
    for (int t5 = 0; t5 < 5; ++t5)
#pragma unroll
        for (int r = 0; r < 16; ++r) { const float p = __builtin_amdgcn_exp2f(S[t5][r] - mxl); sum += p; S[t5][r] = p; }
    sum += __shfl_xor(sum, 32);
    inv_denom = 1.0f / (sum + __builtin_amdgcn_exp2f(sinkp - mx));
    o[0] = f32x16{}; o[1] = f32x16{};
#pragma unroll
    for (int t5 = 0; t5 < 5; ++t5)
#pragma unroll
        for (int s2 = 0; s2 < 2; ++s2) {
            v4u pw; pw.x = pk2(S[t5][8 * s2 + 0], S[t5][8 * s2 + 1]); pw.y = pk2(S[t5][8 * s2 + 2], S[t5][8 * s2 + 3]); pw.z = pk2(S[t5][8 * s2 + 4], S[t5][8 * s2 + 5]); pw.w = pk2(S[t5][8 * s2 + 6], S[t5][8 * s2 + 7]);
            const bf16x8 pf = __builtin_bit_cast(bf16x8, pw);
#pragma unroll
            for (int dt = 0; dt < 2; ++dt) { const LAS bf16* vr = Vt + (32 * dt + r32) * VTS + 32 * (kt0 + t5) + 16 * s2 + 4 * hi;
                const v2u lo2 = *(const LAS v2u*)vr, hh = *(const LAS v2u*)(vr + 8); v4u vw; vw.x = lo2.x; vw.y = lo2.y; vw.z = hh.x; vw.w = hh.y;
                o[dt] = __builtin_amdgcn_mfma_f32_32x32x16_bf16(__builtin_bit_cast(bf16x8, vw), pf, o[dt], 0, 0, 0); }
        }
}
__device__ __forceinline__ void stage_kv_from_z(const bf16* zrow, int kvh, int half, bool valid, LAS bf16* Kl, LAS bf16* Vt, int row, const float* gk, float* outk, float* outv) {
    v4u kw[4], vw[4];
#pragma unroll
    for (int i = 0; i < 4; ++i) { kw[i] = v4u{0u, 0u, 0u, 0u}; vw[i] = v4u{0u, 0u, 0u, 0u}; }
    if (valid) {
#pragma unroll
        for (int i = 0; i < 4; ++i) { kw[i] = *(const v4u*)(zrow + 1024 + kvh * 64 + 32 * half + 8 * i); vw[i] = *(const v4u*)(zrow + 1280 + kvh * 64 + 32 * half + 8 * i); }
    }
    float kf[32]; float ss = 0.f;
#pragma unroll
    for (int i = 0; i < 4; ++i) { kf[8 * i + 0] = bflo(kw[i].x); kf[8 * i + 1] = bfhi(kw[i].x); kf[8 * i + 2] = bflo(kw[i].y); kf[8 * i + 3] = bfhi(kw[i].y);
        kf[8 * i + 4] = bflo(kw[i].z); kf[8 * i + 5] = bfhi(kw[i].z); kf[8 * i + 6] = bflo(kw[i].w); kf[8 * i + 7] = bfhi(kw[i].w); }
#pragma unroll
    for (int i = 0; i < 32; ++i) ss += kf[i] * kf[i];
    ss += __shfl_xor(ss, 1);
    const float rk = rsqrtf(ss * (1.f / 64.f) + EPSN);
#pragma unroll
    for (int i = 0; i < 32; ++i) kf[i] = kf[i] * rk * gk[32 * half + i];
#pragma unroll
    for (int i = 0; i < 4; ++i) { v4u w; w.x = pk2(kf[8 * i], kf[8 * i + 1]); w.y = pk2(kf[8 * i + 2], kf[8 * i + 3]); w.z = pk2(kf[8 * i + 4], kf[8 * i + 5]); w.w = pk2(kf[8 * i + 6], kf[8 * i + 7]);
        *(LAS v4u*)(Kl + row * KLS + 32 * half + 8 * i) = w; }
#pragma unroll
    for (int i = 0; i < 4; ++i) { const unsigned ww[4] = {vw[i].x, vw[i].y, vw[i].z, vw[i].w};
#pragma unroll
        for (int q = 0; q < 4; ++q) { Vt[(32 * half + 8 * i + 2 * q) * VTS + row] = (bf16)(ww[q] & 0xffffu); Vt[(32 * half + 8 * i + 2 * q + 1) * VTS + row] = (bf16)(ww[q] >> 16); } }
    if (outk) {
#pragma unroll
        for (int i = 0; i < 8; ++i) ((f32x4*)(outk + 32 * half))[i] = f32x4{kf[4 * i], kf[4 * i + 1], kf[4 * i + 2], kf[4 * i + 3]};
#pragma unroll
        for (int i = 0; i < 4; ++i) { ((f32x4*)(outv + 32 * half))[2 * i] = f32x4{bflo(vw[i].x), bfhi(vw[i].x), bflo(vw[i].y), bfhi(vw[i].y)};
            ((f32x4*)(outv + 32 * half))[2 * i + 1] = f32x4{bflo(vw[i].z), bfhi(vw[i].z), bflo(vw[i].w), bfhi(vw[i].w)}; }
    }
}
__device__ __forceinline__ void load_q_raw(const bf16* zrow, int h, int hi, v4u (&qw)[4]) {
#pragma unroll
    for (int d0 = 0; d0 < 4; ++d0) qw[d0] = *(const v4u*)(zrow + h * 64 + 16 * d0 + 8 * hi);
}
__device__ __forceinline__ void finish_qfrags(const v4u (&qw)[4], const float* gq, bf16x8 (&qf)[4], int hi) {
    float ss = 0.f;
#pragma unroll
    for (int d0 = 0; d0 < 4; ++d0) {
        const float a0 = bflo(qw[d0].x), a1 = bfhi(qw[d0].x), a2 = bflo(qw[d0].y), a3 = bfhi(qw[d0].y), a4 = bflo(qw[d0].z), a5 = bfhi(qw[d0].z), a6 = bflo(qw[d0].w), a7 = bfhi(qw[d0].w);
        ss += (a0 * a0 + a1 * a1) + (a2 * a2 + a3 * a3) + (a4 * a4 + a5 * a5) + (a6 * a6 + a7 * a7); }
    ss += __shfl_xor(ss, 32);
    const float rq = rsqrtf(ss * (1.f / 64.f) + EPSN) * (0.125f * LOG2E);
#pragma unroll
    for (int d0 = 0; d0 < 4; ++d0) { const float* g = gq + 16 * d0 + 8 * hi; v4u w;
        w.x = pk2(bflo(qw[d0].x) * rq * g[0], bfhi(qw[d0].x) * rq * g[1]); w.y = pk2(bflo(qw[d0].y) * rq * g[2], bfhi(qw[d0].y) * rq * g[3]);
        w.z = pk2(bflo(qw[d0].z) * rq * g[4], bfhi(qw[d0].z) * rq * g[5]); w.w = pk2(bflo(qw[d0].w) * rq * g[6], bfhi(qw[d0].w) * rq * g[7]);
        qf[d0] = __builtin_bit_cast(bf16x8, w); }
}
__device__ __forceinline__ void load_qfrags(const bf16* zrow, int h, const float* gq, bf16x8 (&qf)[4], int hi) { v4u qw[4]; load_q_raw(zrow, h, hi, qw); finish_qfrags(qw, gq, qf, hi); }
__device__ __forceinline__ void store_attn_out(bf16* orow  , float* ssrow  , bool active, const f32x16 (&o)[2], float inv, int hi) {
    float ss = 0.f;
#pragma unroll
    for (int dt = 0; dt < 2; ++dt)
#pragma unroll
        for (int r4 = 0; r4 < 4; ++r4) { const float a = o[dt][4 * r4] * inv, b = o[dt][4 * r4 + 1] * inv, c = o[dt][4 * r4 + 2] * inv, d = o[dt][4 * r4 + 3] * inv;
            ss += (a * a + b * b) + (c * c + d * d);
            v2u w; w.x = pk2(a, b); w.y = pk2(c, d);
            if (active) *(v2u*)(orow + 32 * dt + 8 * r4 + 4 * hi) = w; }
    ss += __shfl_xor(ss, 32);
    if (active && hi == 0) unsafeAtomicAdd(ssrow, ss);
}
__device__ __forceinline__ void attn_prompt_unit(const Args& A, LAS unsigned char* lds, int b, int kvh, int qb, int tid, int wave, int lane) {
    LAS bf16* Kl = (LAS bf16*)(lds + LDS_K); LAS bf16* Vt = (LAS bf16*)(lds + LDS_VT);
    const bf16* Z = (const bf16*)(A.ws + WS_Z); bf16* ATT = (bf16*)(A.ws + WS_MIX); float* SSA = (float*)(A.ws + WS_SSA);
    const int r32 = lane & 31, hi = lane >> 5;
    const int h = kvh * 4 + (wave >> 1);
    const int tok0 = b * 2048 + qb * 128 + 64 * (wave & 1) + r32;
    v4u qw0[4], qw1[4];
    load_q_raw(Z + (size_t)tok0 * PW, h, hi, qw0); load_q_raw(Z + (size_t)(tok0 + 32) * PW, h, hi, qw1);
    {
        const int row = tid >> 1, half = tid & 1, tok = (qb - 1) * 128 + row; const bool valid = tok >= 0;
        const bf16* zrow = Z + (size_t)(b * 2048 + (valid ? tok : 0)) * PW;
        float* outk = nullptr; float* outv = nullptr;
        if (qb == 15 && row >= 128) { const size_t o = ((size_t)(b * 128 + row - 128) * 4 + kvh) * 64; outk = A.out + O_KP + o; outv = A.out + O_VP + o; }
        stage_kv_from_z(zrow, kvh, half, valid, Kl, Vt, row, A.in[I_KG], outk, outv);
    }
    __syncthreads();
    const float slope2 = exp2f(-0.5f * (float)(h + 1)) * LOG2E, sink2 = A.in[I_SINK][h] * LOG2E;
#pragma unroll 1
    for (int jj = 0; jj < 2; ++jj) {
        const int jq = 2 * (wave & 1) + jj, tok = tok0 + 32 * jj;
        v4u qs[4];
#pragma unroll
        for (int d0 = 0; d0 < 4; ++d0) qs[d0] = jj ? qw1[d0] : qw0[d0];
        bf16x8 qf[4]; finish_qfrags(qs, A.in[I_QG], qf, hi);
        f32x16 o[2]; float inv;
        if (qb == 0) attn_qtile(Kl, Vt, jq, qf, 32 * jq + r32, slope2, sink2, 128, o, inv, r32, hi);
        else attn_qtile_fast(Kl, Vt, jq, qf, 32 * jq + r32, slope2, sink2, o, inv, r32, hi);
        store_attn_out(ATT + (size_t)tok * DM + h * 64, SSA + tok, true, o, inv, hi);
    }
    __syncthreads();
}
__device__ __forceinline__ void attn_sample_unit(const Args& A, LAS unsigned char* lds, int n, int kvh, int tid, int wave, int lane) {
    LAS bf16* Kl = (LAS bf16*)(lds + LDS_K); LAS bf16* Vt = (LAS bf16*)(lds + LDS_VT);
    const bf16* Z = (const bf16*)(A.ws + WS_Z); bf16* ATT = (bf16*)(A.ws + WS_MIX); float* SSA = (float*)(A.ws + WS_SSA);
    const int r32 = lane & 31, hi = lane >> 5;
    {
        const int row = tid >> 2, qt = tid & 3; const size_t src = ((size_t)(n * 128 + row) * 4 + kvh) * 64 + 16 * qt;
        f32x4 kv[4], vv[4];
#pragma unroll
        for (int i = 0; i < 4; ++i) { kv[i] = ((const f32x4*)(A.in[I_CK] + src))[i]; vv[i] = ((const f32x4*)(A.in[I_CV] + src))[i]; }
#pragma unroll
        for (int i = 0; i < 2; ++i) { v4u w; w.x = pk2(kv[2 * i].x, kv[2 * i].y); w.y = pk2(kv[2 * i].z, kv[2 * i].w); w.z = pk2(kv[2 * i + 1].x, kv[2 * i + 1].y); w.w = pk2(kv[2 * i + 1].z, kv[2 * i + 1].w);
            *(LAS v4u*)(Kl + row * KLS + 16 * qt + 8 * i) = w; }
#pragma unroll
        for (int i = 0; i < 4; ++i) { Vt[(16 * qt + 4 * i + 0) * VTS + row] = (bf16)f2bf(vv[i].x); Vt[(16 * qt + 4 * i + 1) * VTS + row] = (bf16)f2bf(vv[i].y);
            Vt[(16 * qt + 4 * i + 2) * VTS + row] = (bf16)f2bf(vv[i].z); Vt[(16 * qt + 4 * i + 3) * VTS + row] = (bf16)f2bf(vv[i].w); }
        if (row >= 4) { const size_t dst = ((size_t)(n * 128 + row - 4) * 4 + kvh) * 64 + 16 * qt;
#pragma unroll
            for (int i = 0; i < 4; ++i) { ((f32x4*)(A.out + O_KS + dst))[i] = kv[i]; ((f32x4*)(A.out + O_VS + dst))[i] = vv[i]; } }
        for (int idx = tid; idx < 28 * 64; idx += NTHR) { const int r = 132 + (idx >> 6), c = idx & 63; Kl[r * KLS + c] = 0; Vt[c * VTS + r] = 0; }
        if (tid < 8) {
            const int t = tid >> 1, half = tid & 1; const size_t o = ((size_t)(n * 128 + 124 + t) * 4 + kvh) * 64;
            stage_kv_from_z(Z + (size_t)(MP + 4 * n + t) * PW, kvh, half, true, Kl, Vt, 128 + t, A.in[I_KG], A.out + O_KS + o, A.out + O_VS + o);
        }
    }
    __syncthreads();
    if (wave == 0) {
        const int t = r32 & 3, rr = (r32 >> 2) & 3, h = kvh * 4 + rr, tok = MP + 4 * n + t;
        const float slope2 = exp2f(-0.5f * (float)(h + 1)) * LOG2E, sink2 = A.in[I_SINK][h] * LOG2E;
        bf16x8 qf[4]; load_qfrags(Z + (size_t)tok * PW, h, A.in[I_QG], qf, hi);
        f32x16 o[2]; float inv;
        attn_qtile_fast(Kl, Vt, 0, qf, t, slope2, sink2, o, inv, r32, hi);
        store_attn_out(ATT + (size_t)tok * DM + h * 64, SSA + tok, r32 < 16, o, inv, hi);
    }
    __syncthreads();
}

constexpr int US = 264, ES = 132;
constexpr int LDS_U = 0, LDS_E = 128 * US * 2, LDS_TF = LDS_E + 128 * ES * 4, LDS_SSM_END = LDS_TF + 17 * 1024;
__device__ __forceinline__ void ssm_prompt_unit(const Args& A, LAS unsigned char* lds, int b, int g, int tid, int wave, int lane) {
    LAS bf16* U = (LAS bf16*)(lds + LDS_U); LAS float* E = (LAS float*)(lds + LDS_E); LAS unsigned char* TFl = lds + LDS_TF;
    const int r32 = lane & 31, hi = lane >> 5, w4 = wave & 3, ctp = wave >> 2;
    const bf16* Zu = (const bf16*)(A.ws + WS_Z) + (size_t)(b * 2048) * PW + 1536 + 16 * g;
    {
        v4u uv[8], tv[3];
#pragma unroll
        for (int i = 0; i < 8; ++i) { const int q = tid + 512 * i, t = q >> 1, h = q & 1; uv[i] = *(const v4u*)(Zu + (size_t)t * PW + 8 * h); }
        const v4u* tfg = (const v4u*)(A.ws + WS_TF) + (size_t)g * 17 * 64;
#pragma unroll
        for (int i = 0; i < 3; ++i) { const int q = tid + 512 * i; tv[i] = q < 17 * 64 ? tfg[q] : v4u{0u, 0u, 0u, 0u}; }
#pragma unroll
        for (int i = 0; i < 8; ++i) { const int q = tid + 512 * i, t = q >> 1, h = q & 1; *(LAS v4u*)(U + (t >> 4) * US + (t & 15) * 16 + 8 * h) = uv[i]; }
#pragma unroll
        for (int i = 0; i < 3; ++i) { const int q = tid + 512 * i; if (q < 17 * 64) *(LAS v4u*)(TFl + q * 16) = tv[i]; }
    }
    bf16x8 wf[16];
    {   const bf16x8* wsf = (const bf16x8*)(A.ws + WS_WSF) + (size_t)((g * 4 + w4) * 16) * 64 + lane;
#pragma unroll
        for (int s = 0; s < 16; ++s) wf[s] = wsf[s * 64]; }
    __syncthreads();
    const LAS bf16* u0p = U + (32 * (2 * ctp) + r32) * US + 8 * hi; const LAS bf16* u1p = U + (32 * (2 * ctp + 1) + r32) * US + 8 * hi;
    {
        f32x16 e0 = f32x16{}, e1 = f32x16{};
#pragma unroll
        for (int s = 0; s < 16; ++s) { const bf16x8 u0 = *(const LAS bf16x8*)(u0p + s * 16), u1 = *(const LAS bf16x8*)(u1p + s * 16);
            e0 = __builtin_amdgcn_mfma_f32_32x32x16_bf16(wf[s], u0, e0, 0, 0, 0); e1 = __builtin_amdgcn_mfma_f32_32x32x16_bf16(wf[s], u1, e1, 0, 0, 0); }
#pragma unroll
        for (int r = 0; r < 16; ++r) { const int m = 32 * w4 + crow(r, hi); E[(32 * (2 * ctp) + r32) * ES + m] = e0[r]; E[(32 * (2 * ctp + 1) + r32) * ES + m] = e1[r]; }
    }
    const int ttA = w4, ttB = 7 - w4;
    asm volatile("" ::: "memory");
    bf16x8 whA[8], whB[8];
    {   const bf16x8* pa = (const bf16x8*)(A.ws + WS_WHF) + (size_t)((g * 8 + ttA) * 8) * 64 + lane; const bf16x8* pb = (const bf16x8*)(A.ws + WS_WHF) + (size_t)((g * 8 + ttB) * 8) * 64 + lane;
#pragma unroll
        for (int kb = 0; kb < 8; ++kb) { whA[kb] = pa[kb * 64]; whB[kb] = pb[kb * 64]; } }
    __syncthreads();
    if (wave == 0) {
        const float2 l16 = ((const float2*)(A.ws + WS_LAM16))[g * 64 + lane];
        float hr = 0.f, hm = 0.f;
#pragma unroll 8
        for (int c = 0; c < 128; ++c) { const float er = E[c * ES + lane], ei = E[c * ES + 64 + lane];
            E[c * ES + lane] = __uint_as_float(pk2(hr, hm));
            const float nr = l16.x * hr - l16.y * hm + er, ni = l16.x * hm + l16.y * hr + ei; hr = nr; hm = ni; }
        A.out[O_RP + (size_t)(b * 64 + g) * 64 + lane] = hr; A.out[O_IP + (size_t)(b * 64 + g) * 64 + lane] = hm;
    }
    __syncthreads();
    {
        f32x16 aA0 = f32x16{}, aA1 = f32x16{}, aB0 = f32x16{}, aB1 = f32x16{};
        const LAS unsigned char* tfl = TFl + lane * 16;
#pragma unroll 4
        for (int s = 0; s < 16; ++s) {
            if (s <= 2 * ttB + 1) {
                const bf16x8 u0 = *(const LAS bf16x8*)(u0p + s * 16), u1 = *(const LAS bf16x8*)(u1p + s * 16);
                const bf16x8 tB = *(const LAS bf16x8*)(tfl + (2 * ttB - s + 1) * 1024);
                aB0 = __builtin_amdgcn_mfma_f32_32x32x16_bf16(tB, u0, aB0, 0, 0, 0); aB1 = __builtin_amdgcn_mfma_f32_32x32x16_bf16(tB, u1, aB1, 0, 0, 0);
                if (s <= 2 * ttA + 1) { const bf16x8 tA = *(const LAS bf16x8*)(tfl + (2 * ttA - s + 1) * 1024);
                    aA0 = __builtin_amdgcn_mfma_f32_32x32x16_bf16(tA, u0, aA0, 0, 0, 0); aA1 = __builtin_amdgcn_mfma_f32_32x32x16_bf16(tA, u1, aA1, 0, 0, 0); }
            }
        }
        const LAS bf16* h0p = (const LAS bf16*)(E + (32 * (2 * ctp) + r32) * ES) + 8 * hi; const LAS bf16* h1p = (const LAS bf16*)(E + (32 * (2 * ctp + 1) + r32) * ES) + 8 * hi;
#pragma unroll
        for (int kb = 0; kb < 8; ++kb) {
            const bf16x8 h0 = *(const LAS bf16x8*)(h0p + 16 * kb), h1 = *(const LAS bf16x8*)(h1p + 16 * kb);
            aA0 = __builtin_amdgcn_mfma_f32_32x32x16_bf16(whA[kb], h0, aA0, 0, 0, 0); aA1 = __builtin_amdgcn_mfma_f32_32x32x16_bf16(whA[kb], h1, aA1, 0, 0, 0);
            aB0 = __builtin_amdgcn_mfma_f32_32x32x16_bf16(whB[kb], h0, aB0, 0, 0, 0); aB1 = __builtin_amdgcn_mfma_f32_32x32x16_bf16(whB[kb], h1, aB1, 0, 0, 0);
        }
        bf16* Gm = (bf16*)(A.ws + WS_G);
        const float* Dk = A.in[I_D] + 16 * g;
#define SSM_EPI(acc, tt, ct) do { _Pragma("unroll") for (int r4 = 0; r4 < 4; ++r4) { const int ti = r4 >> 1, ch0 = 8 * (r4 & 1) + 4 * hi, cc = 32 * (ct) + r32, tok = 16 * cc + 2 * (tt) + ti; \
            const v2u uw = *(const LAS v2u*)(U + cc * US + (2 * (tt) + ti) * 16 + ch0); const f32x4 dv = *(const f32x4*)(Dk + ch0); \
            const float y0 = acc[4 * r4 + 0] + dv.x * bflo(uw.x), y1 = acc[4 * r4 + 1] + dv.y * bfhi(uw.x), y2 = acc[4 * r4 + 2] + dv.z * bflo(uw.y), y3 = acc[4 * r4 + 3] + dv.w * bfhi(uw.y); \
            v2u w; w.x = pk2(gelu_tanh(y0), gelu_tanh(y1)); w.y = pk2(gelu_tanh(y2), gelu_tanh(y3)); \
            *(v2u*)(Gm + (size_t)(b * 2048 + tok) * SWD + 16 * g + ch0) = w; } } while (0)
        SSM_EPI(aA0, ttA, 2 * ctp); SSM_EPI(aA1, ttA, 2 * ctp + 1); SSM_EPI(aB0, ttB, 2 * ctp); SSM_EPI(aB1, ttB, 2 * ctp + 1);
#undef SSM_EPI
    }
    __syncthreads();
}
__device__ __forceinline__ void ssm_sample_wave(const Args& A, LAS unsigned char* lds, int gw  , int ngw, int wave, int lane) {
    LAS float* Cr = (LAS float*)(lds + wave * 8192); LAS float* Ci = Cr + 1024; LAS float* hs = (LAS float*)(lds + 65536 + wave * 2048);
    const bf16* Z = (const bf16*)(A.ws + WS_Z);
    const int tl = lane >> 4, cl = lane & 15;
    for (int g = gw & 63; g < 64; g += 64) {
        {   const f32x4* cre = (const f32x4*)(A.in[I_CRE] + (size_t)g * 1024); const f32x4* cim = (const f32x4*)(A.in[I_CIM] + (size_t)g * 1024);
#pragma unroll
            for (int i = 0; i < 4; ++i) { const int q4 = lane + 64 * i, chp = q4 >> 4, p0 = (q4 & 15) * 4; const f32x4 a = cre[q4], c = cim[q4];
                Cr[(p0 + 0) * 16 + chp] = a.x; Cr[(p0 + 1) * 16 + chp] = a.y; Cr[(p0 + 2) * 16 + chp] = a.z; Cr[(p0 + 3) * 16 + chp] = a.w;
                Ci[(p0 + 0) * 16 + chp] = c.x; Ci[(p0 + 1) * 16 + chp] = c.y; Ci[(p0 + 2) * 16 + chp] = c.z; Ci[(p0 + 3) * 16 + chp] = c.w; } }
        const float2 lam = ((const float2*)(A.ws + WS_LAM))[g * 64 + lane];
        float2 bb[16];
#pragma unroll
        for (int ch = 0; ch < 16; ++ch) bb[ch] = ((const float2*)(A.ws + WS_BBAR))[(g * 16 + ch) * 64 + lane];
        const float dsk = A.in[I_D][16 * g + cl];
        for (int n = gw >> 6; n < 128; n += ngw >> 6) {
            float hr = A.in[I_SR][(size_t)(n * 64 + g) * 64 + lane], hm = A.in[I_SI][(size_t)(n * 64 + g) * 64 + lane];
            const unsigned short ub = Z[(size_t)(MP + 4 * n + tl) * PW + 1536 + 16 * g + cl];
            const float uval = __uint_as_float((unsigned)ub << 16);
#pragma unroll
            for (int t = 0; t < 4; ++t) {
                float br = 0.f, bi = 0.f;
#pragma unroll
                for (int ch = 0; ch < 16; ++ch) { const float u = __shfl(uval, t * 16 + ch); br += bb[ch].x * u; bi += bb[ch].y * u; }
                const float nr = lam.x * hr - lam.y * hm + br, ni = lam.x * hm + lam.y * hr + bi; hr = nr; hm = ni;
                hs[(t * 2 + 0) * 64 + lane] = hr; hs[(t * 2 + 1) * 64 + lane] = hm;
            }
            A.out[O_RS + (size_t)(n * 64 + g) * 64 + lane] = hr; A.out[O_IS + (size_t)(n * 64 + g) * 64 + lane] = hm;
            float y = 0.f;
#pragma unroll 4
            for (int p = 0; p < 64; p += 4) { const f32x4 h4 = *(const LAS f32x4*)(hs + (tl * 2 + 0) * 64 + p), g4 = *(const LAS f32x4*)(hs + (tl * 2 + 1) * 64 + p);
                y += (Cr[(p + 0) * 16 + cl] * h4.x - Ci[(p + 0) * 16 + cl] * g4.x) + (Cr[(p + 1) * 16 + cl] * h4.y - Ci[(p + 1) * 16 + cl] * g4.y)
                   + (Cr[(p + 2) * 16 + cl] * h4.z - Ci[(p + 2) * 16 + cl] * g4.z) + (Cr[(p + 3) * 16 + cl] * h4.w - Ci[(p + 3) * 16 + cl] * g4.w); }
            y += dsk * uval;
            ((bf16*)(A.ws + WS_G))[(size_t)(MP + 4 * n + tl) * SWD + 16 * g + cl] = (bf16)f2bf(gelu_tanh(y));
        }
    }
}

__device__ __forceinline__ void convert_two(const float* W1, int K1, int N1, bf16* T1, const float* W2, int K2, int N2, bf16* T2, LAS unsigned char* lds, int w, int nw, int wave, int lane, const float* g0 = nullptr, const float* g1 = nullptr) {
    LAS float* scr = (LAS float*)(lds + wave * 8448);
    const int i1 = (K1 / 64) * (N1 / 32), i2 = (K2 / 64) * (N2 / 32);
    for (int it = w * NWAVES + wave; it < i1 + i2; it += nw * NWAVES) {
        if (it < i1) p0_transpose_item(W1, K1, N1, T1, scr, it, lane); else p0_transpose_item(W2, K2, N2, T2, scr, it - i1, lane, g0, g1);
    }
}
#define XB_TMO      128
#define XB_XCNT(j)  (256  + 64 * (j))
#define XB_XSUB(j)  (1280 + 64 * (j))
#define XB_XGEN(j)  (2304 + 64 * (j))
#define XB_TOP      3328
#define XB_TOPGEN   3392
#define XCD_BAR_WORDS 3456
#define XB_SPIN_CAP (1u << 18)

__device__ __forceinline__ unsigned xb_ld(unsigned* p)              { return __hip_atomic_load(p, __ATOMIC_RELAXED, __HIP_MEMORY_SCOPE_AGENT); }
__device__ __forceinline__ unsigned xb_add(unsigned* p, unsigned v) { return __hip_atomic_fetch_add(p, v, __ATOMIC_RELAXED, __HIP_MEMORY_SCOPE_AGENT); }
__device__ __forceinline__ unsigned xb_xcc_id() { return (unsigned)__builtin_amdgcn_s_getreg((3 << 11) | 20) & 0xFu; }
#define XB_SPIN(cond, bar) do { unsigned _sp = 0; while (cond) { __builtin_amdgcn_s_sleep(1); \
    if ((++_sp & 255u) == 0u) { if (xb_ld(&(bar)[XB_TMO])) break; if (_sp > XB_SPIN_CAP) { atomicAdd(&(bar)[XB_TMO], 1u); break; } } } } while (0)

struct XcdBarrier {
    unsigned* bar; unsigned x;
    volatile LAS unsigned* st;
};

__device__ __forceinline__ XcdBarrier xcd_barrier_post(unsigned* bar, volatile LAS unsigned* st) {
    XcdBarrier b; b.bar = bar; b.x = xb_xcc_id(); b.st = st;
    if (threadIdx.x == 0) (void)xb_add(&bar[XB_XCNT(b.x)], 1u);
    return b;
}
__device__ __forceinline__ void xcd_barrier_complete(unsigned* bar, unsigned x, unsigned& nloc, unsigned& nx) {
    const unsigned G = gridDim.x * gridDim.y * gridDim.z;
    unsigned sum, cnt, mine, sp = 0u;
    for (;;) {
        sum = 0u; cnt = 0u; mine = 0u;
#pragma unroll
        for (unsigned j = 0; j < 16; ++j) { const unsigned c = xb_ld(&bar[XB_XCNT(j)]); sum += c; cnt += (c > 0u) ? 1u : 0u; mine = (j == x) ? c : mine; }
        if (sum == G) break;
        __builtin_amdgcn_s_sleep(1);
        if ((++sp & 255u) == 0u) { if (xb_ld(&bar[XB_TMO])) break; if (sp > XB_SPIN_CAP) { atomicAdd(&bar[XB_TMO], 1u); break; } }
    }
    nloc = mine > 0u ? mine : 1u; nx = cnt > 0u ? cnt : 1u;
}

__device__ __forceinline__ void xcd_barrier(const XcdBarrier& b) {
    asm volatile("s_waitcnt vmcnt(0)" ::: "memory");
    __syncthreads();
    if (threadIdx.x == 0) {
        unsigned* bar = b.bar;
        __builtin_amdgcn_s_waitcnt(0);
        unsigned nloc = b.st[0], nx = b.st[1];
        if (nloc == 0u) { xcd_barrier_complete(bar, b.x, nloc, nx); b.st[0] = nloc; b.st[1] = nx; }
        const unsigned old = xb_add(&bar[XB_XSUB(b.x)], 1u);
        const unsigned gen = old / nloc;
        if (old + 1u == (gen + 1u) * nloc) {
            __builtin_amdgcn_fence(__ATOMIC_RELEASE, "agent");
            asm volatile("s_waitcnt vmcnt(0)" ::: "memory");
            const unsigned og = xb_add(&bar[XB_TOP], 1u);
            const unsigned tg = og / nx;
            if (og + 1u == (tg + 1u) * nx) xb_add(&bar[XB_TOPGEN], 1u);
            else XB_SPIN(xb_ld(&bar[XB_TOPGEN]) == tg, bar);
            __builtin_amdgcn_fence(__ATOMIC_ACQUIRE, "agent");
            xb_add(&bar[XB_XGEN(b.x)], 1u);
            asm volatile("s_waitcnt vmcnt(0)" ::: "memory");
        } else {
            XB_SPIN(xb_ld(&bar[XB_XGEN(b.x)]) == gen, bar);
            __builtin_amdgcn_fence(__ATOMIC_ACQUIRE, "agent");
            asm volatile("s_waitcnt vmcnt(0)" ::: "memory");
        }
    }
    __syncthreads();
}

template <int LO, int HI> __device__ __forceinline__ void fwd_body(const Args& A) {
    extern __shared__ __attribute__((aligned(16))) unsigned char lds_raw[];
    LAS unsigned char* lds = (LAS unsigned char*)lds_raw;
    const int tid = threadIdx.x, lane = tid & 63, wave = __builtin_amdgcn_readfirstlane(tid >> 6);
    const int G = gridDim.x, bx = blockIdx.x, vcu = (G % 8 == 0) ? (bx % 8) * (G / 8) + bx / 8 : bx;
    unsigned char* ws = A.ws;
#define IN(k) (LO <= (k) && (k) < HI)
    volatile LAS unsigned* bst = (volatile LAS unsigned*)(lds + LDS_PHASE);
    if (tid == 0) { bst[0] = 0u; bst[1] = 0u; }
    __syncthreads();
    XcdBarrier bar; bar.bar = (unsigned*)(ws + WS_BAR); bar.x = 0; bar.st = bst;
    if (HI - LO > 1) bar = xcd_barrier_post((unsigned*)(ws + WS_BAR), bst);
#define SEAM(k) do { if (IN(k) && IN((k) + 1)) { xcd_barrier(bar); } } while (0)
    if (HI - LO > 1) cg::this_grid().sync();
    using namespace pg8;
#ifdef PROBE_P0
    if (IN(0)) { const int nrep = A.ph_hi > 100 ? 1 : 2; for (int rep = 0; rep < nrep; ++rep) { p0_prologue(A, lds, vcu, G, tid, wave, lane); __syncthreads(); if (rep + 1 < nrep) xcd_barrier(bar); } }
#else
    if (IN(0)) { p0_prologue(A, lds, vcu, G, tid, wave, lane); __syncthreads(); }
#endif
    SEAM(0);
    if (IN(1)) { Gemm g{(const bf16_t*)(ws + WS_XN), (const bf16_t*)(ws + WS_WIN), MT, PW, DM}; StaticOrder S; S.init(MT, PW, G, bx, DM);
        EpiStoreBf16<0> E{(bf16_t*)(ws + WS_Z), PW};
        gemm_phase<EpiStoreBf16<0>, StaticOrder, true, true>(lds, g, S, E);
        { const int nfull = (MT / 256) * (PW / 256) - 2 * G;
          if (G == 256 && bx >= nfull) convert_two(A.in[I_WGLU], SWD, SWD, (bf16*)(ws + WS_WGLU), A.in[I_WOUT], DM, DM, (bf16*)(ws + WS_WOUT), lds, bx - nfull, G - nfull, wave, lane, A.in[I_AOG], A.in[I_SOG]);
          else if (G != 256) convert_two(A.in[I_WGLU], SWD, SWD, (bf16*)(ws + WS_WGLU), A.in[I_WOUT], DM, DM, (bf16*)(ws + WS_WOUT), lds, bx, G, wave, lane, A.in[I_AOG], A.in[I_SOG]); } }
    SEAM(1);
    if (IN(2)) {
#ifdef PROBE_P2
      const int nrep2 = A.ph_hi > 100 ? 1 : 2;
      for (int rep = 0; rep < nrep2; ++rep) {
        if (rep) xcd_barrier(bar);
#else
      {
#endif
#ifndef SKIP_AP
        for (int u = vcu; u < 512; u += G) { int t_ = threadIdx.x; asm volatile("" : "+v"(t_)); const int l_ = t_ & 63, w_ = __builtin_amdgcn_readfirstlane(t_ >> 6); attn_prompt_unit(A, lds, u >> 6, (u >> 4) & 3, u & 15, t_, w_, l_); }
#endif
#ifdef DUP_AP
        __syncthreads();
        for (int u = vcu; u < 512; u += G) { int t_ = threadIdx.x; asm volatile("" : "+v"(t_)); const int l_ = t_ & 63, w_ = __builtin_amdgcn_readfirstlane(t_ >> 6); attn_prompt_unit(A, lds, u >> 6, (u >> 4) & 3, u & 15, t_, w_, l_); }
#endif
#ifndef SKIP_SP
        for (int u = vcu; u < 512; u += G) { int t_ = threadIdx.x; asm volatile("" : "+v"(t_)); const int l_ = t_ & 63, w_ = __builtin_amdgcn_readfirstlane(t_ >> 6); ssm_prompt_unit(A, lds, u >> 6, u & 63, t_, w_, l_); }
#endif
#ifdef DUP_SP
        __syncthreads();
        for (int u = vcu; u < 512; u += G) { int t_ = threadIdx.x; asm volatile("" : "+v"(t_)); const int l_ = t_ & 63, w_ = __builtin_amdgcn_readfirstlane(t_ >> 6); ssm_prompt_unit(A, lds, u >> 6, u & 63, t_, w_, l_); }
#endif
#ifndef SKIP_AS
        for (int u = vcu; u < 512; u += G) { int t_ = threadIdx.x; asm volatile("" : "+v"(t_)); const int l_ = t_ & 63, w_ = __builtin_amdgcn_readfirstlane(t_ >> 6); attn_sample_unit(A, lds, u >> 2, u & 3, t_, w_, l_); }
#endif
#ifdef DUP_AS
        __syncthreads();
        for (int u = vcu; u < 512; u += G) { int t_ = threadIdx.x; asm volatile("" : "+v"(t_)); const int l_ = t_ & 63, w_ = __builtin_amdgcn_readfirstlane(t_ >> 6); attn_sample_unit(A, lds, u >> 2, u & 3, t_, w_, l_); }
#endif
#ifndef SKIP_SS
        { int t_ = threadIdx.x; asm volatile("" : "+v"(t_)); const int l_ = t_ & 63, w_ = __builtin_amdgcn_readfirstlane(t_ >> 6);
          if ((G * NWAVES) % 64 == 0) ssm_sample_wave(A, lds, vcu * NWAVES + w_, G * NWAVES, w_, l_); }
#endif
#ifdef DUP_SS
        __syncthreads();
        { int t_ = threadIdx.x; asm volatile("" : "+v"(t_)); const int l_ = t_ & 63, w_ = __builtin_amdgcn_readfirstlane(t_ >> 6);
          if ((G * NWAVES) % 64 == 0) ssm_sample_wave(A, lds, vcu * NWAVES + w_, G * NWAVES, w_, l_); }
#endif
        __syncthreads();
      }
    }
    SEAM(2);
    if (IN(3)) { Gemm g{(const bf16_t*)(ws + WS_G), (const bf16_t*)(ws + WS_WGLU), MT, SWD, SWD}; StaticOrder S; S.init(MT, SWD, G, bx, SWD);
        EpiGlu E{(const bf16_t*)(ws + WS_G), (bf16_t*)(ws + WS_MIX), A.in[I_BGLU], (float*)(ws + WS_SSS)};
        gemm_phase<EpiGlu, StaticOrder, true, true>(lds, g, S, E); }
    SEAM(3);
    if (IN(5)) { Gemm g{(const bf16_t*)(ws + WS_MIX), (const bf16_t*)(ws + WS_WOUT), MT, DM, DM}; StaticOrder S; S.init(MT, DM, G, bx, DM);
        EpiHres E{A.in[I_XP], A.in[I_XS], A.out + O_Y, (bf16_t*)(ws + WS_HG), A.in[I_MNG], (float*)(ws + WS_CTL), (const float*)(ws + WS_SSA), (const float*)(ws + WS_SSS)};
        gemm_phase<EpiHres, StaticOrder, true, true>(lds, g, S, E);
        { const int nfull = (MT / 256) * (DM / 256) - 2 * G;
          if (G == 256 && bx >= nfull) convert_two(A.in[I_WUP], DM, FF, (bf16*)(ws + WS_WUP), A.in[I_WDN], FF, DM, (bf16*)(ws + WS_WDN), lds, bx - nfull, G - nfull, wave, lane);
          else if (G != 256) convert_two(A.in[I_WUP], DM, FF, (bf16*)(ws + WS_WUP), A.in[I_WDN], FF, DM, (bf16*)(ws + WS_WDN), lds, bx, G, wave, lane); } }
    SEAM(5);
    if (IN(6)) { Gemm g{(const bf16_t*)(ws + WS_HG), (const bf16_t*)(ws + WS_WUP), MT, FF, DM}; StaticOrder S; S.init(MT, FF, G, bx, DM);
        EpiStoreBf16<2> E{(bf16_t*)(ws + WS_ACT), FF};
        gemm_phase<EpiStoreBf16<2>, StaticOrder, true, true>(lds, g, S, E); }
    SEAM(6);
    if (IN(7)) { Gemm g{(const bf16_t*)(ws + WS_ACT), (const bf16_t*)(ws + WS_WDN), MT, DM, FF};
        { StaticOrder S; S.init(MP, DM, G, bx, FF); EpiDown E{A.out + O_Y, (const float*)(ws + WS_CTL)};
          gemm_phase<EpiDown, StaticOrder, true, true>(lds, g, S, E); }
        { SampleSplitOrder<8, 16, 128> S; S.init(G, bx); EpiPartial E{(float*)(ws + WS_PART), 512};
          gemm_phase<EpiPartial, SampleSplitOrder<8, 16, 128>, true, true>(lds, g, S, E); } }
    SEAM(7);
    if (IN(8)) {
        const float* P = (const float*)(ws + WS_PART); const float* rowss = (const float*)(ws + WS_CTL); float* Y = A.out + O_Y + (size_t)MP * DM;
        for (int idx = vcu * NTHR + tid; idx < 512 * 512; idx += G * NTHR) {
            const int row = idx >> 9, c4 = idx & 511;
            f32x4 s = f32x4{0.f, 0.f, 0.f, 0.f};
#pragma unroll
            for (int k = 0; k < 16; ++k) s += ((const f32x4*)(P + (size_t)k * (512 * 2048)))[idx];
            const float ssr = __hip_atomic_load(rowss + MP + row, __ATOMIC_RELAXED, __HIP_MEMORY_SCOPE_AGENT);
            const float r2 = 1.0f / (ssr * (1.0f / 2048.0f) + 1e-6f);
            f32x4* y = (f32x4*)(Y + (size_t)row * DM) + c4; *y = *y + s * r2;
        }
    }
#undef IN
#undef SEAM
}
template <int LO, int HI> __global__ void __launch_bounds__(NTHR, 2) fwd_t(Args A) { fwd_body<LO, HI>(A); }

extern "C" void kernel_launch(void* const* d_in, const int* in_sizes, int n_in, void* d_out, int out_size, void* d_ws, size_t ws_size, hipStream_t stream) {
    static int grid = 0;
    if (grid == 0) {
        if (n_in != 27 || out_size != (int)O_END || ws_size < WS_END) { fprintf(stderr, "kernel_launch: unexpected shapes: n_in %d out %d ws %zu (need %zu)\n", n_in, out_size, ws_size, (size_t)WS_END); grid = -1; return; }
        int dev = 0, cus = 0, per_cu = 0;
        if (hipGetDevice(&dev) != hipSuccess || hipDeviceGetAttribute(&cus, hipDeviceAttributeMultiprocessorCount, dev) != hipSuccess) { grid = -1; return; }
#if MK_PER_PHASE
        const void* fns[NPHASE] = {(const void*)fwd_t<0, 1>, (const void*)fwd_t<1, 2>, (const void*)fwd_t<2, 3>, (const void*)fwd_t<3, 4>, (const void*)fwd_t<4, 5>, (const void*)fwd_t<5, 6>, (const void*)fwd_t<6, 7>, (const void*)fwd_t<7, 8>, (const void*)fwd_t<8, 9>};
        for (int i = 0; i < NPHASE; ++i) if (hipFuncSetAttribute(fns[i], hipFuncAttributeMaxDynamicSharedMemorySize, LDS_BYTES) != hipSuccess) { fprintf(stderr, "kernel_launch: hipFuncSetAttribute failed\n"); grid = -1; return; }
#else
        if (hipFuncSetAttribute((const void*)fwd_t<0, NPHASE>, hipFuncAttributeMaxDynamicSharedMemorySize, LDS_BYTES) != hipSuccess) { fprintf(stderr, "kernel_launch: hipFuncSetAttribute failed\n"); grid = -1; return; }
        if (hipOccupancyMaxActiveBlocksPerMultiprocessor(&per_cu, (const void*)fwd_t<0, NPHASE>, NTHR, LDS_BYTES) != hipSuccess || per_cu < 1) { fprintf(stderr, "kernel_launch: occupancy query says %d\n", per_cu); per_cu = 1; }
#endif
        (void)hipGetLastError();
        grid = cus;
    }
    if (grid < 0) return;
    (void)hipMemsetAsync((char*)d_ws + WS_CTL, 0, CTL_ZERO_BYTES, stream);
    Args a{};
    for (int i = 0; i < 27; ++i) a.in[i] = (const float*)d_in[i];
    a.out = (float*)d_out; a.ws = (unsigned char*)d_ws;
#if MK_PER_PHASE
    hipLaunchKernelGGL((fwd_t<0, 1>), dim3(grid), dim3(NTHR), LDS_BYTES, stream, a);
#if defined(DUP_PHASE)
    if (DUP_PHASE == 0) hipLaunchKernelGGL((fwd_t<0, 1>), dim3(grid), dim3(NTHR), LDS_BYTES, stream, a);
#endif
    hipLaunchKernelGGL((fwd_t<1, 2>), dim3(grid), dim3(NTHR), LDS_BYTES, stream, a);
#if defined(DUP_PHASE)
    if (DUP_PHASE == 1) hipLaunchKernelGGL((fwd_t<1, 2>), dim3(grid), dim3(NTHR), LDS_BYTES, stream, a);
#endif
    hipLaunchKernelGGL((fwd_t<2, 3>), dim3(grid), dim3(NTHR), LDS_BYTES, stream, a);
#if defined(DUP_PHASE)
    if (DUP_PHASE == 2) hipLaunchKernelGGL((fwd_t<2, 3>), dim3(grid), dim3(NTHR), LDS_BYTES, stream, a);
#endif
    hipLaunchKernelGGL((fwd_t<3, 4>), dim3(grid), dim3(NTHR), LDS_BYTES, stream, a);
#if defined(DUP_PHASE)
    if (DUP_PHASE == 3) hipLaunchKernelGGL((fwd_t<3, 4>), dim3(grid), dim3(NTHR), LDS_BYTES, stream, a);
#endif
    hipLaunchKernelGGL((fwd_t<4, 5>), dim3(grid), dim3(NTHR), LDS_BYTES, stream, a);
#if defined(DUP_PHASE)
    if (DUP_PHASE == 4) hipLaunchKernelGGL((fwd_t<4, 5>), dim3(grid), dim3(NTHR), LDS_BYTES, stream, a);
#endif
    hipLaunchKernelGGL((fwd_t<5, 6>), dim3(grid), dim3(NTHR), LDS_BYTES, stream, a);
#if defined(DUP_PHASE)
    if (DUP_PHASE == 5) hipLaunchKernelGGL((fwd_t<5, 6>), dim3(grid), dim3(NTHR), LDS_BYTES, stream, a);
#endif
    hipLaunchKernelGGL((fwd_t<6, 7>), dim3(grid), dim3(NTHR), LDS_BYTES, stream, a);
#if defined(DUP_PHASE)
    if (DUP_PHASE == 6) hipLaunchKernelGGL((fwd_t<6, 7>), dim3(grid), dim3(NTHR), LDS_BYTES, stream, a);
#endif
    hipLaunchKernelGGL((fwd_t<7, 8>), dim3(grid), dim3(NTHR), LDS_BYTES, stream, a);
#if defined(DUP_PHASE)
    if (DUP_PHASE == 7) hipLaunchKernelGGL((fwd_t<7, 8>), dim3(grid), dim3(NTHR), LDS_BYTES, stream, a);
#endif
    hipLaunchKernelGGL((fwd_t<8, 9>), dim3(grid), dim3(NTHR), LDS_BYTES, stream, a);
#if defined(DUP_PHASE)
    if (DUP_PHASE == 8) hipLaunchKernelGGL((fwd_t<8, 9>), dim3(grid), dim3(NTHR), LDS_BYTES, stream, a);
#endif
#else
    a.ph_lo = 0; a.ph_hi = NPHASE;
    void* kargs[] = {&a};
    hipError_t e = hipLaunchCooperativeKernel((const void*)fwd_t<0, NPHASE>, dim3(grid), dim3(NTHR), kargs, LDS_BYTES, stream);
    if (e != hipSuccess) fprintf(stderr, "cooperative launch failed: %s (grid %d)\n", hipGetErrorString(e), grid);
#endif
}
```

```cpp
#ifndef MK_PER_PHASE
#define MK_PER_PHASE 0
#endif
#include <hip/hip_runtime.h>
#include <hip/hip_cooperative_groups.h>
#include <cstdio>
#include <cstdint>
namespace cg = cooperative_groups;
namespace pg8 {
#define PG8_LAS __attribute__((address_space(3)))
typedef unsigned short bf16_t;
typedef short bf16x8 __attribute__((ext_vector_type(8)));
typedef float f32x4 __attribute__((ext_vector_type(4)));
typedef unsigned u32x4 __attribute__((ext_vector_type(4)));
constexpr int BM = 256, BK = 64, HALF = 128, HTB = HALF * BK * 2  , STAGE_BYTES = 8 * HTB, NXCD = 8, WGM = 8;

__host__ __device__ __forceinline__ int lds_byte(int r, int c) { const int st = (r >> 4) * 2 + (c >> 5), rr = r & 15, cc = c & 31, ob = rr * 64 + cc * 2; return st * 1024 + (ob ^ (((ob >> 9) & 1) << 5)); }
__host__ __device__ __forceinline__ void stage_rc(int b, int& R, int& C) { const int st = b / 1024, sb = b % 1024, swz = sb ^ (((sb >> 9) & 1) << 5); R = (st >> 1) * 16 + swz / 64; C = (st & 1) * 32 + (swz % 64) / 2; }
__host__ __device__ __forceinline__ int perm32(int rho) { const int n = rho >> 4, i = rho & 15; return 8 * (i >> 2) + 4 * n + (i & 3); }

struct Unit { int pm, pn, k0, nt, cont; };
struct Gemm { const bf16_t* A; const bf16_t* Bt; int M, N, K; };

struct StaticOrder {
    int nM, nN, nwg, G, c, ntk;
    __host__ __device__ void init(int M, int N, int G_, int c_, int K) { nM = M / BM; nN = N / BM; nwg = nM * nN; G = G_; c = c_; ntk = K / BK; }
    __host__ __device__ bool next(int i, Unit& u) const {
        const long L = (long)i * G + c; if (L >= nwg) return false;
        int wgid = (int)L; { const int q = nwg / NXCD, r = nwg % NXCD, xcd = wgid % NXCD, off = wgid / NXCD; wgid = (xcd < r ? xcd * (q + 1) : r * (q + 1) + (xcd - r) * q) + off; }
        const int nig = WGM * nN, gid = wgid / nig, fm = gid * WGM, gsz = (nM - fm) < WGM ? (nM - fm) : WGM;
        u.pm = fm + ((wgid % nig) % gsz); u.pn = (wgid % nig) / gsz; u.k0 = 0; u.nt = ntk; u.cont = 0; return true;
    }
    __device__ __forceinline__ void a_ready(const Unit&) const {}
    __device__ __forceinline__ void done(const Unit&) const {}
};

__device__ __forceinline__ unsigned cvt_pk_bf16(float lo, float hi) { unsigned r; asm volatile("v_cvt_pk_bf16_f32 %0, %1, %2" : "=v"(r) : "v"(lo), "v"(hi)); return r; }
typedef float f32x2 __attribute__((ext_vector_type(2)));
__device__ __forceinline__ float bf_lo(unsigned w) { return __uint_as_float(w << 16); }
__device__ __forceinline__ float bf_hi(unsigned w) { return __uint_as_float(w & 0xffff0000u); }
template <int ACT> struct EpiStoreBf16 {
    static constexpr bool PERM = true, AFTER_DRAIN = false, MIDK = false;
    bf16_t* O; int ldc;
    __device__ __forceinline__ void operator()(const f32x4 (&acc)[2][2][4][2], const Unit& u, int wr, int wc, int fr, int fq) const {
        const int row0 = u.pm * BM + wr * 64 + fr; const int col0 = u.pn * BM + wc * 32 + 8 * fq;
#pragma unroll
        for (int ai = 0; ai < 2; ++ai)
#pragma unroll
            for (int m = 0; m < 4; ++m) { bf16_t* rowp = O + (size_t)(row0 + ai * HALF + m * 16) * ldc + col0;
#pragma unroll
                for (int bj = 0; bj < 2; ++bj) { f32x4 v0 = acc[ai][bj][m][0], v1 = acc[ai][bj][m][1];
                    if (ACT == 2) {
#pragma unroll
                        for (int i = 0; i < 4; ++i) { const float a = fmaxf(v0[i], 0.f), b = fmaxf(v1[i], 0.f); v0[i] = a * a; v1[i] = b * b; } }
                    u32x4 w; w.x = cvt_pk_bf16(v0[0], v0[1]); w.y = cvt_pk_bf16(v0[2], v0[3]); w.z = cvt_pk_bf16(v1[0], v1[1]); w.w = cvt_pk_bf16(v1[2], v1[3]);
                    *(u32x4*)(rowp + bj * HALF) = w; } }
    }
};
struct EpiGlu {
    static constexpr bool PERM = true, AFTER_DRAIN = false, MIDK = false;
    const bf16_t* Gm; bf16_t* O; const float* bias; float* rowss;
    __device__ __forceinline__ void operator()(const f32x4 (&acc)[2][2][4][2], const Unit& u, int wr, int wc, int fr, int fq) const {
        const int row0 = u.pm * BM + wr * 64 + fr; const int col0 = u.pn * BM + wc * 32 + 8 * fq;
        float ssq[8];
#pragma unroll
        for (int i = 0; i < 8; ++i) ssq[i] = 0.f;
#pragma unroll
        for (int bj = 0; bj < 2; ++bj) { const f32x4 b0 = *(const f32x4*)(bias + col0 + bj * HALF), b1 = *(const f32x4*)(bias + col0 + bj * HALF + 4);
#pragma unroll
            for (int ai = 0; ai < 2; ++ai)
#pragma unroll
                for (int m = 0; m < 4; ++m) { const size_t row = (size_t)(row0 + ai * HALF + m * 16); const int col = col0 + bj * HALF;
                    const u32x4 gw = *(const u32x4*)(Gm + row * 1024 + col);
                    const f32x4 a0 = acc[ai][bj][m][0] + b0, a1 = acc[ai][bj][m][1] + b1;
                    float g[8] = {bf_lo(gw.x), bf_hi(gw.x), bf_lo(gw.y), bf_hi(gw.y), bf_lo(gw.z), bf_hi(gw.z), bf_lo(gw.w), bf_hi(gw.w)};
                    float o[8]; float sq = 0.f;
#pragma unroll
                    for (int i = 0; i < 4; ++i) { o[i] = g[i] / (1.f + __expf(-a0[i])); o[4 + i] = g[4 + i] / (1.f + __expf(-a1[i])); }
#pragma unroll
                    for (int i = 0; i < 8; ++i) sq += o[i] * o[i];
                    ssq[ai * 4 + m] += sq;
                    u32x4 w; w.x = cvt_pk_bf16(o[0], o[1]); w.y = cvt_pk_bf16(o[2], o[3]); w.z = cvt_pk_bf16(o[4], o[5]); w.w = cvt_pk_bf16(o[6], o[7]);
                    *(u32x4*)(O + row * 2048 + 1024 + col) = w; } }
#pragma unroll
        for (int ai = 0; ai < 2; ++ai)
#pragma unroll
            for (int m = 0; m < 4; ++m) { float v = ssq[ai * 4 + m]; v += __shfl_xor(v, 16); v += __shfl_xor(v, 32);
                if (fq == 0) unsafeAtomicAdd(rowss + row0 + ai * HALF + m * 16, v); }
    }
};
struct EpiHres {
    static constexpr bool PERM = false, AFTER_DRAIN = false, MIDK = true;
    const float* xp; const float* xs; float* Y; bf16_t* HG; const float* gm; float* rowss; const float* ssa; const float* sss;
    __device__ __forceinline__ float rnorm(const float* p, int row) const { return rsqrtf(__hip_atomic_load(p + row, __ATOMIC_RELAXED, __HIP_MEMORY_SCOPE_AGENT) * (1.0f / 1024.0f) + 1e-6f); }
    __device__ __forceinline__ void midk(f32x4 (&acc)[2][2][4][2], const Unit& u, int wr, int fr) const {
        int br = u.pm * BM + wr * 64 + fr; asm volatile("" : "+v"(br) :: "memory");
        const float* pa = ssa + br; const float* ps = sss + br;
#pragma unroll
        for (int ai = 0; ai < 2; ++ai)
#pragma unroll
            for (int m = 0; m < 4; ++m) { const int o = ai * HALF + m * 16;
                const float va = __hip_atomic_load(pa + o, __ATOMIC_RELAXED, __HIP_MEMORY_SCOPE_AGENT), vs = __hip_atomic_load(ps + o, __ATOMIC_RELAXED, __HIP_MEMORY_SCOPE_AGENT);
                const float ratio = rsqrtf(va * (1.0f / 1024.0f) + 1e-6f) * sqrtf(vs * (1.0f / 1024.0f) + 1e-6f);
#pragma unroll
                for (int bj = 0; bj < 2; ++bj)
#pragma unroll
                    for (int n = 0; n < 2; ++n) acc[ai][bj][m][n] *= ratio; }
    }
    __device__ __forceinline__ void operator()(const f32x4 (&acc)[2][2][4][2], const Unit& u, int wr, int wc, int fr, int fq) const {
        typedef unsigned u32x2v __attribute__((ext_vector_type(2)));
        const int colb = u.pn * BM + wc * 32 + 4 * fq;
#pragma unroll
        for (int ai = 0; ai < 2; ++ai)
#pragma unroll
            for (int m = 0; m < 4; ++m) { const int row = u.pm * BM + ai * HALF + wr * 64 + m * 16 + fr;
                const float* xrow = row < 16384 ? xp + (size_t)row * 2048 : xs + (size_t)(row - 16384) * 2048;
                const float rs = rnorm(sss, row);
                float ss = 0.f;
#pragma unroll
                for (int bj = 0; bj < 2; ++bj)
#pragma unroll
                    for (int n = 0; n < 2; ++n) { const int col = colb + bj * HALF + n * 16;
                        const f32x4 xv = *(const f32x4*)(xrow + col); const f32x4 gv = *(const f32x4*)(gm + col);
                        const f32x4 h = xv + acc[ai][bj][m][n] * rs;
                        ss += (h[0] * h[0] + h[1] * h[1]) + (h[2] * h[2] + h[3] * h[3]);
                        u32x2v w; w.x = cvt_pk_bf16(h[0] * gv[0], h[1] * gv[1]); w.y = cvt_pk_bf16(h[2] * gv[2], h[3] * gv[3]);
                        *(u32x2v*)(HG + (size_t)row * 2048 + col) = w; }
                ss += __shfl_xor(ss, 16); ss += __shfl_xor(ss, 32);
                if (fq == 0) unsafeAtomicAdd(rowss + row, ss);
                asm volatile("" ::: "memory"); }
    }
};
struct EpiDown {
    static constexpr bool PERM = false, AFTER_DRAIN = false, MIDK = false;
    float* Y; const float* rowss; const bf16_t* HG; const float* gm;
    __device__ __forceinline__ void operator()(const f32x4 (&acc)[2][2][4][2], const Unit& u, int wr, int wc, int fr, int fq) const {
        typedef unsigned u32x2v __attribute__((ext_vector_type(2)));
        const int colb = u.pn * BM + wc * 32 + 4 * fq;
        f32x4 gi[2][2];
#pragma unroll
        for (int bj = 0; bj < 2; ++bj)
#pragma unroll
            for (int n = 0; n < 2; ++n) { const f32x4 gv = *(const f32x4*)(gm + colb + bj * HALF + n * 16);
                gi[bj][n] = f32x4{__builtin_amdgcn_rcpf(gv[0]), __builtin_amdgcn_rcpf(gv[1]), __builtin_amdgcn_rcpf(gv[2]), __builtin_amdgcn_rcpf(gv[3])}; }
#pragma unroll
        for (int ai = 0; ai < 2; ++ai)
#pragma unroll
            for (int m = 0; m < 4; ++m) { const int row = u.pm * BM + ai * HALF + wr * 64 + m * 16 + fr;
                const float ssr = __hip_atomic_load(rowss + row, __ATOMIC_RELAXED, __HIP_MEMORY_SCOPE_AGENT);
                const float r2 = 1.0f / (ssr * (1.0f / 2048.0f) + 1e-6f);
#pragma unroll
                for (int bj = 0; bj < 2; ++bj)
#pragma unroll
                    for (int n = 0; n < 2; ++n) { const size_t off = (size_t)row * 2048 + colb + bj * HALF + n * 16;
                        const u32x2v hw = *(const u32x2v*)(HG + off);
                        const f32x4 h = f32x4{bf_lo(hw.x), bf_hi(hw.x), bf_lo(hw.y), bf_hi(hw.y)} * gi[bj][n];
                        *(f32x4*)(Y + off) = h + acc[ai][bj][m][n] * r2; } }
    }
};
struct EpiPartial {
    static constexpr bool PERM = false, AFTER_DRAIN = false, MIDK = false;
    float* P; int kper;
    __device__ __forceinline__ void operator()(const f32x4 (&acc)[2][2][4][2], const Unit& u, int wr, int wc, int fr, int fq) const {
        const int colb = u.pn * BM + wc * 32 + 4 * fq; float* base = P + (size_t)(u.k0 / kper) * (512 * 2048);
#pragma unroll
        for (int ai = 0; ai < 2; ++ai)
#pragma unroll
            for (int m = 0; m < 4; ++m) { const int row = (u.pm - 64) * BM + ai * HALF + wr * 64 + m * 16 + fr;
#pragma unroll
                for (int bj = 0; bj < 2; ++bj)
#pragma unroll
                    for (int n = 0; n < 2; ++n) *(f32x4*)(base + (size_t)row * 2048 + colb + bj * HALF + n * 16) = acc[ai][bj][m][n]; }
    }
};
template <int NN  , int NS  , int NTK  > struct SampleSplitOrder {
    int G, c;
    __device__ __forceinline__ void init(int G_, int c_) { G = G_; c = c_; }
    __device__ __forceinline__ bool next(int i, Unit& u) const {
        const int item = i * G + c; if (item >= 2 * NN * NS) return false;
        const int t = item / NS, s = item % NS; u.pm = 64 + t / NN; u.pn = t % NN; u.nt = NTK / NS; u.k0 = s * (NTK / NS) * BK; u.cont = 0; return true;
    }
    __device__ __forceinline__ void a_ready(const Unit&) const {}
    __device__ __forceinline__ void done(const Unit&) const {}
};

struct HalfKOrder {
    StaticOrder base;
    __device__ __forceinline__ void init(int M, int N, int G_, int c_, int K) { base.init(M, N, G_, c_, K); }
    __device__ __forceinline__ bool next(int i, Unit& u) const {
        if (!base.next(i >> 1, u)) return false;
        u.nt = base.ntk >> 1; u.k0 = (i & 1) * u.nt * BK; u.cont = (i & 1) ^ 1; return true;
    }
    __device__ __forceinline__ void a_ready(const Unit&) const {}
    __device__ __forceinline__ void done(const Unit&) const {}
};

template <class Epi, class Sched, bool ALIGN_EPI = false, bool SP2 = false>
__device__ __forceinline__ void gemm_phase(PG8_LAS unsigned char* lds, const Gemm g, const Sched& S, const Epi& E) {
    int tid_ = threadIdx.x; asm volatile("" : "+v"(tid_));
    const int tid = tid_, wid = __builtin_amdgcn_readfirstlane(tid >> 6), lane = tid & 63, wr = wid >> 2, wc = wid & 3, fr = lane & 15, fq = lane >> 4;
    const int K = g.K; int nt;
    unsigned voffA[2], voffB[2];
#pragma unroll
    for (int i = 0; i < 2; ++i) { int R, C; stage_rc(tid * 16 + i * 8192, R, C); const int Rb = Epi::PERM ? ((R & ~31) + perm32(R & 31)) : R;
        voffA[i] = (unsigned)(R * K + C) * 2u; voffB[i] = (unsigned)(Rb * K + C) * 2u; }
    const size_t kstep = (size_t)(BK * 2);
    const size_t hstep = (size_t)HALF * K * 2;
    const size_t tstep = 2 * hstep;
    const unsigned ldsw = (unsigned)wid * 1024u;
    const int aoff = lds_byte(wr * 64 + fr, fq * 8), boff = lds_byte(wc * 32 + fr, fq * 8);
#define PG8_SA(b, h) (((b) * 2 + (h)) * HTB)
#define PG8_SB(b, h) ((4 + (b) * 2 + (h)) * HTB)
#define PG8_STAGE(bufoff, gbase, voff) do { _Pragma("unroll") for (int _i = 0; _i < 2; ++_i) \
        __builtin_amdgcn_global_load_lds((const unsigned*)((const char*)(gbase) + (voff)[_i]), (PG8_LAS unsigned*)(lds + (bufoff) + ldsw + _i * 8192), 16, 0, 0); } while (0)
#define PG8_LDA(dst, b, h) do { _Pragma("unroll") for (int m = 0; m < 4; ++m) _Pragma("unroll") for (int k = 0; k < 2; ++k) dst[m][k] = *(const PG8_LAS bf16x8*)(lds + PG8_SA(b, h) + aoff + m * 2048 + k * 1024); } while (0)
#define PG8_LDB(dst, b, h) do { _Pragma("unroll") for (int n = 0; n < 2; ++n) _Pragma("unroll") for (int k = 0; k < 2; ++k) dst[n][k] = *(const PG8_LAS bf16x8*)(lds + PG8_SB(b, h) + boff + n * 2048 + k * 1024); } while (0)
#define PG8_MMA(ai, bj, At, Bt) do { __builtin_amdgcn_s_setprio(1); _Pragma("unroll") for (int m = 0; m < 4; ++m) _Pragma("unroll") for (int n = 0; n < 2; ++n) _Pragma("unroll") for (int k = 0; k < 2; ++k) \
        acc[ai][bj][m][n] = __builtin_amdgcn_mfma_f32_16x16x32_bf16(Bt[n][k], At[m][k], acc[ai][bj][m][n], 0, 0, 0); __builtin_amdgcn_s_setprio(0); } while (0)
#define PG8_WAIT_V(n) asm volatile("s_waitcnt vmcnt(" #n ")" ::: "memory")
#define PG8_WAIT_L(n) asm volatile("s_waitcnt lgkmcnt(" #n ")" ::: "memory")
#define PG8_BAR __builtin_amdgcn_s_barrier()
#define PG8_SCHED __builtin_amdgcn_sched_barrier(0)
    Unit cur, nxt; int ui = 0;
    if (!S.next(0, cur)) return;
    nt = cur.nt;
    f32x4 acc[2][2][4][2];
#pragma unroll
    for (int a = 0; a < 2; ++a)
#pragma unroll
        for (int b = 0; b < 2; ++b)
#pragma unroll
            for (int m = 0; m < 4; ++m)
#pragma unroll
                for (int n = 0; n < 2; ++n) acc[a][b][m][n] = (f32x4){0.f, 0.f, 0.f, 0.f};
    bf16x8 At[4][2], B0[2][2], B1[2][2];
    const char* cA = (const char*)g.A + (size_t)cur.pm * tstep + (size_t)cur.k0 * 2; const char* cB = (const char*)g.Bt + (size_t)cur.pn * tstep + (size_t)cur.k0 * 2;
    S.a_ready(cur);
    if constexpr (SP2) {
        PG8_STAGE(PG8_SB(0, 0), cB, voffB); PG8_STAGE(PG8_SB(0, 1), cB + hstep, voffB); PG8_STAGE(PG8_SA(0, 0), cA, voffA); PG8_STAGE(PG8_SA(0, 1), cA + hstep, voffA);
        if (wr == 1) PG8_BAR;
        PG8_WAIT_V(2); PG8_BAR;
        PG8_STAGE(PG8_SB(1, 0), cB + kstep, voffB); PG8_STAGE(PG8_SA(1, 0), cA + kstep, voffA); PG8_STAGE(PG8_SB(1, 1), cB + hstep + kstep, voffB);
        PG8_WAIT_V(6); PG8_BAR;
    } else {
        PG8_STAGE(PG8_SB(0, 0), cB, voffB); PG8_STAGE(PG8_SA(0, 0), cA, voffA); PG8_STAGE(PG8_SB(0, 1), cB + hstep, voffB); PG8_STAGE(PG8_SA(0, 1), cA + hstep, voffA);
        if (wr == 1) PG8_BAR;
        PG8_WAIT_V(4); PG8_BAR;
        PG8_STAGE(PG8_SB(1, 0), cB + kstep, voffB); PG8_STAGE(PG8_SA(1, 0), cA + kstep, voffA); PG8_STAGE(PG8_SB(1, 1), cB + hstep + kstep, voffB);
        PG8_WAIT_V(6); PG8_BAR;
    }
    for (;;) {
        const bool has_next = S.next(ui + 1, nxt);
        const char* nA = has_next ? (const char*)g.A + (size_t)nxt.pm * tstep + (size_t)nxt.k0 * 2 : cA; const char* nB = has_next ? (const char*)g.Bt + (size_t)nxt.pn * tstep + (size_t)nxt.k0 * 2 : cB;
        for (int t = 0; t < nt; t += 2) {
            if constexpr (Epi::MIDK) { if (t == (nt >> 1)) E.midk(acc, cur, wr, fr); }
            const bool last = (t == nt - 2);
            const char* a1 = cA + (size_t)(t + 1) * kstep;
            const char* a2 = last ? nA : cA + (size_t)(t + 2) * kstep; const char* b2 = last ? nB : cB + (size_t)(t + 2) * kstep;
            const char* a3 = a2 + kstep; const char* b3 = b2 + kstep;
            if (last && has_next) S.a_ready(nxt);
            if constexpr (SP2) {
            PG8_LDB(B0, 0, 0); PG8_LDB(B1, 0, 1); PG8_SCHED; PG8_LDA(At, 0, 0); PG8_STAGE(PG8_SA(1, 1), a1 + hstep, voffA);
            PG8_WAIT_V(8); PG8_WAIT_L(0); PG8_BAR; PG8_MMA(0, 0, At, B0); PG8_MMA(0, 1, At, B1); PG8_BAR; PG8_SCHED;
            PG8_LDA(At, 0, 1); PG8_STAGE(PG8_SB(0, 0), b2, voffB); PG8_STAGE(PG8_SB(0, 1), b2 + hstep, voffB); PG8_STAGE(PG8_SA(0, 0), a2, voffA);
            PG8_WAIT_V(8); PG8_WAIT_L(0); PG8_BAR; PG8_MMA(1, 0, At, B0); PG8_MMA(1, 1, At, B1); PG8_BAR; PG8_SCHED;
            PG8_LDB(B0, 1, 0); PG8_LDB(B1, 1, 1); PG8_SCHED; PG8_LDA(At, 1, 0); PG8_STAGE(PG8_SA(0, 1), a2 + hstep, voffA);
            PG8_WAIT_V(8); PG8_WAIT_L(0); PG8_BAR; PG8_MMA(0, 0, At, B0); PG8_MMA(0, 1, At, B1); PG8_BAR; PG8_SCHED;
            PG8_LDA(At, 1, 1); PG8_STAGE(PG8_SB(1, 0), b3, voffB); PG8_STAGE(PG8_SB(1, 1), b3 + hstep, voffB); PG8_STAGE(PG8_SA(1, 0), a3, voffA);
            PG8_WAIT_V(8); PG8_WAIT_L(0); PG8_BAR; PG8_MMA(1, 0, At, B0); PG8_MMA(1, 1, At, B1); PG8_BAR; PG8_SCHED;
            } else {
            PG8_LDB(B0, 0, 0); PG8_SCHED; PG8_LDA(At, 0, 0); PG8_STAGE(PG8_SA(1, 1), a1 + hstep, voffA);
            PG8_WAIT_L(8); PG8_BAR; PG8_WAIT_L(0); PG8_MMA(0, 0, At, B0); PG8_BAR; PG8_SCHED;
            PG8_LDB(B1, 0, 1); PG8_STAGE(PG8_SB(0, 0), b2, voffB);
            PG8_BAR; PG8_WAIT_L(0); PG8_MMA(0, 1, At, B1); PG8_BAR;
            PG8_LDA(At, 0, 1); PG8_STAGE(PG8_SA(0, 0), a2, voffA);
            PG8_BAR; PG8_WAIT_L(0); PG8_MMA(1, 0, At, B0); PG8_BAR; PG8_SCHED;
            PG8_STAGE(PG8_SB(0, 1), b2 + hstep, voffB);
            PG8_WAIT_V(6); PG8_BAR; PG8_MMA(1, 1, At, B1); PG8_BAR;
            PG8_LDB(B0, 1, 0); PG8_SCHED; PG8_LDA(At, 1, 0); PG8_STAGE(PG8_SA(0, 1), a2 + hstep, voffA);
            PG8_WAIT_L(8); PG8_BAR; PG8_WAIT_L(0); PG8_MMA(0, 0, At, B0); PG8_BAR; PG8_SCHED;
            PG8_LDB(B1, 1, 1); PG8_STAGE(PG8_SB(1, 0), b3, voffB);
            PG8_BAR; PG8_WAIT_L(0); PG8_MMA(0, 1, At, B1); PG8_BAR;
            PG8_LDA(At, 1, 1); PG8_STAGE(PG8_SA(1, 0), a3, voffA);
            PG8_BAR; PG8_WAIT_L(0); PG8_MMA(1, 0, At, B0); PG8_BAR; PG8_SCHED;
            PG8_STAGE(PG8_SB(1, 1), b3 + hstep, voffB);
            PG8_WAIT_V(6); PG8_BAR; PG8_MMA(1, 1, At, B1); PG8_BAR;
            }
        }
        if constexpr (ALIGN_EPI) { if (wr == 0) PG8_BAR; }
        if constexpr (!Epi::AFTER_DRAIN) { E(acc, cur, wr, wc, fr, fq); S.done(cur); }
        if (!has_next) break;
#pragma unroll
        for (int a = 0; a < 2; ++a)
#pragma unroll
            for (int b = 0; b < 2; ++b)
#pragma unroll
                for (int m = 0; m < 4; ++m)
#pragma unroll
                    for (int n = 0; n < 2; ++n) acc[a][b][m][n] = (f32x4){0.f, 0.f, 0.f, 0.f};
        cur = nxt; cA = nA; cB = nB; ++ui; nt = cur.nt;
        if constexpr (ALIGN_EPI) { if (wr == 1) PG8_BAR; }
    }
    PG8_WAIT_V(0);
    if constexpr (!ALIGN_EPI) { if (wr == 0) PG8_BAR; }
    PG8_BAR;
    if constexpr (Epi::AFTER_DRAIN) { E.fused(acc, cur, wr, wc, fr, fq, lds, wid, lane); S.done(cur); }
#undef PG8_SA
#undef PG8_SB
#undef PG8_STAGE
#undef PG8_LDA
#undef PG8_LDB
#undef PG8_MMA
#undef PG8_WAIT_V
#undef PG8_WAIT_L
#undef PG8_BAR
#undef PG8_SCHED
}
}

#define LAS __attribute__((address_space(3)))
typedef unsigned short bf16;
typedef unsigned v4u __attribute__((ext_vector_type(4)));
typedef unsigned v2u __attribute__((ext_vector_type(2)));
typedef float f32x4 __attribute__((ext_vector_type(4)));
typedef float f32x16 __attribute__((ext_vector_type(16)));
typedef float f32x2 __attribute__((ext_vector_type(2)));
typedef short bf16x8 __attribute__((ext_vector_type(8)));

#ifndef MK_PER_PHASE
#define MK_PER_PHASE 0
#endif
constexpr int NPHASE = 9;
constexpr int NWAVES = 8, NTHR = 512;
constexpr int MP = 16384, MS = 512, MT = MP + MS;
constexpr int DM = 2048, PW = 2560, AW = 1024, SWD = 1024, FF = 8192;
constexpr float EPSN = 1e-6f, LOG2E = 1.4426950408889634f;
constexpr int LDS_PHASE = 152576;
constexpr int LDS_BYTES = LDS_PHASE + 64;

constexpr size_t MiB = 1u << 20;
constexpr size_t WS_CTL = 0, CTL_ZERO_BYTES = 272 * 1024, WS_BAR = 96 * 1024, WS_SSA = 128 * 1024, WS_SSS = 200 * 1024;
constexpr size_t WS_WIN = 1 * MiB, WS_WGLU = 11 * MiB, WS_WOUT = 13 * MiB, WS_WUP = 21 * MiB, WS_WDN = 53 * MiB;
constexpr size_t WS_WSF = 85 * MiB, WS_WHF = 89 * MiB, WS_TF = 93 * MiB, WS_LAM = 94 * MiB + 512 * 1024, WS_LAM16 = WS_LAM + 32768, WS_BBAR = WS_LAM + 65536;
constexpr size_t WS_HG = 96 * MiB;
constexpr size_t WS_PART = 426 * MiB;
constexpr size_t WS_ACT = 162 * MiB;
constexpr size_t WS_XN = 162 * MiB, WS_Z = 228 * MiB, WS_ATT = 311 * MiB, WS_G = 344 * MiB, WS_SO = 377 * MiB, WS_MIX = 410 * MiB, WS_END = 490 * MiB;

constexpr size_t O_Y = 0, O_KP = (size_t)MT * DM, O_VP = O_KP + 262144, O_RP = O_VP + 262144, O_IP = O_RP + 32768, O_KS = O_IP + 32768,
                 O_VS = O_KS + 4194304, O_RS = O_VS + 4194304, O_IS = O_RS + 524288, O_END = O_IS + 524288;

struct Args { const float* in[27]; float* out; unsigned char* ws; int ph_lo, ph_hi; };
enum { I_XP = 0, I_XS, I_CK, I_CV, I_SR, I_SI, I_ANG, I_WIN, I_QG, I_KG, I_SINK, I_ARE, I_AIM, I_LDT, I_BRE, I_BIM, I_CRE, I_CIM, I_D, I_WGLU, I_BGLU,
       I_AOG, I_SOG, I_WOUT, I_MNG, I_WUP, I_WDN };

__device__ __forceinline__ unsigned pk2(float lo, float hi) { unsigned r; asm("v_cvt_pk_bf16_f32 %0, %1, %2" : "=v"(r) : "v"(lo), "v"(hi)); return r; }
__device__ __forceinline__ unsigned f2bf(float f) { return pk2(f, 0.f) & 0xffffu; }
__device__ __forceinline__ float bflo(unsigned w) { return __uint_as_float(w << 16); }
__device__ __forceinline__ float bfhi(unsigned w) { return __uint_as_float(w & 0xffff0000u); }
__device__ __forceinline__ float wave_sum(float v) {
#pragma unroll
    for (int o = 1; o < 64; o <<= 1) v += __shfl_xor(v, o);
    return v;
}
__device__ __forceinline__ int crow(int r, int hi) { return (r & 3) + 8 * (r >> 2) + 4 * hi; }
__device__ __forceinline__ float gelu_tanh(float y) { const float z = 1.5957691216057308f * (y + 0.044715f * y * y * y); return y / (1.f + __expf(-z)); }

__device__ __forceinline__ void p0_transpose_item(const float* W, int K, int N, bf16* WT, LAS float* scr, int item, int lane, const float* g0 = nullptr, const float* g1 = nullptr) {
    const int nblk = N / 32, kb = item / nblk, nb = item % nblk, k0 = 64 * kb, n0 = 32 * nb;
    f32x4 v[8];
#pragma unroll
    for (int i = 0; i < 8; ++i) v[i] = *(const f32x4*)(W + (size_t)(k0 + 8 * i + (lane >> 3)) * N + n0 + 4 * (lane & 7));
#pragma unroll
    for (int i = 0; i < 8; ++i) { LAS float* d = scr + (8 * i + (lane >> 3)) * 33 + 4 * (lane & 7); float gs = 1.f; if (g0) { const int k = k0 + 8 * i + (lane >> 3); gs = k < (K >> 1) ? g0[k] : g1[k - (K >> 1)]; }
        d[0] = v[i].x * gs; d[1] = v[i].y * gs; d[2] = v[i].z * gs; d[3] = v[i].w * gs; }
    asm volatile("s_waitcnt lgkmcnt(0)" ::: "memory");
    const int c = lane & 7;
#pragma unroll
    for (int j = 0; j < 4; ++j) { const int n = (lane >> 3) + 8 * j; const LAS float* s = scr + (8 * c) * 33 + n;
        v4u o; o.x = pk2(s[0 * 33], s[1 * 33]); o.y = pk2(s[2 * 33], s[3 * 33]); o.z = pk2(s[4 * 33], s[5 * 33]); o.w = pk2(s[6 * 33], s[7 * 33]);
        *(v4u*)(WT + (size_t)(n0 + n) * K + k0 + 8 * c) = o; }
    asm volatile("s_waitcnt lgkmcnt(0)" ::: "memory");
}
struct cpx { float re, im; };
__device__ __forceinline__ cpx cmul(cpx a, cpx b) { return {a.re * b.re - a.im * b.im, a.re * b.im + a.im * b.re}; }
__device__ __forceinline__ cpx lam_pow(float a, float th, int n) { const float e = expf((float)n * a), x = (float)n * th; return {e * cosf(x), e * sinf(x)}; }
__device__ __forceinline__ cpx zoh_coef(float are, float aim, float dt) {
    const float a = dt * are, th = dt * aim, em1 = expm1f(a), s = sinf(th), c = cosf(th), sh = sinf(0.5f * th);
    const float nr = em1 * c - 2.f * sh * sh, ni = (em1 + 1.f) * s, den = are * are + aim * aim;
    return {(nr * are + ni * aim) / den, (ni * are - nr * aim) / den};
}

__device__ __forceinline__ void p0_prologue(const Args& A, LAS unsigned char* lds, int vcu, int G, int tid, int wave, int lane) {
    unsigned char* ws = A.ws;
    LAS float* scr = (LAS float*)(lds + wave * 8448);
    const int gw = vcu * NWAVES + wave, NGW = G * NWAVES;
    constexpr int I_1 = (DM / 64) * (PW / 32);
    for (int it = gw; it < I_1; it += NGW) p0_transpose_item(A.in[I_WIN], DM, PW, (bf16*)(ws + WS_WIN), scr, it, lane);
    {
        f32x4 gv[8];
#pragma unroll
        for (int j = 0; j < 8; ++j) gv[j] = ((const f32x4*)A.in[I_ANG])[lane + 64 * j];
        bf16* XN = (bf16*)(ws + WS_XN);
        for (int m = gw; m < MT; m += NGW) {
            const float* xrow = m < MP ? A.in[I_XP] + (size_t)m * DM : A.in[I_XS] + (size_t)(m - MP) * DM;
            f32x4 v[8]; float s = 0.f;
#pragma unroll
            for (int j = 0; j < 8; ++j) { v[j] = ((const f32x4*)xrow)[lane + 64 * j]; s += (v[j].x * v[j].x + v[j].y * v[j].y) + (v[j].z * v[j].z + v[j].w * v[j].w); }
            const float r = rsqrtf(wave_sum(s) * (1.f / DM) + EPSN);
            v2u* o8 = (v2u*)(XN + (size_t)m * DM) + lane;
#pragma unroll
            for (int j = 0; j < 8; ++j) { v2u w; w.x = pk2(v[j].x * r * gv[j].x, v[j].y * r * gv[j].y); w.y = pk2(v[j].z * r * gv[j].z, v[j].w * r * gv[j].w); o8[64 * j] = w; }
        }
    }
    const float* Are = A.in[I_ARE]; const float* Aim = A.in[I_AIM]; const float* Ldt = A.in[I_LDT];
    const float* Bre = A.in[I_BRE]; const float* Bim = A.in[I_BIM]; const float* Cre = A.in[I_CRE]; const float* Cim = A.in[I_CIM];
    const int gt = vcu * NTHR + tid, NT = G * NTHR;
    for (int idx = gt; idx < 4096; idx += NT) {
        const int g = idx >> 6, p = idx & 63; const float dt = expf(Ldt[g]), are = Are[idx], aim = Aim[idx];
        const cpx l1 = lam_pow(dt * are, dt * aim, 1), l16 = lam_pow(dt * are, dt * aim, 16), cf = zoh_coef(are, aim, dt);
        ((float2*)(ws + WS_LAM))[idx] = make_float2(l1.re, l1.im); ((float2*)(ws + WS_LAM16))[idx] = make_float2(l16.re, l16.im);
#pragma unroll 4
        for (int ch = 0; ch < 16; ++ch) { const cpx b = cmul(cf, cpx{Bre[idx * 16 + ch], Bim[idx * 16 + ch]}); ((float2*)(ws + WS_BBAR))[(g * 16 + ch) * 64 + p] = make_float2(b.re, b.im); }
    }
    for (int idx = gt; idx < 64 * 4 * 16 * 64; idx += NT) {
        const int l = idx & 63, s = (idx >> 6) & 15, rt = (idx >> 10) & 3, g = idx >> 12, r32 = l & 31, hi = l >> 5;
        const int m = 32 * rt + r32, p = m & 63, part = m >> 6, gp = g * 64 + p; const float dt = expf(Ldt[g]), are = Are[gp], aim = Aim[gp];
        const cpx w = cmul(lam_pow(dt * are, dt * aim, 15 - s), zoh_coef(are, aim, dt));
        float v[8];
#pragma unroll
        for (int j = 0; j < 8; ++j) { const int ch = 8 * hi + j; const float br = Bre[gp * 16 + ch], bi = Bim[gp * 16 + ch]; v[j] = part ? (w.re * bi + w.im * br) : (w.re * br - w.im * bi); }
        v4u o; o.x = pk2(v[0], v[1]); o.y = pk2(v[2], v[3]); o.z = pk2(v[4], v[5]); o.w = pk2(v[6], v[7]);
        ((v4u*)(ws + WS_WSF))[idx] = o;
    }
    for (int idx = gt; idx < 64 * 8 * 8 * 64; idx += NT) {
        const int l = idx & 63, kb = (idx >> 6) & 7, tt = (idx >> 9) & 7, g = idx >> 12, r32 = l & 31, hi = l >> 5;
        const int ti = r32 >> 4, chp = r32 & 15, tl = 2 * tt + ti; const float dt = expf(Ldt[g]);
        float v[8];
#pragma unroll
        for (int jp = 0; jp < 4; ++jp) { const int p = 8 * kb + 4 * hi + jp, gp = g * 64 + p;
            const cpx w = cmul(cpx{Cre[(g * 16 + chp) * 64 + p], Cim[(g * 16 + chp) * 64 + p]}, lam_pow(dt * Are[gp], dt * Aim[gp], tl + 1));
            v[2 * jp] = w.re; v[2 * jp + 1] = -w.im; }
        v4u o; o.x = pk2(v[0], v[1]); o.y = pk2(v[2], v[3]); o.z = pk2(v[4], v[5]); o.w = pk2(v[6], v[7]);
        ((v4u*)(ws + WS_WHF))[idx] = o;
    }
    __syncthreads();
    for (int g2 = vcu; g2 < 32; g2 += G) {
        LAS f32x2* pw = (LAS f32x2*)lds;
        LAS f32x2* cf = (LAS f32x2*)(lds + 16384);
        if (tid < 128) { const int gs = tid >> 6, p = tid & 63, gp = (2 * g2 + gs) * 64 + p; const float dt = expf(Ldt[2 * g2 + gs]), are = Are[gp], aim = Aim[gp];
            const cpx c1 = zoh_coef(are, aim, dt); cf[gs * 64 + p] = f32x2{c1.re, c1.im};
#pragma unroll 1
            for (int lag = 0; lag < 16; ++lag) { const cpx w = lam_pow(dt * are, dt * aim, lag); pw[(gs * 16 + lag) * 64 + p] = f32x2{w.re, w.im}; } }
        __syncthreads();
        {
            const int gs = tid >> 8, chp = (tid >> 4) & 15, ch = tid & 15, g = 2 * g2 + gs;
            float acc[16];
#pragma unroll
            for (int l = 0; l < 16; ++l) acc[l] = 0.f;
            for (int p = 0; p < 64; ++p) { const f32x2 c2 = cf[gs * 64 + p];
                const cpx q = cmul(cmul(cpx{Cre[(g * 16 + chp) * 64 + p], Cim[(g * 16 + chp) * 64 + p]}, cpx{c2.x, c2.y}), cpx{Bre[(g * 64 + p) * 16 + ch], Bim[(g * 64 + p) * 16 + ch]});
#pragma unroll
                for (int l = 0; l < 16; ++l) { const f32x2 w = pw[(gs * 16 + l) * 64 + p]; acc[l] += q.re * w.x - q.im * w.y; } }
            bf16* TF = (bf16*)(ws + WS_TF) + (size_t)g * 17 * 512;
            const int hi2 = ch >> 3, j = ch & 7;
#pragma unroll
            for (int l = 0; l < 16; ++l) { const unsigned short v = (unsigned short)f2bf(acc[l]);
                TF[(l * 64 + 32 * hi2 + 16 + chp) * 8 + j] = v;
                if (l < 15) TF[((l + 1) * 64 + 32 * hi2 + chp) * 8 + j] = v; }
            TF[(0 * 64 + 32 * hi2 + chp) * 8 + j] = 0;
            TF[(16 * 64 + 32 * hi2 + chp) * 8 + j] = 0; TF[(16 * 64 + 32 * hi2 + 16 + chp) * 8 + j] = 0;
        }
        __syncthreads();
    }
}

constexpr int KLS = 72, VTS = 264;
constexpr int LDS_K = 0, LDS_VT = 256 * KLS * 2;

__device__ __forceinline__ void attn_qtile(const LAS bf16* Kl, const LAS bf16* Vt, int kt0, const bf16x8 (&qf)[4], int iq, float slope2, float sink2, int jmin,
                                           f32x16 (&o)[2], float& inv_denom, int r32, int hi) {
    f32x16 S[5];
#pragma unroll
    for (int t5 = 0; t5 < 5; ++t5) {
        S[t5] = f32x16{};
#pragma unroll
        for (int d0 = 0; d0 < 4; ++d0) { const bf16x8 kf = *(const LAS bf16x8*)(Kl + (32 * (kt0 + t5) + r32) * KLS + 16 * d0 + 8 * hi); S[t5] = __builtin_amdgcn_mfma_f32_32x32x16_bf16(kf, qf[d0], S[t5], 0, 0, 0); }
    }
    float mx = sink2;
#pragma unroll
    for (int t5 = 0; t5 < 5; ++t5)
#pragma unroll
        for (int r = 0; r < 16; ++r) { const int j = 32 * (kt0 + t5) + crow(r, hi), delta = iq + 128 - j; const bool valid = (delta >= 0) && (delta <= 128) && (j >= jmin);
            const float s = valid ? S[t5][r] - slope2 * (float)delta : -1e30f; S[t5][r] = s; mx = fmaxf(mx, s); }
    mx = fmaxf(mx, __shfl_xor(mx, 32));
    float sum = 0.f;
#pragma unroll
    for (int t5 = 0; t5 < 5; ++t5)
#pragma unroll
        for (int r = 0; r < 16; ++r) { const float p = __builtin_amdgcn_exp2f(S[t5][r] - mx); sum += p; S[t5][r] = p; }
    sum += __shfl_xor(sum, 32);
    inv_denom = 1.0f / (sum + __builtin_amdgcn_exp2f(sink2 - mx));
    o[0] = f32x16{}; o[1] = f32x16{};
#pragma unroll
    for (int t5 = 0; t5 < 5; ++t5)
#pragma unroll
        for (int s2 = 0; s2 < 2; ++s2) {
            v4u pw; pw.x = pk2(S[t5][8 * s2 + 0], S[t5][8 * s2 + 1]); pw.y = pk2(S[t5][8 * s2 + 2], S[t5][8 * s2 + 3]); pw.z = pk2(S[t5][8 * s2 + 4], S[t5][8 * s2 + 5]); pw.w = pk2(S[t5][8 * s2 + 6], S[t5][8 * s2 + 7]);
            const bf16x8 pf = __builtin_bit_cast(bf16x8, pw);
#pragma unroll
            for (int dt = 0; dt < 2; ++dt) { const LAS bf16* vr = Vt + (32 * dt + r32) * VTS + 32 * (kt0 + t5) + 16 * s2 + 4 * hi;
                const v2u lo = *(const LAS v2u*)vr, hh = *(const LAS v2u*)(vr + 8); v4u vw; vw.x = lo.x; vw.y = lo.y; vw.z = hh.x; vw.w = hh.y;
                o[dt] = __builtin_amdgcn_mfma_f32_32x32x16_bf16(__builtin_bit_cast(bf16x8, vw), pf, o[dt], 0, 0, 0); }
        }
}
__device__ __forceinline__ void attn_qtile_fast(const LAS bf16* Kl, const LAS bf16* Vt, int kt0, const bf16x8 (&qf)[4], int iq, float slope2, float sink2,
                                                f32x16 (&o)[2], float& inv_denom, int r32, int hi) {
    f32x16 S[5];
    const float sbase = slope2 * (float)(4 * hi);
#pragma unroll
    for (int t5 = 0; t5 < 5; ++t5) {
        S[t5] = f32x16{};
#pragma unroll
        for (int d0 = 0; d0 < 4; ++d0) { const bf16x8 kf = *(const LAS bf16x8*)(Kl + (32 * (kt0 + t5) + r32) * KLS + 16 * d0 + 8 * hi); S[t5] = __builtin_amdgcn_mfma_f32_32x32x16_bf16(kf, qf[d0], S[t5], 0, 0, 0); }
    }
    const int D0 = iq + 128 - 32 * kt0 - 4 * hi, lo = D0 - 128;
    const float sinkp = sink2 + slope2 * (float)(iq + 128 - 32 * kt0);
    float m0 = -1e30f;
#pragma unroll
    for (int t5 = 0; t5 < 5; ++t5)
#pragma unroll
        for (int r = 0; r < 16; ++r) { const int off = 32 * t5 + (r & 3) + 8 * (r >> 2);
            float s = fmaf(slope2, (float)off, S[t5][r]);
            if (t5 == 0) s = (off >= lo) ? s : -1e30f;
            if (t5 == 4) s = (off <= D0) ? s : -1e30f;
            S[t5][r] = s; m0 = fmaxf(m0, s); }
    const float mloc = m0 + sbase;
    const float mx = fmaxf(sinkp, fmaxf(mloc, __shfl_xor(mloc, 32))), mxl = mx - sbase;
    float sum = 0.f;
#pragma unroll
    for (int t5 = 0; t5 < 5; ++t5)
#pragma unroll
        for (int r = 0; r < 16; ++r) { const float p = __builtin_amdgcn_exp2f(S[t5][r] - mxl); sum += p; S[t5][r] = p; }
    sum += __shfl_xor(sum, 32);
    inv_denom = 1.0f / (sum + __builtin_amdgcn_exp2f(sinkp - mx));
    o[0] = f32x16{}; o[1] = f32x16{};
#pragma unroll
    for (int t5 = 0; t5 < 5; ++t5)
#pragma unroll
        for (int s2 = 0; s2 < 2; ++s2) {
            v4u pw; pw.x = pk2(S[t5][8 * s2 + 0], S[t5][8 * s2 + 1]); pw.y = pk2(S[t5][8 * s2 + 2], S[t5][8 * s2 + 3]); pw.z = pk2(S[t5][8 * s2 + 4], S[t5][8 * s2 + 5]); pw.w = pk2(S[t5][8 * s2 + 6], S[t5][8 * s2 + 7]);
            const bf16x8 pf = __builtin_bit_cast(bf16x8, pw);
#pragma unroll
            for (int dt = 0; dt < 2; ++dt) { const LAS bf16* vr = Vt + (32 * dt + r32) * VTS + 32 * (kt0 + t5) + 16 * s2 + 4 * hi;
                const v2u lo2 = *(const LAS v2u*)vr, hh = *(const LAS v2u*)(vr + 8); v4u vw; vw.x = lo2.x; vw.y = lo2.y; vw.z = hh.x; vw.w = hh.y;
                o[dt] = __builtin_amdgcn_mfma_f32_32x32x16_bf16(__builtin_bit_cast(bf16x8, vw), pf, o[dt], 0, 0, 0); }
        }
}
__device__ __forceinline__ void stage_kv_from_z(const bf16* zrow, int kvh, int half, bool valid, LAS bf16* Kl, LAS bf16* Vt, int row, const float* gk, float* outk, float* outv) {
    v4u kw[4], vw[4];
#pragma unroll
    for (int i = 0; i < 4; ++i) { kw[i] = v4u{0u, 0u, 0u, 0u}; vw[i] = v4u{0u, 0u, 0u, 0u}; }
    if (valid) {
#pragma unroll
        for (int i = 0; i < 4; ++i) { kw[i] = *(const v4u*)(zrow + 1024 + kvh * 64 + 32 * half + 8 * i); vw[i] = *(const v4u*)(zrow + 1280 + kvh * 64 + 32 * half + 8 * i); }
    }
    float kf[32]; float ss = 0.f;
#pragma unroll
    for (int i = 0; i < 4; ++i) { kf[8 * i + 0] = bflo(kw[i].x); kf[8 * i + 1] = bfhi(kw[i].x); kf[8 * i + 2] = bflo(kw[i].y); kf[8 * i + 3] = bfhi(kw[i].y);
        kf[8 * i + 4] = bflo(kw[i].z); kf[8 * i + 5] = bfhi(kw[i].z); kf[8 * i + 6] = bflo(kw[i].w); kf[8 * i + 7] = bfhi(kw[i].w); }
#pragma unroll
    for (int i = 0; i < 32; ++i) ss += kf[i] * kf[i];
    ss += __shfl_xor(ss, 1);
    const float rk = rsqrtf(ss * (1.f / 64.f) + EPSN);
#pragma unroll
    for (int i = 0; i < 32; ++i) kf[i] = kf[i] * rk * gk[32 * half + i];
#pragma unroll
    for (int i = 0; i < 4; ++i) { v4u w; w.x = pk2(kf[8 * i], kf[8 * i + 1]); w.y = pk2(kf[8 * i + 2], kf[8 * i + 3]); w.z = pk2(kf[8 * i + 4], kf[8 * i + 5]); w.w = pk2(kf[8 * i + 6], kf[8 * i + 7]);
        *(LAS v4u*)(Kl + row * KLS + 32 * half + 8 * i) = w; }
#pragma unroll
    for (int i = 0; i < 4; ++i) { const unsigned ww[4] = {vw[i].x, vw[i].y, vw[i].z, vw[i].w};
#pragma unroll
        for (int q = 0; q < 4; ++q) { Vt[(32 * half + 8 * i + 2 * q) * VTS + row] = (bf16)(ww[q] & 0xffffu); Vt[(32 * half + 8 * i + 2 * q + 1) * VTS + row] = (bf16)(ww[q] >> 16); } }
    if (outk) {
#pragma unroll
        for (int i = 0; i < 8; ++i) ((f32x4*)(outk + 32 * half))[i] = f32x4{kf[4 * i], kf[4 * i + 1], kf[4 * i + 2], kf[4 * i + 3]};
#pragma unroll
        for (int i = 0; i < 4; ++i) { ((f32x4*)(outv + 32 * half))[2 * i] = f32x4{bflo(vw[i].x), bfhi(vw[i].x), bflo(vw[i].y), bfhi(vw[i].y)};
            ((f32x4*)(outv + 32 * half))[2 * i + 1] = f32x4{bflo(vw[i].z), bfhi(vw[i].z), bflo(vw[i].w), bfhi(vw[i].w)}; }
    }
}
__device__ __forceinline__ void load_q_raw(const bf16* zrow, int h, int hi, v4u (&qw)[4]) {
#pragma unroll
    for (int d0 = 0; d0 < 4; ++d0) qw[d0] = *(const v4u*)(zrow + h * 64 + 16 * d0 + 8 * hi);
}
__device__ __forceinline__ void finish_qfrags(const v4u (&qw)[4], const float* gq, bf16x8 (&qf)[4], int hi) {
    float ss = 0.f;
#pragma unroll
    for (int d0 = 0; d0 < 4; ++d0) {
        const float a0 = bflo(qw[d0].x), a1 = bfhi(qw[d0].x), a2 = bflo(qw[d0].y), a3 = bfhi(qw[d0].y), a4 = bflo(qw[d0].z), a5 = bfhi(qw[d0].z), a6 = bflo(qw[d0].w), a7 = bfhi(qw[d0].w);
        ss += (a0 * a0 + a1 * a1) + (a2 * a2 + a3 * a3) + (a4 * a4 + a5 * a5) + (a6 * a6 + a7 * a7); }
    ss += __shfl_xor(ss, 32);
    const float rq = rsqrtf(ss * (1.f / 64.f) + EPSN) * (0.125f * LOG2E);
#pragma unroll
    for (int d0 = 0; d0 < 4; ++d0) { const float* g = gq + 16 * d0 + 8 * hi; v4u w;
        w.x = pk2(bflo(qw[d0].x) * rq * g[0], bfhi(qw[d0].x) * rq * g[1]); w.y = pk2(bflo(qw[d0].y) * rq * g[2], bfhi(qw[d0].y) * rq * g[3]);
        w.z = pk2(bflo(qw[d0].z) * rq * g[4], bfhi(qw[d0].z) * rq * g[5]); w.w = pk2(bflo(qw[d0].w) * rq * g[6], bfhi(qw[d0].w) * rq * g[7]);
        qf[d0] = __builtin_bit_cast(bf16x8, w); }
}
__device__ __forceinline__ void load_qfrags(const bf16* zrow, int h, const float* gq, bf16x8 (&qf)[4], int hi) { v4u qw[4]; load_q_raw(zrow, h, hi, qw); finish_qfrags(qw, gq, qf, hi); }
__device__ __forceinline__ void store_attn_out(bf16* orow  , float* ssrow  , bool active, const f32x16 (&o)[2], float inv, int hi) {
    float ss = 0.f;
#pragma unroll
    for (int dt = 0; dt < 2; ++dt)
#pragma unroll
        for (int r4 = 0; r4 < 4; ++r4) { const float a = o[dt][4 * r4] * inv, b = o[dt][4 * r4 + 1] * inv, c = o[dt][4 * r4 + 2] * inv, d = o[dt][4 * r4 + 3] * inv;
            ss += (a * a + b * b) + (c * c + d * d);
            v2u w; w.x = pk2(a, b); w.y = pk2(c, d);
            if (active) *(v2u*)(orow + 32 * dt + 8 * r4 + 4 * hi) = w; }
    ss += __shfl_xor(ss, 32);
    if (active && hi == 0) unsafeAtomicAdd(ssrow, ss);
}
__device__ __forceinline__ void attn_prompt_unit(const Args& A, LAS unsigned char* lds, int b, int kvh, int qb, int tid, int wave, int lane) {
    LAS bf16* Kl = (LAS bf16*)(lds + LDS_K); LAS bf16* Vt = (LAS bf16*)(lds + LDS_VT);
    const bf16* Z = (const bf16*)(A.ws + WS_Z); bf16* ATT = (bf16*)(A.ws + WS_MIX); float* SSA = (float*)(A.ws + WS_SSA);
    const int r32 = lane & 31, hi = lane >> 5;
    const int h = kvh * 4 + (wave >> 1);
    const int tok0 = b * 2048 + qb * 128 + 64 * (wave & 1) + r32;
    v4u qw0[4], qw1[4];
    load_q_raw(Z + (size_t)tok0 * PW, h, hi, qw0); load_q_raw(Z + (size_t)(tok0 + 32) * PW, h, hi, qw1);
    {
        const int row = tid >> 1, half = tid & 1, tok = (qb - 1) * 128 + row; const bool valid = tok >= 0;
        const bf16* zrow = Z + (size_t)(b * 2048 + (valid ? tok : 0)) * PW;
        float* outk = nullptr; float* outv = nullptr;
        if (qb == 15 && row >= 128) { const size_t o = ((size_t)(b * 128 + row - 128) * 4 + kvh) * 64; outk = A.out + O_KP + o; outv = A.out + O_VP + o; }
        stage_kv_from_z(zrow, kvh, half, valid, Kl, Vt, row, A.in[I_KG], outk, outv);
    }
    __syncthreads();
    const float slope2 = exp2f(-0.5f * (float)(h + 1)) * LOG2E, sink2 = A.in[I_SINK][h] * LOG2E;
#pragma unroll 1
    for (int jj = 0; jj < 2; ++jj) {
        const int jq = 2 * (wave & 1) + jj, tok = tok0 + 32 * jj;
        v4u qs[4];
#pragma unroll
        for (int d0 = 0; d0 < 4; ++d0) qs[d0] = jj ? qw1[d0] : qw0[d0];
        bf16x8 qf[4]; finish_qfrags(qs, A.in[I_QG], qf, hi);
        f32x16 o[2]; float inv;
        if (qb == 0) attn_qtile(Kl, Vt, jq, qf, 32 * jq + r32, slope2, sink2, 128, o, inv, r32, hi);
        else attn_qtile_fast(Kl, Vt, jq, qf, 32 * jq + r32, slope2, sink2, o, inv, r32, hi);
        store_attn_out(ATT + (size_t)tok * DM + h * 64, SSA + tok, true, o, inv, hi);
    }
    __syncthreads();
}
__device__ __forceinline__ void attn_sample_unit(const Args& A, LAS unsigned char* lds, int n, int kvh, int tid, int wave, int lane) {
    LAS bf16* Kl = (LAS bf16*)(lds + LDS_K); LAS bf16* Vt = (LAS bf16*)(lds + LDS_VT);
    const bf16* Z = (const bf16*)(A.ws + WS_Z); bf16* ATT = (bf16*)(A.ws + WS_MIX); float* SSA = (float*)(A.ws + WS_SSA);
    const int r32 = lane & 31, hi = lane >> 5;
    {
        const int row = tid >> 2, qt = tid & 3; const size_t src = ((size_t)(n * 128 + row) * 4 + kvh) * 64 + 16 * qt;
        f32x4 kv[4], vv[4];
#pragma unroll
        for (int i = 0; i < 4; ++i) { kv[i] = ((const f32x4*)(A.in[I_CK] + src))[i]; vv[i] = ((const f32x4*)(A.in[I_CV] + src))[i]; }
#pragma unroll
        for (int i = 0; i < 2; ++i) { v4u w; w.x = pk2(kv[2 * i].x, kv[2 * i].y); w.y = pk2(kv[2 * i].z, kv[2 * i].w); w.z = pk2(kv[2 * i + 1].x, kv[2 * i + 1].y); w.w = pk2(kv[2 * i + 1].z, kv[2 * i + 1].w);
            *(LAS v4u*)(Kl + row * KLS + 16 * qt + 8 * i) = w; }
#pragma unroll
        for (int i = 0; i < 4; ++i) { Vt[(16 * qt + 4 * i + 0) * VTS + row] = (bf16)f2bf(vv[i].x); Vt[(16 * qt + 4 * i + 1) * VTS + row] = (bf16)f2bf(vv[i].y);
            Vt[(16 * qt + 4 * i + 2) * VTS + row] = (bf16)f2bf(vv[i].z); Vt[(16 * qt + 4 * i + 3) * VTS + row] = (bf16)f2bf(vv[i].w); }
        if (row >= 4) { const size_t dst = ((size_t)(n * 128 + row - 4) * 4 + kvh) * 64 + 16 * qt;
#pragma unroll
            for (int i = 0; i < 4; ++i) { ((f32x4*)(A.out + O_KS + dst))[i] = kv[i]; ((f32x4*)(A.out + O_VS + dst))[i] = vv[i]; } }
        for (int idx = tid; idx < 28 * 64; idx += NTHR) { const int r = 132 + (idx >> 6), c = idx & 63; Kl[r * KLS + c] = 0; Vt[c * VTS + r] = 0; }
        if (tid < 8) {
            const int t = tid >> 1, half = tid & 1; const size_t o = ((size_t)(n * 128 + 124 + t) * 4 + kvh) * 64;
            stage_kv_from_z(Z + (size_t)(MP + 4 * n + t) * PW, kvh, half, true, Kl, Vt, 128 + t, A.in[I_KG], A.out + O_KS + o, A.out + O_VS + o);
        }
    }
    __syncthreads();
    if (wave == 0) {
        const int t = r32 & 3, rr = (r32 >> 2) & 3, h = kvh * 4 + rr, tok = MP + 4 * n + t;
        const float slope2 = exp2f(-0.5f * (float)(h + 1)) * LOG2E, sink2 = A.in[I_SINK][h] * LOG2E;
        bf16x8 qf[4]; load_qfrags(Z + (size_t)tok * PW, h, A.in[I_QG], qf, hi);
        f32x16 o[2]; float inv;
        attn_qtile_fast(Kl, Vt, 0, qf, t, slope2, sink2, o, inv, r32, hi);
        store_attn_out(ATT + (size_t)tok * DM + h * 64, SSA + tok, r32 < 16, o, inv, hi);
    }
    __syncthreads();
}

constexpr int US = 264, ES = 132;
constexpr int LDS_U = 0, LDS_E = 128 * US * 2, LDS_TF = LDS_E + 128 * ES * 4, LDS_SSM_END = LDS_TF + 17 * 1024;
__device__ __forceinline__ void ssm_prompt_unit(const Args& A, LAS unsigned char* lds, int b, int g, int tid, int wave, int lane) {
    LAS bf16* U = (LAS bf16*)(lds + LDS_U); LAS float* E = (LAS float*)(lds + LDS_E); LAS unsigned char* TFl = lds + LDS_TF;
    const int r32 = lane & 31, hi = lane >> 5, w4 = wave & 3, ctp = wave >> 2;
    const bf16* Zu = (const bf16*)(A.ws + WS_Z) + (size_t)(b * 2048) * PW + 1536 + 16 * g;
    {
        v4u uv[8], tv[3];
#pragma unroll
        for (int i = 0; i < 8; ++i) { const int q = tid + 512 * i, t = q >> 1, h = q & 1; uv[i] = *(const v4u*)(Zu + (size_t)t * PW + 8 * h); }
        const v4u* tfg = (const v4u*)(A.ws + WS_TF) + (size_t)g * 17 * 64;
#pragma unroll
        for (int i = 0; i < 3; ++i) { const int q = tid + 512 * i; tv[i] = q < 17 * 64 ? tfg[q] : v4u{0u, 0u, 0u, 0u}; }
#pragma unroll
        for (int i = 0; i < 8; ++i) { const int q = tid + 512 * i, t = q >> 1, h = q & 1; *(LAS v4u*)(U + (t >> 4) * US + (t & 15) * 16 + 8 * h) = uv[i]; }
#pragma unroll
        for (int i = 0; i < 3; ++i) { const int q = tid + 512 * i; if (q < 17 * 64) *(LAS v4u*)(TFl + q * 16) = tv[i]; }
    }
    bf16x8 wf[16];
    {   const bf16x8* wsf = (const bf16x8*)(A.ws + WS_WSF) + (size_t)((g * 4 + w4) * 16) * 64 + lane;
#pragma unroll
        for (int s = 0; s < 16; ++s) wf[s] = wsf[s * 64]; }
    __syncthreads();
    const LAS bf16* u0p = U + (32 * (2 * ctp) + r32) * US + 8 * hi; const LAS bf16* u1p = U + (32 * (2 * ctp + 1) + r32) * US + 8 * hi;
    {
        f32x16 e0 = f32x16{}, e1 = f32x16{};
#pragma unroll
        for (int s = 0; s < 16; ++s) { const bf16x8 u0 = *(const LAS bf16x8*)(u0p + s * 16), u1 = *(const LAS bf16x8*)(u1p + s * 16);
            e0 = __builtin_amdgcn_mfma_f32_32x32x16_bf16(wf[s], u0, e0, 0, 0, 0); e1 = __builtin_amdgcn_mfma_f32_32x32x16_bf16(wf[s], u1, e1, 0, 0, 0); }
#pragma unroll
        for (int r = 0; r < 16; ++r) { const int m = 32 * w4 + crow(r, hi); E[(32 * (2 * ctp) + r32) * ES + m] = e0[r]; E[(32 * (2 * ctp + 1) + r32) * ES + m] = e1[r]; }
    }
    const int ttA = w4, ttB = 7 - w4;
    asm volatile("" ::: "memory");
    bf16x8 whA[8], whB[8];
    {   const bf16x8* pa = (const bf16x8*)(A.ws + WS_WHF) + (size_t)((g * 8 + ttA) * 8) * 64 + lane; const bf16x8* pb = (const bf16x8*)(A.ws + WS_WHF) + (size_t)((g * 8 + ttB) * 8) * 64 + lane;
#pragma unroll
        for (int kb = 0; kb < 8; ++kb) { whA[kb] = pa[kb * 64]; whB[kb] = pb[kb * 64]; } }
    __syncthreads();
    if (wave == 0) {
        const float2 l16 = ((const float2*)(A.ws + WS_LAM16))[g * 64 + lane];
        float hr = 0.f, hm = 0.f;
#pragma unroll 8
        for (int c = 0; c < 128; ++c) { const float er = E[c * ES + lane], ei = E[c * ES + 64 + lane];
            E[c * ES + lane] = __uint_as_float(pk2(hr, hm));
            const float nr = l16.x * hr - l16.y * hm + er, ni = l16.x * hm + l16.y * hr + ei; hr = nr; hm = ni; }
        A.out[O_RP + (size_t)(b * 64 + g) * 64 + lane] = hr; A.out[O_IP + (size_t)(b * 64 + g) * 64 + lane] = hm;
    }
    __syncthreads();
    {
        f32x16 aA0 = f32x16{}, aA1 = f32x16{}, aB0 = f32x16{}, aB1 = f32x16{};
        const LAS unsigned char* tfl = TFl + lane * 16;
#pragma unroll 4
        for (int s = 0; s < 16; ++s) {
            if (s <= 2 * ttB + 1) {
                const bf16x8 u0 = *(const LAS bf16x8*)(u0p + s * 16), u1 = *(const LAS bf16x8*)(u1p + s * 16);
                const bf16x8 tB = *(const LAS bf16x8*)(tfl + (2 * ttB - s + 1) * 1024);
                aB0 = __builtin_amdgcn_mfma_f32_32x32x16_bf16(tB, u0, aB0, 0, 0, 0); aB1 = __builtin_amdgcn_mfma_f32_32x32x16_bf16(tB, u1, aB1, 0, 0, 0);
                if (s <= 2 * ttA + 1) { const bf16x8 tA = *(const LAS bf16x8*)(tfl + (2 * ttA - s + 1) * 1024);
                    aA0 = __builtin_amdgcn_mfma_f32_32x32x16_bf16(tA, u0, aA0, 0, 0, 0); aA1 = __builtin_amdgcn_mfma_f32_32x32x16_bf16(tA, u1, aA1, 0, 0, 0); }
            }
        }
        const LAS bf16* h0p = (const LAS bf16*)(E + (32 * (2 * ctp) + r32) * ES) + 8 * hi; const LAS bf16* h1p = (const LAS bf16*)(E + (32 * (2 * ctp + 1) + r32) * ES) + 8 * hi;
#pragma unroll
        for (int kb = 0; kb < 8; ++kb) {
            const bf16x8 h0 = *(const LAS bf16x8*)(h0p + 16 * kb), h1 = *(const LAS bf16x8*)(h1p + 16 * kb);
            aA0 = __builtin_amdgcn_mfma_f32_32x32x16_bf16(whA[kb], h0, aA0, 0, 0, 0); aA1 = __builtin_amdgcn_mfma_f32_32x32x16_bf16(whA[kb], h1, aA1, 0, 0, 0);
            aB0 = __builtin_amdgcn_mfma_f32_32x32x16_bf16(whB[kb], h0, aB0, 0, 0, 0); aB1 = __builtin_amdgcn_mfma_f32_32x32x16_bf16(whB[kb], h1, aB1, 0, 0, 0);
        }
        bf16* Gm = (bf16*)(A.ws + WS_G);
        const float* Dk = A.in[I_D] + 16 * g;
#define SSM_EPI(acc, tt, ct) do { _Pragma("unroll") for (int r4 = 0; r4 < 4; ++r4) { const int ti = r4 >> 1, ch0 = 8 * (r4 & 1) + 4 * hi, cc = 32 * (ct) + r32, tok = 16 * cc + 2 * (tt) + ti; \
            const v2u uw = *(const LAS v2u*)(U + cc * US + (2 * (tt) + ti) * 16 + ch0); const f32x4 dv = *(const f32x4*)(Dk + ch0); \
            const float y0 = acc[4 * r4 + 0] + dv.x * bflo(uw.x), y1 = acc[4 * r4 + 1] + dv.y * bfhi(uw.x), y2 = acc[4 * r4 + 2] + dv.z * bflo(uw.y), y3 = acc[4 * r4 + 3] + dv.w * bfhi(uw.y); \
            v2u w; w.x = pk2(gelu_tanh(y0), gelu_tanh(y1)); w.y = pk2(gelu_tanh(y2), gelu_tanh(y3)); \
            *(v2u*)(Gm + (size_t)(b * 2048 + tok) * SWD + 16 * g + ch0) = w; } } while (0)
        SSM_EPI(aA0, ttA, 2 * ctp); SSM_EPI(aA1, ttA, 2 * ctp + 1); SSM_EPI(aB0, ttB, 2 * ctp); SSM_EPI(aB1, ttB, 2 * ctp + 1);
#undef SSM_EPI
    }
    __syncthreads();
}
__device__ __forceinline__ void ssm_sample_wave(const Args& A, LAS unsigned char* lds, int gw  , int ngw, int wave, int lane) {
    LAS float* Cr = (LAS float*)(lds + wave * 8192); LAS float* Ci = Cr + 1024; LAS float* hs = (LAS float*)(lds + 65536 + wave * 2048);
    const bf16* Z = (const bf16*)(A.ws + WS_Z);
    const int tl = lane >> 4, cl = lane & 15;
    for (int g = gw & 63; g < 64; g += 64) {
        {   const f32x4* cre = (const f32x4*)(A.in[I_CRE] + (size_t)g * 1024); const f32x4* cim = (const f32x4*)(A.in[I_CIM] + (size_t)g * 1024);
#pragma unroll
            for (int i = 0; i < 4; ++i) { const int q4 = lane + 64 * i, chp = q4 >> 4, p0 = (q4 & 15) * 4; const f32x4 a = cre[q4], c = cim[q4];
                Cr[(p0 + 0) * 16 + chp] = a.x; Cr[(p0 + 1) * 16 + chp] = a.y; Cr[(p0 + 2) * 16 + chp] = a.z; Cr[(p0 + 3) * 16 + chp] = a.w;
                Ci[(p0 + 0) * 16 + chp] = c.x; Ci[(p0 + 1) * 16 + chp] = c.y; Ci[(p0 + 2) * 16 + chp] = c.z; Ci[(p0 + 3) * 16 + chp] = c.w; } }
        const float2 lam = ((const float2*)(A.ws + WS_LAM))[g * 64 + lane];
        float2 bb[16];
#pragma unroll
        for (int ch = 0; ch < 16; ++ch) bb[ch] = ((const float2*)(A.ws + WS_BBAR))[(g * 16 + ch) * 64 + lane];
        const float dsk = A.in[I_D][16 * g + cl];
        for (int n = gw >> 6; n < 128; n += ngw >> 6) {
            float hr = A.in[I_SR][(size_t)(n * 64 + g) * 64 + lane], hm = A.in[I_SI][(size_t)(n * 64 + g) * 64 + lane];
            const unsigned short ub = Z[(size_t)(MP + 4 * n + tl) * PW + 1536 + 16 * g + cl];
            const float uval = __uint_as_float((unsigned)ub << 16);
#pragma unroll
            for (int t = 0; t < 4; ++t) {
                float br = 0.f, bi = 0.f;
#pragma unroll
                for (int ch = 0; ch < 16; ++ch) { const float u = __shfl(uval, t * 16 + ch); br += bb[ch].x * u; bi += bb[ch].y * u; }
                const float nr = lam.x * hr - lam.y * hm + br, ni = lam.x * hm + lam.y * hr + bi; hr = nr; hm = ni;
                hs[(t * 2 + 0) * 64 + lane] = hr; hs[(t * 2 + 1) * 64 + lane] = hm;
            }
            A.out[O_RS + (size_t)(n * 64 + g) * 64 + lane] = hr; A.out[O_IS + (size_t)(n * 64 + g) * 64 + lane] = hm;
            float y = 0.f;
#pragma unroll 4
            for (int p = 0; p < 64; p += 4) { const f32x4 h4 = *(const LAS f32x4*)(hs + (tl * 2 + 0) * 64 + p), g4 = *(const LAS f32x4*)(hs + (tl * 2 + 1) * 64 + p);
                y += (Cr[(p + 0) * 16 + cl] * h4.x - Ci[(p + 0) * 16 + cl] * g4.x) + (Cr[(p + 1) * 16 + cl] * h4.y - Ci[(p + 1) * 16 + cl] * g4.y)
                   + (Cr[(p + 2) * 16 + cl] * h4.z - Ci[(p + 2) * 16 + cl] * g4.z) + (Cr[(p + 3) * 16 + cl] * h4.w - Ci[(p + 3) * 16 + cl] * g4.w); }
            y += dsk * uval;
            ((bf16*)(A.ws + WS_G))[(size_t)(MP + 4 * n + tl) * SWD + 16 * g + cl] = (bf16)f2bf(gelu_tanh(y));
        }
    }
}

__device__ __forceinline__ void convert_two(const float* W1, int K1, int N1, bf16* T1, const float* W2, int K2, int N2, bf16* T2, LAS unsigned char* lds, int w, int nw, int wave, int lane, const float* g0 = nullptr, const float* g1 = nullptr) {
    LAS float* scr = (LAS float*)(lds + wave * 8448);
    const int i1 = (K1 / 64) * (N1 / 32), i2 = (K2 / 64) * (N2 / 32);
    for (int it = w * NWAVES + wave; it < i1 + i2; it += nw * NWAVES) {
        if (it < i1) p0_transpose_item(W1, K1, N1, T1, scr, it, lane); else p0_transpose_item(W2, K2, N2, T2, scr, it - i1, lane, g0, g1);
    }
}
#define XB_TMO      128
#define XB_XCNT(j)  (256  + 64 * (j))
#define XB_XSUB(j)  (1280 + 64 * (j))
#define XB_XGEN(j)  (2304 + 64 * (j))
#define XB_TOP      3328
#define XB_TOPGEN   3392
#define XCD_BAR_WORDS 3456
#define XB_SPIN_CAP (1u << 18)

__device__ __forceinline__ unsigned xb_ld(unsigned* p)              { return __hip_atomic_load(p, __ATOMIC_RELAXED, __HIP_MEMORY_SCOPE_AGENT); }
__device__ __forceinline__ unsigned xb_add(unsigned* p, unsigned v) { return __hip_atomic_fetch_add(p, v, __ATOMIC_RELAXED, __HIP_MEMORY_SCOPE_AGENT); }
__device__ __forceinline__ unsigned xb_xcc_id() { return (unsigned)__builtin_amdgcn_s_getreg((3 << 11) | 20) & 0xFu; }
#define XB_SPIN(cond, bar) do { unsigned _sp = 0; while (cond) { __builtin_amdgcn_s_sleep(1); \
    if ((++_sp & 255u) == 0u) { if (xb_ld(&(bar)[XB_TMO])) break; if (_sp > XB_SPIN_CAP) { atomicAdd(&(bar)[XB_TMO], 1u); break; } } } } while (0)

struct XcdBarrier {
    unsigned* bar; unsigned x;
    volatile LAS unsigned* st;
};

__device__ __forceinline__ XcdBarrier xcd_barrier_post(unsigned* bar, volatile LAS unsigned* st) {
    XcdBarrier b; b.bar = bar; b.x = xb_xcc_id(); b.st = st;
    if (threadIdx.x == 0) (void)xb_add(&bar[XB_XCNT(b.x)], 1u);
    return b;
}
__device__ __forceinline__ void xcd_barrier_complete(unsigned* bar, unsigned x, unsigned& nloc, unsigned& nx) {
    const unsigned G = gridDim.x * gridDim.y * gridDim.z;
    unsigned sum, cnt, mine, sp = 0u;
    for (;;) {
        sum = 0u; cnt = 0u; mine = 0u;
#pragma unroll
        for (unsigned j = 0; j < 16; ++j) { const unsigned c = xb_ld(&bar[XB_XCNT(j)]); sum += c; cnt += (c > 0u) ? 1u : 0u; mine = (j == x) ? c : mine; }
        if (sum == G) break;
        __builtin_amdgcn_s_sleep(1);
        if ((++sp & 255u) == 0u) { if (xb_ld(&bar[XB_TMO])) break; if (sp > XB_SPIN_CAP) { atomicAdd(&bar[XB_TMO], 1u); break; } }
    }
    nloc = mine > 0u ? mine : 1u; nx = cnt > 0u ? cnt : 1u;
}

__device__ __forceinline__ void xcd_barrier(const XcdBarrier& b) {
    asm volatile("s_waitcnt vmcnt(0)" ::: "memory");
    __syncthreads();
    if (threadIdx.x == 0) {
        unsigned* bar = b.bar;
        __builtin_amdgcn_s_waitcnt(0);
        unsigned nloc = b.st[0], nx = b.st[1];
        if (nloc == 0u) { xcd_barrier_complete(bar, b.x, nloc, nx); b.st[0] = nloc; b.st[1] = nx; }
        const unsigned old = xb_add(&bar[XB_XSUB(b.x)], 1u);
        const unsigned gen = old / nloc;
        if (old + 1u == (gen + 1u) * nloc) {
            __builtin_amdgcn_fence(__ATOMIC_RELEASE, "agent");
            asm volatile("s_waitcnt vmcnt(0)" ::: "memory");
            const unsigned og = xb_add(&bar[XB_TOP], 1u);
            const unsigned tg = og / nx;
            if (og + 1u == (tg + 1u) * nx) xb_add(&bar[XB_TOPGEN], 1u);
            else XB_SPIN(xb_ld(&bar[XB_TOPGEN]) == tg, bar);
            __builtin_amdgcn_fence(__ATOMIC_ACQUIRE, "agent");
            xb_add(&bar[XB_XGEN(b.x)], 1u);
            asm volatile("s_waitcnt vmcnt(0)" ::: "memory");
        } else {
            XB_SPIN(xb_ld(&bar[XB_XGEN(b.x)]) == gen, bar);
            __builtin_amdgcn_fence(__ATOMIC_ACQUIRE, "agent");
            asm volatile("s_waitcnt vmcnt(0)" ::: "memory");
        }
    }
    __syncthreads();
}

template <int LO, int HI> __device__ __forceinline__ void fwd_body(const Args& A) {
    extern __shared__ __attribute__((aligned(16))) unsigned char lds_raw[];
    LAS unsigned char* lds = (LAS unsigned char*)lds_raw;
    const int tid = threadIdx.x, lane = tid & 63, wave = __builtin_amdgcn_readfirstlane(tid >> 6);
    const int G = gridDim.x, bx = blockIdx.x, vcu = (G % 8 == 0) ? (bx % 8) * (G / 8) + bx / 8 : bx;
    unsigned char* ws = A.ws;
#define IN(k) (LO <= (k) && (k) < HI)
    volatile LAS unsigned* bst = (volatile LAS unsigned*)(lds + LDS_PHASE);
    if (tid == 0) { bst[0] = 0u; bst[1] = 0u; }
    __syncthreads();
    XcdBarrier bar; bar.bar = (unsigned*)(ws + WS_BAR); bar.x = 0; bar.st = bst;
    if (HI - LO > 1) bar = xcd_barrier_post((unsigned*)(ws + WS_BAR), bst);
#define SEAM(k) do { if (IN(k) && IN((k) + 1)) { xcd_barrier(bar); } } while (0)
    if (HI - LO > 1) cg::this_grid().sync();
    using namespace pg8;
#ifdef PROBE_P0
    if (IN(0)) { const int nrep = A.ph_hi > 100 ? 1 : 2; for (int rep = 0; rep < nrep; ++rep) { p0_prologue(A, lds, vcu, G, tid, wave, lane); __syncthreads(); if (rep + 1 < nrep) xcd_barrier(bar); } }
#else
    if (IN(0)) { p0_prologue(A, lds, vcu, G, tid, wave, lane); __syncthreads(); }
#endif
    SEAM(0);
    if (IN(1)) { Gemm g{(const bf16_t*)(ws + WS_XN), (const bf16_t*)(ws + WS_WIN), MT, PW, DM}; StaticOrder S; S.init(MT, PW, G, bx, DM);
        EpiStoreBf16<0> E{(bf16_t*)(ws + WS_Z), PW};
        gemm_phase<EpiStoreBf16<0>, StaticOrder, true, true>(lds, g, S, E);
        { const int nfull = (MT / 256) * (PW / 256) - 2 * G;
          if (G == 256 && bx >= nfull) convert_two(A.in[I_WGLU], SWD, SWD, (bf16*)(ws + WS_WGLU), A.in[I_WOUT], DM, DM, (bf16*)(ws + WS_WOUT), lds, bx - nfull, G - nfull, wave, lane, A.in[I_AOG], A.in[I_SOG]);
          else if (G != 256) convert_two(A.in[I_WGLU], SWD, SWD, (bf16*)(ws + WS_WGLU), A.in[I_WOUT], DM, DM, (bf16*)(ws + WS_WOUT), lds, bx, G, wave, lane, A.in[I_AOG], A.in[I_SOG]); } }
    SEAM(1);
    if (IN(2)) {
#ifdef PROBE_P2
      const int nrep2 = A.ph_hi > 100 ? 1 : 2;
      for (int rep = 0; rep < nrep2; ++rep) {
        if (rep) xcd_barrier(bar);
#else
      {
#endif
#ifndef SKIP_AP
        for (int u = vcu; u < 512; u += G) { int t_ = threadIdx.x; asm volatile("" : "+v"(t_)); const int l_ = t_ & 63, w_ = __builtin_amdgcn_readfirstlane(t_ >> 6); attn_prompt_unit(A, lds, u >> 6, (u >> 4) & 3, u & 15, t_, w_, l_); }
#endif
#ifdef DUP_AP
        __syncthreads();
        for (int u = vcu; u < 512; u += G) { int t_ = threadIdx.x; asm volatile("" : "+v"(t_)); const int l_ = t_ & 63, w_ = __builtin_amdgcn_readfirstlane(t_ >> 6); attn_prompt_unit(A, lds, u >> 6, (u >> 4) & 3, u & 15, t_, w_, l_); }
#endif
#ifndef SKIP_SP
        for (int u = vcu; u < 512; u += G) { int t_ = threadIdx.x; asm volatile("" : "+v"(t_)); const int l_ = t_ & 63, w_ = __builtin_amdgcn_readfirstlane(t_ >> 6); ssm_prompt_unit(A, lds, u >> 6, u & 63, t_, w_, l_); }
#endif
#ifdef DUP_SP
        __syncthreads();
        for (int u = vcu; u < 512; u += G) { int t_ = threadIdx.x; asm volatile("" : "+v"(t_)); const int l_ = t_ & 63, w_ = __builtin_amdgcn_readfirstlane(t_ >> 6); ssm_prompt_unit(A, lds, u >> 6, u & 63, t_, w_, l_); }
#endif
#ifndef SKIP_AS
        for (int u = vcu; u < 512; u += G) { int t_ = threadIdx.x; asm volatile("" : "+v"(t_)); const int l_ = t_ & 63, w_ = __builtin_amdgcn_readfirstlane(t_ >> 6); attn_sample_unit(A, lds, u >> 2, u & 3, t_, w_, l_); }
#endif
#ifdef DUP_AS
        __syncthreads();
        for (int u = vcu; u < 512; u += G) { int t_ = threadIdx.x; asm volatile("" : "+v"(t_)); const int l_ = t_ & 63, w_ = __builtin_amdgcn_readfirstlane(t_ >> 6); attn_sample_unit(A, lds, u >> 2, u & 3, t_, w_, l_); }
#endif
#ifndef SKIP_SS
        { int t_ = threadIdx.x; asm volatile("" : "+v"(t_)); const int l_ = t_ & 63, w_ = __builtin_amdgcn_readfirstlane(t_ >> 6);
          if ((G * NWAVES) % 64 == 0) ssm_sample_wave(A, lds, vcu * NWAVES + w_, G * NWAVES, w_, l_); }
#endif
#ifdef DUP_SS
        __syncthreads();
        { int t_ = threadIdx.x; asm volatile("" : "+v"(t_)); const int l_ = t_ & 63, w_ = __builtin_amdgcn_readfirstlane(t_ >> 6);
          if ((G * NWAVES) % 64 == 0) ssm_sample_wave(A, lds, vcu * NWAVES + w_, G * NWAVES, w_, l_); }
#endif
        __syncthreads();
      }
    }
    SEAM(2);
    if (IN(3)) { Gemm g{(const bf16_t*)(ws + WS_G), (const bf16_t*)(ws + WS_WGLU), MT, SWD, SWD}; StaticOrder S; S.init(MT, SWD, G, bx, SWD);
        EpiGlu E{(const bf16_t*)(ws + WS_G), (bf16_t*)(ws + WS_MIX), A.in[I_BGLU], (float*)(ws + WS_SSS)};
        gemm_phase<EpiGlu, StaticOrder, true, true>(lds, g, S, E); }
    SEAM(3);
    if (IN(5)) { Gemm g{(const bf16_t*)(ws + WS_MIX), (const bf16_t*)(ws + WS_WOUT), MT, DM, DM}; StaticOrder S; S.init(MT, DM, G, bx, DM);
        EpiHres E{A.in[I_XP], A.in[I_XS], A.out + O_Y, (bf16_t*)(ws + WS_HG), A.in[I_MNG], (float*)(ws + WS_CTL), (const float*)(ws + WS_SSA), (const float*)(ws + WS_SSS)};
        gemm_phase<EpiHres, StaticOrder, true, true>(lds, g, S, E);
        { const int nfull = (MT / 256) * (DM / 256) - 2 * G;
          if (G == 256 && bx >= nfull) convert_two(A.in[I_WUP], DM, FF, (bf16*)(ws + WS_WUP), A.in[I_WDN], FF, DM, (bf16*)(ws + WS_WDN), lds, bx - nfull, G - nfull, wave, lane);
          else if (G != 256) convert_two(A.in[I_WUP], DM, FF, (bf16*)(ws + WS_WUP), A.in[I_WDN], FF, DM, (bf16*)(ws + WS_WDN), lds, bx, G, wave, lane); } }
    SEAM(5);
    if (IN(6)) { Gemm g{(const bf16_t*)(ws + WS_HG), (const bf16_t*)(ws + WS_WUP), MT, FF, DM}; StaticOrder S; S.init(MT, FF, G, bx, DM);
        EpiStoreBf16<2> E{(bf16_t*)(ws + WS_ACT), FF};
        gemm_phase<EpiStoreBf16<2>, StaticOrder, true, true>(lds, g, S, E); }
    SEAM(6);
    if (IN(7)) { Gemm g{(const bf16_t*)(ws + WS_ACT), (const bf16_t*)(ws + WS_WDN), MT, DM, FF};
        { StaticOrder S; S.init(MP, DM, G, bx, FF); EpiDown E{A.out + O_Y, (const float*)(ws + WS_CTL), (const bf16_t*)(ws + WS_HG), A.in[I_MNG]};
          gemm_phase<EpiDown, StaticOrder, true, true>(lds, g, S, E); }
        { SampleSplitOrder<8, 16, 128> S; S.init(G, bx); EpiPartial E{(float*)(ws + WS_PART), 512};
          gemm_phase<EpiPartial, SampleSplitOrder<8, 16, 128>, true, true>(lds, g, S, E); } }
    SEAM(7);
    if (IN(8)) {
        const float* P = (const float*)(ws + WS_PART); const float* rowss = (const float*)(ws + WS_CTL); float* Y = A.out + O_Y + (size_t)MP * DM;
        const bf16* HGs = (const bf16*)(ws + WS_HG) + (size_t)MP * DM;
        for (int idx = vcu * NTHR + tid; idx < 512 * 512; idx += G * NTHR) {
            const int row = idx >> 9, c4 = idx & 511;
            f32x4 s = f32x4{0.f, 0.f, 0.f, 0.f};
#pragma unroll
            for (int k = 0; k < 16; ++k) s += ((const f32x4*)(P + (size_t)k * (512 * 2048)))[idx];
            const float ssr = __hip_atomic_load(rowss + MP + row, __ATOMIC_RELAXED, __HIP_MEMORY_SCOPE_AGENT);
            const float r2 = 1.0f / (ssr * (1.0f / 2048.0f) + 1e-6f);
            const v2u hw = *(const v2u*)(HGs + (size_t)row * DM + 4 * c4); const f32x4 gv = *(const f32x4*)(A.in[I_MNG] + 4 * c4);
            const f32x4 h = f32x4{bflo(hw.x) / gv.x, bfhi(hw.x) / gv.y, bflo(hw.y) / gv.z, bfhi(hw.y) / gv.w};
            ((f32x4*)(Y + (size_t)row * DM))[c4] = h + s * r2;
        }
    }
#undef IN
#undef SEAM
}
template <int LO, int HI> __global__ void __launch_bounds__(NTHR, 2) fwd_t(Args A) { fwd_body<LO, HI>(A); }

extern "C" void kernel_launch(void* const* d_in, const int* in_sizes, int n_in, void* d_out, int out_size, void* d_ws, size_t ws_size, hipStream_t stream) {
    static int grid = 0;
    if (grid == 0) {
        if (n_in != 27 || out_size != (int)O_END || ws_size < WS_END) { fprintf(stderr, "kernel_launch: unexpected shapes: n_in %d out %d ws %zu (need %zu)\n", n_in, out_size, ws_size, (size_t)WS_END); grid = -1; return; }
        int dev = 0, cus = 0, per_cu = 0;
        if (hipGetDevice(&dev) != hipSuccess || hipDeviceGetAttribute(&cus, hipDeviceAttributeMultiprocessorCount, dev) != hipSuccess) { grid = -1; return; }
#if MK_PER_PHASE
        const void* fns[NPHASE] = {(const void*)fwd_t<0, 1>, (const void*)fwd_t<1, 2>, (const void*)fwd_t<2, 3>, (const void*)fwd_t<3, 4>, (const void*)fwd_t<4, 5>, (const void*)fwd_t<5, 6>, (const void*)fwd_t<6, 7>, (const void*)fwd_t<7, 8>, (const void*)fwd_t<8, 9>};
        for (int i = 0; i < NPHASE; ++i) if (hipFuncSetAttribute(fns[i], hipFuncAttributeMaxDynamicSharedMemorySize, LDS_BYTES) != hipSuccess) { fprintf(stderr, "kernel_launch: hipFuncSetAttribute failed\n"); grid = -1; return; }
#else
        if (hipFuncSetAttribute((const void*)fwd_t<0, NPHASE>, hipFuncAttributeMaxDynamicSharedMemorySize, LDS_BYTES) != hipSuccess) { fprintf(stderr, "kernel_launch: hipFuncSetAttribute failed\n"); grid = -1; return; }
        if (hipOccupancyMaxActiveBlocksPerMultiprocessor(&per_cu, (const void*)fwd_t<0, NPHASE>, NTHR, LDS_BYTES) != hipSuccess || per_cu < 1) { fprintf(stderr, "kernel_launch: occupancy query says %d\n", per_cu); per_cu = 1; }
#endif
        (void)hipGetLastError();
        grid = cus;
    }
    if (grid < 0) return;
    (void)hipMemsetAsync((char*)d_ws + WS_CTL, 0, CTL_ZERO_BYTES, stream);
    Args a{};
    for (int i = 0; i < 27; ++i) a.in[i] = (const float*)d_in[i];
    a.out = (float*)d_out; a.ws = (unsigned char*)d_ws;
#if MK_PER_PHASE
    hipLaunchKernelGGL((fwd_t<0, 1>), dim3(grid), dim3(NTHR), LDS_BYTES, stream, a);
#if defined(DUP_PHASE)
    if (DUP_PHASE == 0) hipLaunchKernelGGL((fwd_t<0, 1>), dim3(grid), dim3(NTHR), LDS_BYTES, stream, a);
#endif
    hipLaunchKernelGGL((fwd_t<1, 2>), dim3(grid), dim3(NTHR), LDS_BYTES, stream, a);
#if defined(DUP_PHASE)
    if (DUP_PHASE == 1) hipLaunchKernelGGL((fwd_t<1, 2>), dim3(grid), dim3(NTHR), LDS_BYTES, stream, a);
#endif
    hipLaunchKernelGGL((fwd_t<2, 3>), dim3(grid), dim3(NTHR), LDS_BYTES, stream, a);
#if defined(DUP_PHASE)
    if (DUP_PHASE == 2) hipLaunchKernelGGL((fwd_t<2, 3>), dim3(grid), dim3(NTHR), LDS_BYTES, stream, a);
#endif
    hipLaunchKernelGGL((fwd_t<3, 4>), dim3(grid), dim3(NTHR), LDS_BYTES, stream, a);
#if defined(DUP_PHASE)
    if (DUP_PHASE == 3) hipLaunchKernelGGL((fwd_t<3, 4>), dim3(grid), dim3(NTHR), LDS_BYTES, stream, a);
#endif
    hipLaunchKernelGGL((fwd_t<4, 5>), dim3(grid), dim3(NTHR), LDS_BYTES, stream, a);
#if defined(DUP_PHASE)
    if (DUP_PHASE == 4) hipLaunchKernelGGL((fwd_t<4, 5>), dim3(grid), dim3(NTHR), LDS_BYTES, stream, a);
#endif
    hipLaunchKernelGGL((fwd_t<5, 6>), dim3(grid), dim3(NTHR), LDS_BYTES, stream, a);
#if defined(DUP_PHASE)
    if (DUP_PHASE == 5) hipLaunchKernelGGL((fwd_t<5, 6>), dim3(grid), dim3(NTHR), LDS_BYTES, stream, a);
#endif
    hipLaunchKernelGGL((fwd_t<6, 7>), dim3(grid), dim3(NTHR), LDS_BYTES, stream, a);
#if defined(DUP_PHASE)
    if (DUP_PHASE == 6) hipLaunchKernelGGL((fwd_t<6, 7>), dim3(grid), dim3(NTHR), LDS_BYTES, stream, a);
#endif
    hipLaunchKernelGGL((fwd_t<7, 8>), dim3(grid), dim3(NTHR), LDS_BYTES, stream, a);
#if defined(DUP_PHASE)
    if (DUP_PHASE == 7) hipLaunchKernelGGL((fwd_t<7, 8>), dim3(grid), dim3(NTHR), LDS_BYTES, stream, a);
#endif
    hipLaunchKernelGGL((fwd_t<8, 9>), dim3(grid), dim3(NTHR), LDS_BYTES, stream, a);
#if defined(DUP_PHASE)
    if (DUP_PHASE == 8) hipLaunchKernelGGL((fwd_t<8, 9>), dim3(grid), dim3(NTHR), LDS_BYTES, stream, a);
#endif
#else
    a.ph_lo = 0; a.ph_hi = NPHASE;
    void* kargs[] = {&a};
    hipError_t e = hipLaunchCooperativeKernel((const void*)fwd_t<0, NPHASE>, dim3(grid), dim3(NTHR), kargs, LDS_BYTES, stream);
    if (e != hipSuccess) fprintf(stderr, "cooperative launch failed: %s (grid %d)\n", hipGetErrorString(e), grid);
#endif
}
```

```cpp
#ifndef MK_PER_PHASE
#define MK_PER_PHASE 0
#endif
#include <hip/hip_runtime.h>
#include <hip/hip_cooperative_groups.h>
#include <cstdio>
#include <cstdint>
namespace cg = cooperative_groups;
namespace pg8 {
#define PG8_LAS __attribute__((address_space(3)))
typedef unsigned short bf16_t;
typedef short bf16x8 __attribute__((ext_vector_type(8)));
typedef float f32x4 __attribute__((ext_vector_type(4)));
typedef unsigned u32x4 __attribute__((ext_vector_type(4)));
constexpr int BM = 256, BK = 64, HALF = 128, HTB = HALF * BK * 2  , STAGE_BYTES = 8 * HTB, NXCD = 8, WGM = 8;

__host__ __device__ __forceinline__ int lds_byte(int r, int c) { const int st = (r >> 4) * 2 + (c >> 5), rr = r & 15, cc = c & 31, ob = rr * 64 + cc * 2; return st * 1024 + (ob ^ (((ob >> 9) & 1) << 5)); }
__host__ __device__ __forceinline__ void stage_rc(int b, int& R, int& C) { const int st = b / 1024, sb = b % 1024, swz = sb ^ (((sb >> 9) & 1) << 5); R = (st >> 1) * 16 + swz / 64; C = (st & 1) * 32 + (swz % 64) / 2; }
__host__ __device__ __forceinline__ int perm32(int rho) { const int n = rho >> 4, i = rho & 15; return 8 * (i >> 2) + 4 * n + (i & 3); }

struct Unit { int pm, pn, k0, nt, cont; };
struct Gemm { const bf16_t* A; const bf16_t* Bt; int M, N, K; };

struct StaticOrder {
    int nM, nN, nwg, G, c, ntk;
    __host__ __device__ void init(int M, int N, int G_, int c_, int K) { nM = M / BM; nN = N / BM; nwg = nM * nN; G = G_; c = c_; ntk = K / BK; }
    __host__ __device__ bool next(int i, Unit& u) const {
        const long L = (long)i * G + c; if (L >= nwg) return false;
        int wgid = (int)L; { const int q = nwg / NXCD, r = nwg % NXCD, xcd = wgid % NXCD, off = wgid / NXCD; wgid = (xcd < r ? xcd * (q + 1) : r * (q + 1) + (xcd - r) * q) + off; }
        const int nig = WGM * nN, gid = wgid / nig, fm = gid * WGM, gsz = (nM - fm) < WGM ? (nM - fm) : WGM;
        u.pm = fm + ((wgid % nig) % gsz); u.pn = (wgid % nig) / gsz; u.k0 = 0; u.nt = ntk; u.cont = 0; return true;
    }
    __device__ __forceinline__ void a_ready(const Unit&) const {}
    __device__ __forceinline__ void done(const Unit&) const {}
};

__device__ __forceinline__ unsigned cvt_pk_bf16(float lo, float hi) { unsigned r; asm volatile("v_cvt_pk_bf16_f32 %0, %1, %2" : "=v"(r) : "v"(lo), "v"(hi)); return r; }
typedef float f32x2 __attribute__((ext_vector_type(2)));
__device__ __forceinline__ float bf_lo(unsigned w) { return __uint_as_float(w << 16); }
__device__ __forceinline__ float bf_hi(unsigned w) { return __uint_as_float(w & 0xffff0000u); }
template <int ACT> struct EpiStoreBf16 {
    static constexpr bool PERM = true, AFTER_DRAIN = false, MIDK = false;
    bf16_t* O; int ldc;
    __device__ __forceinline__ void operator()(const f32x4 (&acc)[2][2][4][2], const Unit& u, int wr, int wc, int fr, int fq) const {
        const int row0 = u.pm * BM + wr * 64 + fr; const int col0 = u.pn * BM + wc * 32 + 8 * fq;
#pragma unroll
        for (int ai = 0; ai < 2; ++ai)
#pragma unroll
            for (int m = 0; m < 4; ++m) { bf16_t* rowp = O + (size_t)(row0 + ai * HALF + m * 16) * ldc + col0;
#pragma unroll
                for (int bj = 0; bj < 2; ++bj) { f32x4 v0 = acc[ai][bj][m][0], v1 = acc[ai][bj][m][1];
                    if (ACT == 2) {
#pragma unroll
                        for (int i = 0; i < 4; ++i) { const float a = fmaxf(v0[i], 0.f), b = fmaxf(v1[i], 0.f); v0[i] = a * a; v1[i] = b * b; } }
                    u32x4 w; w.x = cvt_pk_bf16(v0[0], v0[1]); w.y = cvt_pk_bf16(v0[2], v0[3]); w.z = cvt_pk_bf16(v1[0], v1[1]); w.w = cvt_pk_bf16(v1[2], v1[3]);
                    *(u32x4*)(rowp + bj * HALF) = w; } }
    }
};
struct EpiGlu {
    static constexpr bool PERM = true, AFTER_DRAIN = false, MIDK = false;
    const bf16_t* Gm; bf16_t* O; const float* bias; float* rowss;
    __device__ __forceinline__ void operator()(const f32x4 (&acc)[2][2][4][2], const Unit& u, int wr, int wc, int fr, int fq) const {
        const int row0 = u.pm * BM + wr * 64 + fr; const int col0 = u.pn * BM + wc * 32 + 8 * fq;
        float ssq[8];
#pragma unroll
        for (int i = 0; i < 8; ++i) ssq[i] = 0.f;
#pragma unroll
        for (int bj = 0; bj < 2; ++bj) { const f32x4 b0 = *(const f32x4*)(bias + col0 + bj * HALF), b1 = *(const f32x4*)(bias + col0 + bj * HALF + 4);
#pragma unroll
            for (int ai = 0; ai < 2; ++ai)
#pragma unroll
                for (int m = 0; m < 4; ++m) { const size_t row = (size_t)(row0 + ai * HALF + m * 16); const int col = col0 + bj * HALF;
                    const u32x4 gw = *(const u32x4*)(Gm + row * 1024 + col);
                    const f32x4 a0 = acc[ai][bj][m][0] + b0, a1 = acc[ai][bj][m][1] + b1;
                    float g[8] = {bf_lo(gw.x), bf_hi(gw.x), bf_lo(gw.y), bf_hi(gw.y), bf_lo(gw.z), bf_hi(gw.z), bf_lo(gw.w), bf_hi(gw.w)};
                    float o[8]; float sq = 0.f;
#pragma unroll
                    for (int i = 0; i < 4; ++i) { o[i] = g[i] / (1.f + __expf(-a0[i])); o[4 + i] = g[4 + i] / (1.f + __expf(-a1[i])); }
#pragma unroll
                    for (int i = 0; i < 8; ++i) sq += o[i] * o[i];
                    ssq[ai * 4 + m] += sq;
                    u32x4 w; w.x = cvt_pk_bf16(o[0], o[1]); w.y = cvt_pk_bf16(o[2], o[3]); w.z = cvt_pk_bf16(o[4], o[5]); w.w = cvt_pk_bf16(o[6], o[7]);
                    *(u32x4*)(O + row * 2048 + 1024 + col) = w; } }
#pragma unroll
        for (int ai = 0; ai < 2; ++ai)
#pragma unroll
            for (int m = 0; m < 4; ++m) { float v = ssq[ai * 4 + m]; v += __shfl_xor(v, 16); v += __shfl_xor(v, 32);
                if (fq == 0) unsafeAtomicAdd(rowss + row0 + ai * HALF + m * 16, v); }
    }
};
struct EpiHres {
    static constexpr bool PERM = false, AFTER_DRAIN = false, MIDK = true;
    const bf16_t* XN; const float* xrms; const float* ga; bf16_t* HG; const float* gm; float* rowss; const float* ssa; const float* sss;
    __device__ __forceinline__ float rnorm(const float* p, int row) const { return rsqrtf(__hip_atomic_load(p + row, __ATOMIC_RELAXED, __HIP_MEMORY_SCOPE_AGENT) * (1.0f / 1024.0f) + 1e-6f); }
    __device__ __forceinline__ void midk(f32x4 (&acc)[2][2][4][2], const Unit& u, int wr, int fr) const {
        int br = u.pm * BM + wr * 64 + fr; asm volatile("" : "+v"(br) :: "memory");
        const float* pa = ssa + br; const float* ps = sss + br;
#pragma unroll
        for (int ai = 0; ai < 2; ++ai)
#pragma unroll
            for (int m = 0; m < 4; ++m) { const int o = ai * HALF + m * 16;
                const float va = __hip_atomic_load(pa + o, __ATOMIC_RELAXED, __HIP_MEMORY_SCOPE_AGENT), vs = __hip_atomic_load(ps + o, __ATOMIC_RELAXED, __HIP_MEMORY_SCOPE_AGENT);
                const float ratio = rsqrtf(va * (1.0f / 1024.0f) + 1e-6f) * sqrtf(vs * (1.0f / 1024.0f) + 1e-6f);
#pragma unroll
                for (int bj = 0; bj < 2; ++bj)
#pragma unroll
                    for (int n = 0; n < 2; ++n) acc[ai][bj][m][n] *= ratio; }
    }
    __device__ __forceinline__ void operator()(const f32x4 (&acc)[2][2][4][2], const Unit& u, int wr, int wc, int fr, int fq) const {
        typedef unsigned u32x2v __attribute__((ext_vector_type(2)));
        const int colb = u.pn * BM + wc * 32 + 4 * fq;
#pragma unroll
        for (int ai = 0; ai < 2; ++ai)
#pragma unroll
            for (int m = 0; m < 4; ++m) { const int row = u.pm * BM + ai * HALF + wr * 64 + m * 16 + fr;
                const bf16_t* xrow = XN + (size_t)row * 2048; const float xr = xrms[row];
                const float rs = rnorm(sss, row);
                float ss = 0.f;
#pragma unroll
                for (int bj = 0; bj < 2; ++bj)
#pragma unroll
                    for (int n = 0; n < 2; ++n) { const int col = colb + bj * HALF + n * 16;
                        const u32x2v xw = *(const u32x2v*)(xrow + col); const f32x4 gav = *(const f32x4*)(ga + col); const f32x4 gv = *(const f32x4*)(gm + col);
                        const f32x4 xv = f32x4{bf_lo(xw.x) * __builtin_amdgcn_rcpf(gav[0]), bf_hi(xw.x) * __builtin_amdgcn_rcpf(gav[1]), bf_lo(xw.y) * __builtin_amdgcn_rcpf(gav[2]), bf_hi(xw.y) * __builtin_amdgcn_rcpf(gav[3])} * xr;
                        const f32x4 h = xv + acc[ai][bj][m][n] * rs;
                        ss += (h[0] * h[0] + h[1] * h[1]) + (h[2] * h[2] + h[3] * h[3]);
                        u32x2v w; w.x = cvt_pk_bf16(h[0] * gv[0], h[1] * gv[1]); w.y = cvt_pk_bf16(h[2] * gv[2], h[3] * gv[3]);
                        *(u32x2v*)(HG + (size_t)row * 2048 + col) = w; }
                ss += __shfl_xor(ss, 16); ss += __shfl_xor(ss, 32);
                if (fq == 0) unsafeAtomicAdd(rowss + row, ss);
                asm volatile("" ::: "memory"); }
    }
};
struct EpiDown {
    static constexpr bool PERM = false, AFTER_DRAIN = false, MIDK = false;
    float* Y; const float* rowss; const bf16_t* HG; const float* gm;
    __device__ __forceinline__ void operator()(const f32x4 (&acc)[2][2][4][2], const Unit& u, int wr, int wc, int fr, int fq) const {
        typedef unsigned u32x2v __attribute__((ext_vector_type(2)));
        const int colb = u.pn * BM + wc * 32 + 4 * fq;
        f32x4 gi[2][2];
#pragma unroll
        for (int bj = 0; bj < 2; ++bj)
#pragma unroll
            for (int n = 0; n < 2; ++n) { const f32x4 gv = *(const f32x4*)(gm + colb + bj * HALF + n * 16);
                gi[bj][n] = f32x4{__builtin_amdgcn_rcpf(gv[0]), __builtin_amdgcn_rcpf(gv[1]), __builtin_amdgcn_rcpf(gv[2]), __builtin_amdgcn_rcpf(gv[3])}; }
#pragma unroll
        for (int ai = 0; ai < 2; ++ai)
#pragma unroll
            for (int m = 0; m < 4; ++m) { const int row = u.pm * BM + ai * HALF + wr * 64 + m * 16 + fr;
                const float ssr = __hip_atomic_load(rowss + row, __ATOMIC_RELAXED, __HIP_MEMORY_SCOPE_AGENT);
                const float r2 = 1.0f / (ssr * (1.0f / 2048.0f) + 1e-6f);
#pragma unroll
                for (int bj = 0; bj < 2; ++bj)
#pragma unroll
                    for (int n = 0; n < 2; ++n) { const size_t off = (size_t)row * 2048 + colb + bj * HALF + n * 16;
                        const u32x2v hw = *(const u32x2v*)(HG + off);
                        const f32x4 h = f32x4{bf_lo(hw.x), bf_hi(hw.x), bf_lo(hw.y), bf_hi(hw.y)} * gi[bj][n];
                        *(f32x4*)(Y + off) = h + acc[ai][bj][m][n] * r2; } }
    }
};
struct EpiPartial {
    static constexpr bool PERM = false, AFTER_DRAIN = false, MIDK = false;
    float* P; int kper;
    __device__ __forceinline__ void operator()(const f32x4 (&acc)[2][2][4][2], const Unit& u, int wr, int wc, int fr, int fq) const {
        const int colb = u.pn * BM + wc * 32 + 4 * fq; float* base = P + (size_t)(u.k0 / kper) * (512 * 2048);
#pragma unroll
        for (int ai = 0; ai < 2; ++ai)
#pragma unroll
            for (int m = 0; m < 4; ++m) { const int row = (u.pm - 64) * BM + ai * HALF + wr * 64 + m * 16 + fr;
#pragma unroll
                for (int bj = 0; bj < 2; ++bj)
#pragma unroll
                    for (int n = 0; n < 2; ++n) *(f32x4*)(base + (size_t)row * 2048 + colb + bj * HALF + n * 16) = acc[ai][bj][m][n]; }
    }
};
template <int NN  , int NS  , int NTK  > struct SampleSplitOrder {
    int G, c;
    __device__ __forceinline__ void init(int G_, int c_) { G = G_; c = c_; }
    __device__ __forceinline__ bool next(int i, Unit& u) const {
        const int item = i * G + c; if (item >= 2 * NN * NS) return false;
        const int t = item / NS, s = item % NS; u.pm = 64 + t / NN; u.pn = t % NN; u.nt = NTK / NS; u.k0 = s * (NTK / NS) * BK; u.cont = 0; return true;
    }
    __device__ __forceinline__ void a_ready(const Unit&) const {}
    __device__ __forceinline__ void done(const Unit&) const {}
};

struct HalfKOrder {
    StaticOrder base;
    __device__ __forceinline__ void init(int M, int N, int G_, int c_, int K) { base.init(M, N, G_, c_, K); }
    __device__ __forceinline__ bool next(int i, Unit& u) const {
        if (!base.next(i >> 1, u)) return false;
        u.nt = base.ntk >> 1; u.k0 = (i & 1) * u.nt * BK; u.cont = (i & 1) ^ 1; return true;
    }
    __device__ __forceinline__ void a_ready(const Unit&) const {}
    __device__ __forceinline__ void done(const Unit&) const {}
};

template <class Epi, class Sched, bool ALIGN_EPI = false, bool SP2 = false>
__device__ __forceinline__ void gemm_phase(PG8_LAS unsigned char* lds, const Gemm g, const Sched& S, const Epi& E) {
    int tid_ = threadIdx.x; asm volatile("" : "+v"(tid_));
    const int tid = tid_, wid = __builtin_amdgcn_readfirstlane(tid >> 6), lane = tid & 63, wr = wid >> 2, wc = wid & 3, fr = lane & 15, fq = lane >> 4;
    const int K = g.K; int nt;
    unsigned voffA[2], voffB[2];
#pragma unroll
    for (int i = 0; i < 2; ++i) { int R, C; stage_rc(tid * 16 + i * 8192, R, C); const int Rb = Epi::PERM ? ((R & ~31) + perm32(R & 31)) : R;
        voffA[i] = (unsigned)(R * K + C) * 2u; voffB[i] = (unsigned)(Rb * K + C) * 2u; }
    const size_t kstep = (size_t)(BK * 2);
    const size_t hstep = (size_t)HALF * K * 2;
    const size_t tstep = 2 * hstep;
    const unsigned ldsw = (unsigned)wid * 1024u;
    const int aoff = lds_byte(wr * 64 + fr, fq * 8), boff = lds_byte(wc * 32 + fr, fq * 8);
#define PG8_SA(b, h) (((b) * 2 + (h)) * HTB)
#define PG8_SB(b, h) ((4 + (b) * 2 + (h)) * HTB)
#define PG8_STAGE(bufoff, gbase, voff) do { _Pragma("unroll") for (int _i = 0; _i < 2; ++_i) \
        __builtin_amdgcn_global_load_lds((const unsigned*)((const char*)(gbase) + (voff)[_i]), (PG8_LAS unsigned*)(lds + (bufoff) + ldsw + _i * 8192), 16, 0, 0); } while (0)
#define PG8_LDA(dst, b, h) do { _Pragma("unroll") for (int m = 0; m < 4; ++m) _Pragma("unroll") for (int k = 0; k < 2; ++k) dst[m][k] = *(const PG8_LAS bf16x8*)(lds + PG8_SA(b, h) + aoff + m * 2048 + k * 1024); } while (0)
#define PG8_LDB(dst, b, h) do { _Pragma("unroll") for (int n = 0; n < 2; ++n) _Pragma("unroll") for (int k = 0; k < 2; ++k) dst[n][k] = *(const PG8_LAS bf16x8*)(lds + PG8_SB(b, h) + boff + n * 2048 + k * 1024); } while (0)
#define PG8_MMA(ai, bj, At, Bt) do { __builtin_amdgcn_s_setprio(1); _Pragma("unroll") for (int m = 0; m < 4; ++m) _Pragma("unroll") for (int n = 0; n < 2; ++n) _Pragma("unroll") for (int k = 0; k < 2; ++k) \
        acc[ai][bj][m][n] = __builtin_amdgcn_mfma_f32_16x16x32_bf16(Bt[n][k], At[m][k], acc[ai][bj][m][n], 0, 0, 0); __builtin_amdgcn_s_setprio(0); } while (0)
#define PG8_WAIT_V(n) asm volatile("s_waitcnt vmcnt(" #n ")" ::: "memory")
#define PG8_WAIT_L(n) asm volatile("s_waitcnt lgkmcnt(" #n ")" ::: "memory")
#define PG8_BAR __builtin_amdgcn_s_barrier()
#define PG8_SCHED __builtin_amdgcn_sched_barrier(0)
    Unit cur, nxt; int ui = 0;
    if (!S.next(0, cur)) return;
    nt = cur.nt;
    f32x4 acc[2][2][4][2];
#pragma unroll
    for (int a = 0; a < 2; ++a)
#pragma unroll
        for (int b = 0; b < 2; ++b)
#pragma unroll
            for (int m = 0; m < 4; ++m)
#pragma unroll
                for (int n = 0; n < 2; ++n) acc[a][b][m][n] = (f32x4){0.f, 0.f, 0.f, 0.f};
    bf16x8 At[4][2], B0[2][2], B1[2][2];
    const char* cA = (const char*)g.A + (size_t)cur.pm * tstep + (size_t)cur.k0 * 2; const char* cB = (const char*)g.Bt + (size_t)cur.pn * tstep + (size_t)cur.k0 * 2;
    S.a_ready(cur);
    if constexpr (SP2) {
        PG8_STAGE(PG8_SB(0, 0), cB, voffB); PG8_STAGE(PG8_SB(0, 1), cB + hstep, voffB); PG8_STAGE(PG8_SA(0, 0), cA, voffA); PG8_STAGE(PG8_SA(0, 1), cA + hstep, voffA);
        if (wr == 1) PG8_BAR;
        PG8_WAIT_V(2); PG8_BAR;
        PG8_STAGE(PG8_SB(1, 0), cB + kstep, voffB); PG8_STAGE(PG8_SA(1, 0), cA + kstep, voffA); PG8_STAGE(PG8_SB(1, 1), cB + hstep + kstep, voffB);
        PG8_WAIT_V(6); PG8_BAR;
    } else {
        PG8_STAGE(PG8_SB(0, 0), cB, voffB); PG8_STAGE(PG8_SA(0, 0), cA, voffA); PG8_STAGE(PG8_SB(0, 1), cB + hstep, voffB); PG8_STAGE(PG8_SA(0, 1), cA + hstep, voffA);
        if (wr == 1) PG8_BAR;
        PG8_WAIT_V(4); PG8_BAR;
        PG8_STAGE(PG8_SB(1, 0), cB + kstep, voffB); PG8_STAGE(PG8_SA(1, 0), cA + kstep, voffA); PG8_STAGE(PG8_SB(1, 1), cB + hstep + kstep, voffB);
        PG8_WAIT_V(6); PG8_BAR;
    }
    for (;;) {
        const bool has_next = S.next(ui + 1, nxt);
        const char* nA = has_next ? (const char*)g.A + (size_t)nxt.pm * tstep + (size_t)nxt.k0 * 2 : cA; const char* nB = has_next ? (const char*)g.Bt + (size_t)nxt.pn * tstep + (size_t)nxt.k0 * 2 : cB;
        for (int t = 0; t < nt; t += 2) {
            if constexpr (Epi::MIDK) { if (t == (nt >> 1)) E.midk(acc, cur, wr, fr); }
            const bool last = (t == nt - 2);
            const char* a1 = cA + (size_t)(t + 1) * kstep;
            const char* a2 = last ? nA : cA + (size_t)(t + 2) * kstep; const char* b2 = last ? nB : cB + (size_t)(t + 2) * kstep;
            const char* a3 = a2 + kstep; const char* b3 = b2 + kstep;
            if (last && has_next) S.a_ready(nxt);
            if constexpr (SP2) {
            PG8_LDB(B0, 0, 0); PG8_LDB(B1, 0, 1); PG8_SCHED; PG8_LDA(At, 0, 0); PG8_STAGE(PG8_SA(1, 1), a1 + hstep, voffA);
            PG8_WAIT_V(8); PG8_WAIT_L(0); PG8_BAR; PG8_MMA(0, 0, At, B0); PG8_MMA(0, 1, At, B1); PG8_BAR; PG8_SCHED;
            PG8_LDA(At, 0, 1); PG8_STAGE(PG8_SB(0, 0), b2, voffB); PG8_STAGE(PG8_SB(0, 1), b2 + hstep, voffB); PG8_STAGE(PG8_SA(0, 0), a2, voffA);
            PG8_WAIT_V(8); PG8_WAIT_L(0); PG8_BAR; PG8_MMA(1, 0, At, B0); PG8_MMA(1, 1, At, B1); PG8_BAR; PG8_SCHED;
            PG8_LDB(B0, 1, 0); PG8_LDB(B1, 1, 1); PG8_SCHED; PG8_LDA(At, 1, 0); PG8_STAGE(PG8_SA(0, 1), a2 + hstep, voffA);
            PG8_WAIT_V(8); PG8_WAIT_L(0); PG8_BAR; PG8_MMA(0, 0, At, B0); PG8_MMA(0, 1, At, B1); PG8_BAR; PG8_SCHED;
            PG8_LDA(At, 1, 1); PG8_STAGE(PG8_SB(1, 0), b3, voffB); PG8_STAGE(PG8_SB(1, 1), b3 + hstep, voffB); PG8_STAGE(PG8_SA(1, 0), a3, voffA);
            PG8_WAIT_V(8); PG8_WAIT_L(0); PG8_BAR; PG8_MMA(1, 0, At, B0); PG8_MMA(1, 1, At, B1); PG8_BAR; PG8_SCHED;
            } else {
            PG8_LDB(B0, 0, 0); PG8_SCHED; PG8_LDA(At, 0, 0); PG8_STAGE(PG8_SA(1, 1), a1 + hstep, voffA);
            PG8_WAIT_L(8); PG8_BAR; PG8_WAIT_L(0); PG8_MMA(0, 0, At, B0); PG8_BAR; PG8_SCHED;
            PG8_LDB(B1, 0, 1); PG8_STAGE(PG8_SB(0, 0), b2, voffB);
            PG8_BAR; PG8_WAIT_L(0); PG8_MMA(0, 1, At, B1); PG8_BAR;
            PG8_LDA(At, 0, 1); PG8_STAGE(PG8_SA(0, 0), a2, voffA);
            PG8_BAR; PG8_WAIT_L(0); PG8_MMA(1, 0, At, B0); PG8_BAR; PG8_SCHED;
            PG8_STAGE(PG8_SB(0, 1), b2 + hstep, voffB);
            PG8_WAIT_V(6); PG8_BAR; PG8_MMA(1, 1, At, B1); PG8_BAR;
            PG8_LDB(B0, 1, 0); PG8_SCHED; PG8_LDA(At, 1, 0); PG8_STAGE(PG8_SA(0, 1), a2 + hstep, voffA);
            PG8_WAIT_L(8); PG8_BAR; PG8_WAIT_L(0); PG8_MMA(0, 0, At, B0); PG8_BAR; PG8_SCHED;
            PG8_LDB(B1, 1, 1); PG8_STAGE(PG8_SB(1, 0), b3, voffB);
            PG8_BAR; PG8_WAIT_L(0); PG8_MMA(0, 1, At, B1); PG8_BAR;
            PG8_LDA(At, 1, 1); PG8_STAGE(PG8_SA(1, 0), a3, voffA);
            PG8_BAR; PG8_WAIT_L(0); PG8_MMA(1, 0, At, B0); PG8_BAR; PG8_SCHED;
            PG8_STAGE(PG8_SB(1, 1), b3 + hstep, voffB);
            PG8_WAIT_V(6); PG8_BAR; PG8_MMA(1, 1, At, B1); PG8_BAR;
            }
        }
        if constexpr (ALIGN_EPI) { if (wr == 0) PG8_BAR; }
        if constexpr (!Epi::AFTER_DRAIN) { E(acc, cur, wr, wc, fr, fq); S.done(cur); }
        if (!has_next) break;
#pragma unroll
        for (int a = 0; a < 2; ++a)
#pragma unroll
            for (int b = 0; b < 2; ++b)
#pragma unroll
                for (int m = 0; m < 4; ++m)
#pragma unroll
                    for (int n = 0; n < 2; ++n) acc[a][b][m][n] = (f32x4){0.f, 0.f, 0.f, 0.f};
        cur = nxt; cA = nA; cB = nB; ++ui; nt = cur.nt;
        if constexpr (ALIGN_EPI) { if (wr == 1) PG8_BAR; }
    }
    PG8_WAIT_V(0);
    if constexpr (!ALIGN_EPI) { if (wr == 0) PG8_BAR; }
    PG8_BAR;
    if constexpr (Epi::AFTER_DRAIN) { E.fused(acc, cur, wr, wc, fr, fq, lds, wid, lane); S.done(cur); }
#undef PG8_SA
#undef PG8_SB
#undef PG8_STAGE
#undef PG8_LDA
#undef PG8_LDB
#undef PG8_MMA
#undef PG8_WAIT_V
#undef PG8_WAIT_L
#undef PG8_BAR
#undef PG8_SCHED
}
}

#define LAS __attribute__((address_space(3)))
typedef unsigned short bf16;
typedef unsigned v4u __attribute__((ext_vector_type(4)));
typedef unsigned v2u __attribute__((ext_vector_type(2)));
typedef float f32x4 __attribute__((ext_vector_type(4)));
typedef float f32x16 __attribute__((ext_vector_type(16)));
typedef float f32x2 __attribute__((ext_vector_type(2)));
typedef short bf16x8 __attribute__((ext_vector_type(8)));

#ifndef MK_PER_PHASE
#define MK_PER_PHASE 0
#endif
constexpr int NPHASE = 9;
constexpr int NWAVES = 8, NTHR = 512;
constexpr int MP = 16384, MS = 512, MT = MP + MS;
constexpr int DM = 2048, PW = 2560, AW = 1024, SWD = 1024, FF = 8192;
constexpr float EPSN = 1e-6f, LOG2E = 1.4426950408889634f;
constexpr int LDS_PHASE = 152576;
constexpr int LDS_BYTES = LDS_PHASE + 64;

constexpr size_t MiB = 1u << 20;
constexpr size_t WS_CTL = 0, CTL_ZERO_BYTES = 272 * 1024, WS_BAR = 96 * 1024, WS_SSA = 128 * 1024, WS_SSS = 200 * 1024, WS_XR = 512 * 1024;
constexpr size_t WS_WIN = 1 * MiB, WS_WGLU = 11 * MiB, WS_WOUT = 13 * MiB, WS_WUP = 21 * MiB, WS_WDN = 53 * MiB;
constexpr size_t WS_WSF = 85 * MiB, WS_WHF = 89 * MiB, WS_TF = 93 * MiB, WS_LAM = 94 * MiB + 512 * 1024, WS_LAM16 = WS_LAM + 32768, WS_BBAR = WS_LAM + 65536;
constexpr size_t WS_HG = 96 * MiB;
constexpr size_t WS_PART = 426 * MiB;
constexpr size_t WS_ACT = 162 * MiB;
constexpr size_t WS_XN = 162 * MiB, WS_Z = 228 * MiB, WS_ATT = 311 * MiB, WS_G = 344 * MiB, WS_SO = 377 * MiB, WS_MIX = 410 * MiB, WS_END = 490 * MiB;

constexpr size_t O_Y = 0, O_KP = (size_t)MT * DM, O_VP = O_KP + 262144, O_RP = O_VP + 262144, O_IP = O_RP + 32768, O_KS = O_IP + 32768,
                 O_VS = O_KS + 4194304, O_RS = O_VS + 4194304, O_IS = O_RS + 524288, O_END = O_IS + 524288;

struct Args { const float* in[27]; float* out; unsigned char* ws; int ph_lo, ph_hi; };
enum { I_XP = 0, I_XS, I_CK, I_CV, I_SR, I_SI, I_ANG, I_WIN, I_QG, I_KG, I_SINK, I_ARE, I_AIM, I_LDT, I_BRE, I_BIM, I_CRE, I_CIM, I_D, I_WGLU, I_BGLU,
       I_AOG, I_SOG, I_WOUT, I_MNG, I_WUP, I_WDN };

__device__ __forceinline__ unsigned pk2(float lo, float hi) { unsigned r; asm("v_cvt_pk_bf16_f32 %0, %1, %2" : "=v"(r) : "v"(lo), "v"(hi)); return r; }
__device__ __forceinline__ unsigned f2bf(float f) { return pk2(f, 0.f) & 0xffffu; }
__device__ __forceinline__ float bflo(unsigned w) { return __uint_as_float(w << 16); }
__device__ __forceinline__ float bfhi(unsigned w) { return __uint_as_float(w & 0xffff0000u); }
__device__ __forceinline__ float wave_sum(float v) {
#pragma unroll
    for (int o = 1; o < 64; o <<= 1) v += __shfl_xor(v, o);
    return v;
}
__device__ __forceinline__ int crow(int r, int hi) { return (r & 3) + 8 * (r >> 2) + 4 * hi; }
__device__ __forceinline__ float gelu_tanh(float y) { const float z = 1.5957691216057308f * (y + 0.044715f * y * y * y); return y / (1.f + __expf(-z)); }

__device__ __forceinline__ void p0_transpose_item(const float* W, int K, int N, bf16* WT, LAS float* scr, int item, int lane, const float* g0 = nullptr, const float* g1 = nullptr) {
    const int nblk = N / 32, kb = item / nblk, nb = item % nblk, k0 = 64 * kb, n0 = 32 * nb;
    f32x4 v[8];
#pragma unroll
    for (int i = 0; i < 8; ++i) v[i] = *(const f32x4*)(W + (size_t)(k0 + 8 * i + (lane >> 3)) * N + n0 + 4 * (lane & 7));
#pragma unroll
    for (int i = 0; i < 8; ++i) { LAS float* d = scr + (8 * i + (lane >> 3)) * 33 + 4 * (lane & 7); float gs = 1.f; if (g0) { const int k = k0 + 8 * i + (lane >> 3); gs = k < (K >> 1) ? g0[k] : g1[k - (K >> 1)]; }
        d[0] = v[i].x * gs; d[1] = v[i].y * gs; d[2] = v[i].z * gs; d[3] = v[i].w * gs; }
    asm volatile("s_waitcnt lgkmcnt(0)" ::: "memory");
    const int c = lane & 7;
#pragma unroll
    for (int j = 0; j < 4; ++j) { const int n = (lane >> 3) + 8 * j; const LAS float* s = scr + (8 * c) * 33 + n;
        v4u o; o.x = pk2(s[0 * 33], s[1 * 33]); o.y = pk2(s[2 * 33], s[3 * 33]); o.z = pk2(s[4 * 33], s[5 * 33]); o.w = pk2(s[6 * 33], s[7 * 33]);
        *(v4u*)(WT + (size_t)(n0 + n) * K + k0 + 8 * c) = o; }
    asm volatile("s_waitcnt lgkmcnt(0)" ::: "memory");
}
struct cpx { float re, im; };
__device__ __forceinline__ cpx cmul(cpx a, cpx b) { return {a.re * b.re - a.im * b.im, a.re * b.im + a.im * b.re}; }
__device__ __forceinline__ cpx lam_pow(float a, float th, int n) { const float e = expf((float)n * a), x = (float)n * th; return {e * cosf(x), e * sinf(x)}; }
__device__ __forceinline__ cpx zoh_coef(float are, float aim, float dt) {
    const float a = dt * are, th = dt * aim, em1 = expm1f(a), s = sinf(th), c = cosf(th), sh = sinf(0.5f * th);
    const float nr = em1 * c - 2.f * sh * sh, ni = (em1 + 1.f) * s, den = are * are + aim * aim;
    return {(nr * are + ni * aim) / den, (ni * are - nr * aim) / den};
}

__device__ __forceinline__ void p0_prologue(const Args& A, LAS unsigned char* lds, int vcu, int G, int tid, int wave, int lane) {
    unsigned char* ws = A.ws;
    LAS float* scr = (LAS float*)(lds + wave * 8448);
    const int gw = vcu * NWAVES + wave, NGW = G * NWAVES;
    constexpr int I_1 = (DM / 64) * (PW / 32);
    for (int it = gw; it < I_1; it += NGW) p0_transpose_item(A.in[I_WIN], DM, PW, (bf16*)(ws + WS_WIN), scr, it, lane);
    {
        f32x4 gv[8];
#pragma unroll
        for (int j = 0; j < 8; ++j) gv[j] = ((const f32x4*)A.in[I_ANG])[lane + 64 * j];
        bf16* XN = (bf16*)(ws + WS_XN);
        for (int m = gw; m < MT; m += NGW) {
            const float* xrow = m < MP ? A.in[I_XP] + (size_t)m * DM : A.in[I_XS] + (size_t)(m - MP) * DM;
            f32x4 v[8]; float s = 0.f;
#pragma unroll
            for (int j = 0; j < 8; ++j) { v[j] = ((const f32x4*)xrow)[lane + 64 * j]; s += (v[j].x * v[j].x + v[j].y * v[j].y) + (v[j].z * v[j].z + v[j].w * v[j].w); }
            const float r = rsqrtf(wave_sum(s) * (1.f / DM) + EPSN);
            if (lane == 0) ((float*)(ws + WS_XR))[m] = 1.0f / r;
            v2u* o8 = (v2u*)(XN + (size_t)m * DM) + lane;
#pragma unroll
            for (int j = 0; j < 8; ++j) { v2u w; w.x = pk2(v[j].x * r * gv[j].x, v[j].y * r * gv[j].y); w.y = pk2(v[j].z * r * gv[j].z, v[j].w * r * gv[j].w); o8[64 * j] = w; }
        }
    }
    const float* Are = A.in[I_ARE]; const float* Aim = A.in[I_AIM]; const float* Ldt = A.in[I_LDT];
    const float* Bre = A.in[I_BRE]; const float* Bim = A.in[I_BIM]; const float* Cre = A.in[I_CRE]; const float* Cim = A.in[I_CIM];
    const int gt = vcu * NTHR + tid, NT = G * NTHR;
    for (int idx = gt; idx < 4096; idx += NT) {
        const int g = idx >> 6, p = idx & 63; const float dt = expf(Ldt[g]), are = Are[idx], aim = Aim[idx];
        const cpx l1 = lam_pow(dt * are, dt * aim, 1), l16 = lam_pow(dt * are, dt * aim, 16), cf = zoh_coef(are, aim, dt);
        ((float2*)(ws + WS_LAM))[idx] = make_float2(l1.re, l1.im); ((float2*)(ws + WS_LAM16))[idx] = make_float2(l16.re, l16.im);
#pragma unroll 4
        for (int ch = 0; ch < 16; ++ch) { const cpx b = cmul(cf, cpx{Bre[idx * 16 + ch], Bim[idx * 16 + ch]}); ((float2*)(ws + WS_BBAR))[(g * 16 + ch) * 64 + p] = make_float2(b.re, b.im); }
    }
    for (int idx = gt; idx < 64 * 4 * 16 * 64; idx += NT) {
        const int l = idx & 63, s = (idx >> 6) & 15, rt = (idx >> 10) & 3, g = idx >> 12, r32 = l & 31, hi = l >> 5;
        const int m = 32 * rt + r32, p = m & 63, part = m >> 6, gp = g * 64 + p; const float dt = expf(Ldt[g]), are = Are[gp], aim = Aim[gp];
        const cpx w = cmul(lam_pow(dt * are, dt * aim, 15 - s), zoh_coef(are, aim, dt));
        float v[8];
#pragma unroll
        for (int j = 0; j < 8; ++j) { const int ch = 8 * hi + j; const float br = Bre[gp * 16 + ch], bi = Bim[gp * 16 + ch]; v[j] = part ? (w.re * bi + w.im * br) : (w.re * br - w.im * bi); }
        v4u o; o.x = pk2(v[0], v[1]); o.y = pk2(v[2], v[3]); o.z = pk2(v[4], v[5]); o.w = pk2(v[6], v[7]);
        ((v4u*)(ws + WS_WSF))[idx] = o;
    }
    for (int idx = gt; idx < 64 * 8 * 8 * 64; idx += NT) {
        const int l = idx & 63, kb = (idx >> 6) & 7, tt = (idx >> 9) & 7, g = idx >> 12, r32 = l & 31, hi = l >> 5;
        const int ti = r32 >> 4, chp = r32 & 15, tl = 2 * tt + ti; const float dt = expf(Ldt[g]);
        float v[8];
#pragma unroll
        for (int jp = 0; jp < 4; ++jp) { const int p = 8 * kb + 4 * hi + jp, gp = g * 64 + p;
            const cpx w = cmul(cpx{Cre[(g * 16 + chp) * 64 + p], Cim[(g * 16 + chp) * 64 + p]}, lam_pow(dt * Are[gp], dt * Aim[gp], tl + 1));
            v[2 * jp] = w.re; v[2 * jp + 1] = -w.im; }
        v4u o; o.x = pk2(v[0], v[1]); o.y = pk2(v[2], v[3]); o.z = pk2(v[4], v[5]); o.w = pk2(v[6], v[7]);
        ((v4u*)(ws + WS_WHF))[idx] = o;
    }
    __syncthreads();
    for (int g = vcu; g < 64; g += G) {
        LAS f32x2* pw = (LAS f32x2*)lds;
        LAS f32x2* cf = (LAS f32x2*)(lds + 8192);
        LAS float* part = (LAS float*)(lds + 16384);
        { const int p = tid & 63, gp = g * 64 + p; const float dt = expf(Ldt[g]), are = Are[gp], aim = Aim[gp];
          const cpx w0 = lam_pow(dt * are, dt * aim, tid >> 6), w1 = lam_pow(dt * are, dt * aim, (tid >> 6) + 8);
          pw[(tid >> 6) * 64 + p] = f32x2{w0.re, w0.im}; pw[((tid >> 6) + 8) * 64 + p] = f32x2{w1.re, w1.im};
          if (tid < 64) { const cpx c1 = zoh_coef(are, aim, dt); cf[p] = f32x2{c1.re, c1.im}; } }
        __syncthreads();
        const int pair = tid & 255, ph = tid >> 8, chp = pair >> 4, ch = pair & 15;
        {
            float acc[16];
#pragma unroll
            for (int l = 0; l < 16; ++l) acc[l] = 0.f;
            for (int p = 32 * ph; p < 32 * ph + 32; ++p) { const f32x2 c2 = cf[p];
                const cpx q = cmul(cmul(cpx{Cre[(g * 16 + chp) * 64 + p], Cim[(g * 16 + chp) * 64 + p]}, cpx{c2.x, c2.y}), cpx{Bre[(g * 64 + p) * 16 + ch], Bim[(g * 64 + p) * 16 + ch]});
#pragma unroll
                for (int l = 0; l < 16; ++l) { const f32x2 w = pw[l * 64 + p]; acc[l] += q.re * w.x - q.im * w.y; } }
#pragma unroll
            for (int l = 0; l < 16; ++l) part[(ph * 16 + l) * 256 + pair] = acc[l];
        }
        __syncthreads();
        if (tid < 256) {
            bf16* TF = (bf16*)(ws + WS_TF) + (size_t)g * 17 * 512;
            const int hi2 = ch >> 3, j = ch & 7;
#pragma unroll
            for (int l = 0; l < 16; ++l) { const unsigned short v = (unsigned short)f2bf(part[l * 256 + pair] + part[(16 + l) * 256 + pair]);
                TF[(l * 64 + 32 * hi2 + 16 + chp) * 8 + j] = v;
                if (l < 15) TF[((l + 1) * 64 + 32 * hi2 + chp) * 8 + j] = v; }
            TF[(0 * 64 + 32 * hi2 + chp) * 8 + j] = 0;
            TF[(16 * 64 + 32 * hi2 + chp) * 8 + j] = 0; TF[(16 * 64 + 32 * hi2 + 16 + chp) * 8 + j] = 0;
        }
        __syncthreads();
    }
}

constexpr int KLS = 72, VTS = 264;
constexpr int LDS_K = 0, LDS_VT = 256 * KLS * 2;

__device__ __forceinline__ void attn_qtile(const LAS bf16* Kl, const LAS bf16* Vt, int kt0, const bf16x8 (&qf)[4], int iq, float slope2, float sink2, int jmin,
                                           f32x16 (&o)[2], float& inv_denom, int r32, int hi) {
    f32x16 S[5];
#pragma unroll
    for (int t5 = 0; t5 < 5; ++t5) {
        S[t5] = f32x16{};
#pragma unroll
        for (int d0 = 0; d0 < 4; ++d0) { const bf16x8 kf = *(const LAS bf16x8*)(Kl + (32 * (kt0 + t5) + r32) * KLS + 16 * d0 + 8 * hi); S[t5] = __builtin_amdgcn_mfma_f32_32x32x16_bf16(kf, qf[d0], S[t5], 0, 0, 0); }
    }
    float mx = sink2;
#pragma unroll
    for (int t5 = 0; t5 < 5; ++t5)
#pragma unroll
        for (int r = 0; r < 16; ++r) { const int j = 32 * (kt0 + t5) + crow(r, hi), delta = iq + 128 - j; const bool valid = (delta >= 0) && (delta <= 128) && (j >= jmin);
            const float s = valid ? S[t5][r] - slope2 * (float)delta : -1e30f; S[t5][r] = s; mx = fmaxf(mx, s); }
    mx = fmaxf(mx, __shfl_xor(mx, 32));
    float sum = 0.f;
#pragma unroll
    for (int t5 = 0; t5 < 5; ++t5)
#pragma unroll
        for (int r = 0; r < 16; ++r) { const float p = __builtin_amdgcn_exp2f(S[t5][r] - mx); sum += p; S[t5][r] = p; }
    sum += __shfl_xor(sum, 32);
    inv_denom = 1.0f / (sum + __builtin_amdgcn_exp2f(sink2 - mx));
    o[0] = f32x16{}; o[1] = f32x16{};
#pragma unroll
    for (int t5 = 0; t5 < 5; ++t5)
#pragma unroll
        for (int s2 = 0; s2 < 2; ++s2) {
            v4u pw; pw.x = pk2(S[t5][8 * s2 + 0], S[t5][8 * s2 + 1]); pw.y = pk2(S[t5][8 * s2 + 2], S[t5][8 * s2 + 3]); pw.z = pk2(S[t5][8 * s2 + 4], S[t5][8 * s2 + 5]); pw.w = pk2(S[t5][8 * s2 + 6], S[t5][8 * s2 + 7]);
            const bf16x8 pf = __builtin_bit_cast(bf16x8, pw);
#pragma unroll
            for (int dt = 0; dt < 2; ++dt) { const LAS bf16* vr = Vt + (32 * dt + r32) * VTS + 32 * (kt0 + t5) + 16 * s2 + 4 * hi;
                const v2u lo = *(const LAS v2u*)vr, hh = *(const LAS v2u*)(vr + 8); v4u vw; vw.x = lo.x; vw.y = lo.y; vw.z = hh.x; vw.w = hh.y;
                o[dt] = __builtin_amdgcn_mfma_f32_32x32x16_bf16(__builtin_bit_cast(bf16x8, vw), pf, o[dt], 0, 0, 0); }
        }
}
__device__ __forceinline__ void attn_qtile_fast(const LAS bf16* Kl, const LAS bf16* Vt, int kt0, const bf16x8 (&qf)[4], int iq, float slope2, float sink2,
                                                f32x16 (&o)[2], float& inv_denom, int r32, int hi) {
    f32x16 S[5];
    const float sbase = slope2 * (float)(4 * hi);
#pragma unroll
    for (int t5 = 0; t5 < 5; ++t5) {
        S[t5] = f32x16{};
#pragma unroll
        for (int d0 = 0; d0 < 4; ++d0) { const bf16x8 kf = *(const LAS bf16x8*)(Kl + (32 * (kt0 + t5) + r32) * KLS + 16 * d0 + 8 * hi); S[t5] = __builtin_amdgcn_mfma_f32_32x32x16_bf16(kf, qf[d0], S[t5], 0, 0, 0); }
    }
    const int D0 = iq + 128 - 32 * kt0 - 4 * hi, lo = D0 - 128;
    const float sinkp = sink2 + slope2 * (float)(iq + 128 - 32 * kt0);
    float m0 = -1e30f;
#pragma unroll
    for (int t5 = 0; t5 < 5; ++t5)
#pragma unroll
        for (int r = 0; r < 16; ++r) { const int off = 32 * t5 + (r & 3) + 8 * (r >> 2);
            float s = fmaf(slope2, (float)off, S[t5][r]);
            if (t5 == 0) s = (off >= lo) ? s : -1e30f;
            if (t5 == 4) s = (off <= D0) ? s : -1e30f;
            S[t5][r] = s; m0 = fmaxf(m0, s); }
    const float mloc = m0 + sbase;
    const float mx = fmaxf(sinkp, fmaxf(mloc, __shfl_xor(mloc, 32))), mxl = mx - sbase;
    float sum = 0.f;
#pragma unroll
    for (int t5 = 0; t5 < 5; ++t5)
#pragma unroll
        for (int r = 0; r < 16; ++r) { const float p = __builtin_amdgcn_exp2f(S[t5][r] - mxl); sum += p; S[t5][r] = p; }
    sum += __shfl_xor(sum, 32);
    inv_denom = 1.0f / (sum + __builtin_amdgcn_exp2f(sinkp - mx));
    o[0] = f32x16{}; o[1] = f32x16{};
#pragma unroll
    for (int t5 = 0; t5 < 5; ++t5)
#pragma unroll
        for (int s2 = 0; s2 < 2; ++s2) {
            v4u pw; pw.x = pk2(S[t5][8 * s2 + 0], S[t5][8 * s2 + 1]); pw.y = pk2(S[t5][8 * s2 + 2], S[t5][8 * s2 + 3]); pw.z = pk2(S[t5][8 * s2 + 4], S[t5][8 * s2 + 5]); pw.w = pk2(S[t5][8 * s2 + 6], S[t5][8 * s2 + 7]);
            const bf16x8 pf = __builtin_bit_cast(bf16x8, pw);
#pragma unroll
            for (int dt = 0; dt < 2; ++dt) { const LAS bf16* vr = Vt + (32 * dt + r32) * VTS + 32 * (kt0 + t5) + 16 * s2 + 4 * hi;
                const v2u lo2 = *(const LAS v2u*)vr, hh = *(const LAS v2u*)(vr + 8); v4u vw; vw.x = lo2.x; vw.y = lo2.y; vw.z = hh.x; vw.w = hh.y;
                o[dt] = __builtin_amdgcn_mfma_f32_32x32x16_bf16(__builtin_bit_cast(bf16x8, vw), pf, o[dt], 0, 0, 0); }
        }
}
__device__ __forceinline__ void stage_kv_from_z(const bf16* zrow, int kvh, int half, bool valid, LAS bf16* Kl, LAS bf16* Vt, int row, const float* gk, float* outk, float* outv) {
    v4u kw[4], vw[4];
#pragma unroll
    for (int i = 0; i < 4; ++i) { kw[i] = v4u{0u, 0u, 0u, 0u}; vw[i] = v4u{0u, 0u, 0u, 0u}; }
    if (valid) {
#pragma unroll
        for (int i = 0; i < 4; ++i) { kw[i] = *(const v4u*)(zrow + 1024 + kvh * 64 + 32 * half + 8 * i); vw[i] = *(const v4u*)(zrow + 1280 + kvh * 64 + 32 * half + 8 * i); }
    }
    float kf[32]; float ss = 0.f;
#pragma unroll
    for (int i = 0; i < 4; ++i) { kf[8 * i + 0] = bflo(kw[i].x); kf[8 * i + 1] = bfhi(kw[i].x); kf[8 * i + 2] = bflo(kw[i].y); kf[8 * i + 3] = bfhi(kw[i].y);
        kf[8 * i + 4] = bflo(kw[i].z); kf[8 * i + 5] = bfhi(kw[i].z); kf[8 * i + 6] = bflo(kw[i].w); kf[8 * i + 7] = bfhi(kw[i].w); }
#pragma unroll
    for (int i = 0; i < 32; ++i) ss += kf[i] * kf[i];
    ss += __shfl_xor(ss, 1);
    const float rk = rsqrtf(ss * (1.f / 64.f) + EPSN);
#pragma unroll
    for (int i = 0; i < 32; ++i) kf[i] = kf[i] * rk * gk[32 * half + i];
#pragma unroll
    for (int i = 0; i < 4; ++i) { v4u w; w.x = pk2(kf[8 * i], kf[8 * i + 1]); w.y = pk2(kf[8 * i + 2], kf[8 * i + 3]); w.z = pk2(kf[8 * i + 4], kf[8 * i + 5]); w.w = pk2(kf[8 * i + 6], kf[8 * i + 7]);
        *(LAS v4u*)(Kl + row * KLS + 32 * half + 8 * i) = w; }
#pragma unroll
    for (int i = 0; i < 4; ++i) { const unsigned ww[4] = {vw[i].x, vw[i].y, vw[i].z, vw[i].w};
#pragma unroll
        for (int q = 0; q < 4; ++q) { Vt[(32 * half + 8 * i + 2 * q) * VTS + row] = (bf16)(ww[q] & 0xffffu); Vt[(32 * half + 8 * i + 2 * q + 1) * VTS + row] = (bf16)(ww[q] >> 16); } }
    if (outk) {
#pragma unroll
        for (int i = 0; i < 8; ++i) ((f32x4*)(outk + 32 * half))[i] = f32x4{kf[4 * i], kf[4 * i + 1], kf[4 * i + 2], kf[4 * i + 3]};
#pragma unroll
        for (int i = 0; i < 4; ++i) { ((f32x4*)(outv + 32 * half))[2 * i] = f32x4{bflo(vw[i].x), bfhi(vw[i].x), bflo(vw[i].y), bfhi(vw[i].y)};
            ((f32x4*)(outv + 32 * half))[2 * i + 1] = f32x4{bflo(vw[i].z), bfhi(vw[i].z), bflo(vw[i].w), bfhi(vw[i].w)}; }
    }
}
__device__ __forceinline__ void load_q_raw(const bf16* zrow, int h, int hi, v4u (&qw)[4]) {
#pragma unroll
    for (int d0 = 0; d0 < 4; ++d0) qw[d0] = *(const v4u*)(zrow + h * 64 + 16 * d0 + 8 * hi);
}
__device__ __forceinline__ void finish_qfrags(const v4u (&qw)[4], const float* gq, bf16x8 (&qf)[4], int hi) {
    float ss = 0.f;
#pragma unroll
    for (int d0 = 0; d0 < 4; ++d0) {
        const float a0 = bflo(qw[d0].x), a1 = bfhi(qw[d0].x), a2 = bflo(qw[d0].y), a3 = bfhi(qw[d0].y), a4 = bflo(qw[d0].z), a5 = bfhi(qw[d0].z), a6 = bflo(qw[d0].w), a7 = bfhi(qw[d0].w);
        ss += (a0 * a0 + a1 * a1) + (a2 * a2 + a3 * a3) + (a4 * a4 + a5 * a5) + (a6 * a6 + a7 * a7); }
    ss += __shfl_xor(ss, 32);
    const float rq = rsqrtf(ss * (1.f / 64.f) + EPSN) * (0.125f * LOG2E);
#pragma unroll
    for (int d0 = 0; d0 < 4; ++d0) { const float* g = gq + 16 * d0 + 8 * hi; v4u w;
        w.x = pk2(bflo(qw[d0].x) * rq * g[0], bfhi(qw[d0].x) * rq * g[1]); w.y = pk2(bflo(qw[d0].y) * rq * g[2], bfhi(qw[d0].y) * rq * g[3]);
        w.z = pk2(bflo(qw[d0].z) * rq * g[4], bfhi(qw[d0].z) * rq * g[5]); w.w = pk2(bflo(qw[d0].w) * rq * g[6], bfhi(qw[d0].w) * rq * g[7]);
        qf[d0] = __builtin_bit_cast(bf16x8, w); }
}
__device__ __forceinline__ void load_qfrags(const bf16* zrow, int h, const float* gq, bf16x8 (&qf)[4], int hi) { v4u qw[4]; load_q_raw(zrow, h, hi, qw); finish_qfrags(qw, gq, qf, hi); }
__device__ __forceinline__ void store_attn_out(bf16* orow  , float* ssrow  , bool active, const f32x16 (&o)[2], float inv, int hi) {
    float ss = 0.f;
#pragma unroll
    for (int dt = 0; dt < 2; ++dt)
#pragma unroll
        for (int r4 = 0; r4 < 4; ++r4) { const float a = o[dt][4 * r4] * inv, b = o[dt][4 * r4 + 1] * inv, c = o[dt][4 * r4 + 2] * inv, d = o[dt][4 * r4 + 3] * inv;
            ss += (a * a + b * b) + (c * c + d * d);
            v2u w; w.x = pk2(a, b); w.y = pk2(c, d);
            if (active) *(v2u*)(orow + 32 * dt + 8 * r4 + 4 * hi) = w; }
    ss += __shfl_xor(ss, 32);
    if (active && hi == 0) unsafeAtomicAdd(ssrow, ss);
}
__device__ __forceinline__ void attn_prompt_unit(const Args& A, LAS unsigned char* lds, int b, int kvh, int qb, int tid, int wave, int lane) {
    LAS bf16* Kl = (LAS bf16*)(lds + LDS_K); LAS bf16* Vt = (LAS bf16*)(lds + LDS_VT);
    const bf16* Z = (const bf16*)(A.ws + WS_Z); bf16* ATT = (bf16*)(A.ws + WS_MIX); float* SSA = (float*)(A.ws + WS_SSA);
    const int r32 = lane & 31, hi = lane >> 5;
    const int h = kvh * 4 + (wave >> 1);
    const int tok0 = b * 2048 + qb * 128 + 64 * (wave & 1) + r32;
    v4u qw0[4], qw1[4];
    load_q_raw(Z + (size_t)tok0 * PW, h, hi, qw0); load_q_raw(Z + (size_t)(tok0 + 32) * PW, h, hi, qw1);
    {
        const int row = tid >> 1, half = tid & 1, tok = (qb - 1) * 128 + row; const bool valid = tok >= 0;
        const bf16* zrow = Z + (size_t)(b * 2048 + (valid ? tok : 0)) * PW;
        float* outk = nullptr; float* outv = nullptr;
        if (qb == 15 && row >= 128) { const size_t o = ((size_t)(b * 128 + row - 128) * 4 + kvh) * 64; outk = A.out + O_KP + o; outv = A.out + O_VP + o; }
        stage_kv_from_z(zrow, kvh, half, valid, Kl, Vt, row, A.in[I_KG], outk, outv);
    }
    __syncthreads();
    const float slope2 = exp2f(-0.5f * (float)(h + 1)) * LOG2E, sink2 = A.in[I_SINK][h] * LOG2E;
#pragma unroll 1
    for (int jj = 0; jj < 2; ++jj) {
        const int jq = 2 * (wave & 1) + jj, tok = tok0 + 32 * jj;
        v4u qs[4];
#pragma unroll
        for (int d0 = 0; d0 < 4; ++d0) qs[d0] = jj ? qw1[d0] : qw0[d0];
        bf16x8 qf[4]; finish_qfrags(qs, A.in[I_QG], qf, hi);
        f32x16 o[2]; float inv;
        if (qb == 0) attn_qtile(Kl, Vt, jq, qf, 32 * jq + r32, slope2, sink2, 128, o, inv, r32, hi);
        else attn_qtile_fast(Kl, Vt, jq, qf, 32 * jq + r32, slope2, sink2, o, inv, r32, hi);
        store_attn_out(ATT + (size_t)tok * DM + h * 64, SSA + tok, true, o, inv, hi);
    }
    __syncthreads();
}
__device__ __forceinline__ void attn_sample_unit(const Args& A, LAS unsigned char* lds, int n, int kvh, int tid, int wave, int lane) {
    LAS bf16* Kl = (LAS bf16*)(lds + LDS_K); LAS bf16* Vt = (LAS bf16*)(lds + LDS_VT);
    const bf16* Z = (const bf16*)(A.ws + WS_Z); bf16* ATT = (bf16*)(A.ws + WS_MIX); float* SSA = (float*)(A.ws + WS_SSA);
    const int r32 = lane & 31, hi = lane >> 5;
    {
        const int row = tid >> 2, qt = tid & 3; const size_t src = ((size_t)(n * 128 + row) * 4 + kvh) * 64 + 16 * qt;
        f32x4 kv[4], vv[4];
#pragma unroll
        for (int i = 0; i < 4; ++i) { kv[i] = ((const f32x4*)(A.in[I_CK] + src))[i]; vv[i] = ((const f32x4*)(A.in[I_CV] + src))[i]; }
#pragma unroll
        for (int i = 0; i < 2; ++i) { v4u w; w.x = pk2(kv[2 * i].x, kv[2 * i].y); w.y = pk2(kv[2 * i].z, kv[2 * i].w); w.z = pk2(kv[2 * i + 1].x, kv[2 * i + 1].y); w.w = pk2(kv[2 * i + 1].z, kv[2 * i + 1].w);
            *(LAS v4u*)(Kl + row * KLS + 16 * qt + 8 * i) = w; }
#pragma unroll
        for (int i = 0; i < 4; ++i) { Vt[(16 * qt + 4 * i + 0) * VTS + row] = (bf16)f2bf(vv[i].x); Vt[(16 * qt + 4 * i + 1) * VTS + row] = (bf16)f2bf(vv[i].y);
            Vt[(16 * qt + 4 * i + 2) * VTS + row] = (bf16)f2bf(vv[i].z); Vt[(16 * qt + 4 * i + 3) * VTS + row] = (bf16)f2bf(vv[i].w); }
        if (row >= 4) { const size_t dst = ((size_t)(n * 128 + row - 4) * 4 + kvh) * 64 + 16 * qt;
#pragma unroll
            for (int i = 0; i < 4; ++i) { ((f32x4*)(A.out + O_KS + dst))[i] = kv[i]; ((f32x4*)(A.out + O_VS + dst))[i] = vv[i]; } }
        for (int idx = tid; idx < 28 * 64; idx += NTHR) { const int r = 132 + (idx >> 6), c = idx & 63; Kl[r * KLS + c] = 0; Vt[c * VTS + r] = 0; }
        if (tid < 8) {
            const int t = tid >> 1, half = tid & 1; const size_t o = ((size_t)(n * 128 + 124 + t) * 4 + kvh) * 64;
            stage_kv_from_z(Z + (size_t)(MP + 4 * n + t) * PW, kvh, half, true, Kl, Vt, 128 + t, A.in[I_KG], A.out + O_KS + o, A.out + O_VS + o);
        }
    }
    __syncthreads();
    if (wave == 0) {
        const int t = r32 & 3, rr = (r32 >> 2) & 3, h = kvh * 4 + rr, tok = MP + 4 * n + t;
        const float slope2 = exp2f(-0.5f * (float)(h + 1)) * LOG2E, sink2 = A.in[I_SINK][h] * LOG2E;
        bf16x8 qf[4]; load_qfrags(Z + (size_t)tok * PW, h, A.in[I_QG], qf, hi);
        f32x16 o[2]; float inv;
        attn_qtile_fast(Kl, Vt, 0, qf, t, slope2, sink2, o, inv, r32, hi);
        store_attn_out(ATT + (size_t)tok * DM + h * 64, SSA + tok, r32 < 16, o, inv, hi);
    }
    __syncthreads();
}

constexpr int US = 264, ES = 132;
constexpr int LDS_U = 0, LDS_E = 128 * US * 2, LDS_TF = LDS_E + 128 * ES * 4, LDS_SSM_END = LDS_TF + 17 * 1024;
__device__ __forceinline__ void ssm_prompt_unit(const Args& A, LAS unsigned char* lds, int b, int g, int tid, int wave, int lane) {
    LAS bf16* U = (LAS bf16*)(lds + LDS_U); LAS float* E = (LAS float*)(lds + LDS_E); LAS unsigned char* TFl = lds + LDS_TF;
    const int r32 = lane & 31, hi = lane >> 5, w4 = wave & 3, ctp = wave >> 2;
    const bf16* Zu = (const bf16*)(A.ws + WS_Z) + (size_t)(b * 2048) * PW + 1536 + 16 * g;
    {
        v4u uv[8], tv[3];
#pragma unroll
        for (int i = 0; i < 8; ++i) { const int q = tid + 512 * i, t = q >> 1, h = q & 1; uv[i] = *(const v4u*)(Zu + (size_t)t * PW + 8 * h); }
        const v4u* tfg = (const v4u*)(A.ws + WS_TF) + (size_t)g * 17 * 64;
#pragma unroll
        for (int i = 0; i < 3; ++i) { const int q = tid + 512 * i; tv[i] = q < 17 * 64 ? tfg[q] : v4u{0u, 0u, 0u, 0u}; }
#pragma unroll
        for (int i = 0; i < 8; ++i) { const int q = tid + 512 * i, t = q >> 1, h = q & 1; *(LAS v4u*)(U + (t >> 4) * US + (t & 15) * 16 + 8 * h) = uv[i]; }
#pragma unroll
        for (int i = 0; i < 3; ++i) { const int q = tid + 512 * i; if (q < 17 * 64) *(LAS v4u*)(TFl + q * 16) = tv[i]; }
    }
    bf16x8 wf[16];
    {   const bf16x8* wsf = (const bf16x8*)(A.ws + WS_WSF) + (size_t)((g * 4 + w4) * 16) * 64 + lane;
#pragma unroll
        for (int s = 0; s < 16; ++s) wf[s] = wsf[s * 64]; }
    __syncthreads();
    const LAS bf16* u0p = U + (32 * (2 * ctp) + r32) * US + 8 * hi; const LAS bf16* u1p = U + (32 * (2 * ctp + 1) + r32) * US + 8 * hi;
    {
        f32x16 e0 = f32x16{}, e1 = f32x16{};
#pragma unroll
        for (int s = 0; s < 16; ++s) { const bf16x8 u0 = *(const LAS bf16x8*)(u0p + s * 16), u1 = *(const LAS bf16x8*)(u1p + s * 16);
            e0 = __builtin_amdgcn_mfma_f32_32x32x16_bf16(wf[s], u0, e0, 0, 0, 0); e1 = __builtin_amdgcn_mfma_f32_32x32x16_bf16(wf[s], u1, e1, 0, 0, 0); }
#pragma unroll
        for (int r = 0; r < 16; ++r) { const int m = 32 * w4 + crow(r, hi); E[(32 * (2 * ctp) + r32) * ES + m] = e0[r]; E[(32 * (2 * ctp + 1) + r32) * ES + m] = e1[r]; }
    }
    const int ttA = w4, ttB = 7 - w4;
    asm volatile("" ::: "memory");
    bf16x8 whA[8], whB[8];
    {   const bf16x8* pa = (const bf16x8*)(A.ws + WS_WHF) + (size_t)((g * 8 + ttA) * 8) * 64 + lane; const bf16x8* pb = (const bf16x8*)(A.ws + WS_WHF) + (size_t)((g * 8 + ttB) * 8) * 64 + lane;
#pragma unroll
        for (int kb = 0; kb < 8; ++kb) { whA[kb] = pa[kb * 64]; whB[kb] = pb[kb * 64]; } }
    __syncthreads();
    if (wave == 0) {
        const float2 l16 = ((const float2*)(A.ws + WS_LAM16))[g * 64 + lane];
        float hr = 0.f, hm = 0.f;
#pragma unroll 8
        for (int c = 0; c < 128; ++c) { const float er = E[c * ES + lane], ei = E[c * ES + 64 + lane];
            E[c * ES + lane] = __uint_as_float(pk2(hr, hm));
            const float nr = l16.x * hr - l16.y * hm + er, ni = l16.x * hm + l16.y * hr + ei; hr = nr; hm = ni; }
        A.out[O_RP + (size_t)(b * 64 + g) * 64 + lane] = hr; A.out[O_IP + (size_t)(b * 64 + g) * 64 + lane] = hm;
    }
    __syncthreads();
    {
        f32x16 aA0 = f32x16{}, aA1 = f32x16{}, aB0 = f32x16{}, aB1 = f32x16{};
        const LAS unsigned char* tfl = TFl + lane * 16;
#pragma unroll 4
        for (int s = 0; s < 16; ++s) {
            if (s <= 2 * ttB + 1) {
                const bf16x8 u0 = *(const LAS bf16x8*)(u0p + s * 16), u1 = *(const LAS bf16x8*)(u1p + s * 16);
                const bf16x8 tB = *(const LAS bf16x8*)(tfl + (2 * ttB - s + 1) * 1024);
                aB0 = __builtin_amdgcn_mfma_f32_32x32x16_bf16(tB, u0, aB0, 0, 0, 0); aB1 = __builtin_amdgcn_mfma_f32_32x32x16_bf16(tB, u1, aB1, 0, 0, 0);
                if (s <= 2 * ttA + 1) { const bf16x8 tA = *(const LAS bf16x8*)(tfl + (2 * ttA - s + 1) * 1024);
                    aA0 = __builtin_amdgcn_mfma_f32_32x32x16_bf16(tA, u0, aA0, 0, 0, 0); aA1 = __builtin_amdgcn_mfma_f32_32x32x16_bf16(tA, u1, aA1, 0, 0, 0); }
            }
        }
        const LAS bf16* h0p = (const LAS bf16*)(E + (32 * (2 * ctp) + r32) * ES) + 8 * hi; const LAS bf16* h1p = (const LAS bf16*)(E + (32 * (2 * ctp + 1) + r32) * ES) + 8 * hi;
#pragma unroll
        for (int kb = 0; kb < 8; ++kb) {
            const bf16x8 h0 = *(const LAS bf16x8*)(h0p + 16 * kb), h1 = *(const LAS bf16x8*)(h1p + 16 * kb);
            aA0 = __builtin_amdgcn_mfma_f32_32x32x16_bf16(whA[kb], h0, aA0, 0, 0, 0); aA1 = __builtin_amdgcn_mfma_f32_32x32x16_bf16(whA[kb], h1, aA1, 0, 0, 0);
            aB0 = __builtin_amdgcn_mfma_f32_32x32x16_bf16(whB[kb], h0, aB0, 0, 0, 0); aB1 = __builtin_amdgcn_mfma_f32_32x32x16_bf16(whB[kb], h1, aB1, 0, 0, 0);
        }
        bf16* Gm = (bf16*)(A.ws + WS_G);
        const float* Dk = A.in[I_D] + 16 * g;
#define SSM_EPI(acc, tt, ct) do { _Pragma("unroll") for (int r4 = 0; r4 < 4; ++r4) { const int ti = r4 >> 1, ch0 = 8 * (r4 & 1) + 4 * hi, cc = 32 * (ct) + r32, tok = 16 * cc + 2 * (tt) + ti; \
            const v2u uw = *(const LAS v2u*)(U + cc * US + (2 * (tt) + ti) * 16 + ch0); const f32x4 dv = *(const f32x4*)(Dk + ch0); \
            const float y0 = acc[4 * r4 + 0] + dv.x * bflo(uw.x), y1 = acc[4 * r4 + 1] + dv.y * bfhi(uw.x), y2 = acc[4 * r4 + 2] + dv.z * bflo(uw.y), y3 = acc[4 * r4 + 3] + dv.w * bfhi(uw.y); \
            v2u w; w.x = pk2(gelu_tanh(y0), gelu_tanh(y1)); w.y = pk2(gelu_tanh(y2), gelu_tanh(y3)); \
            *(v2u*)(Gm + (size_t)(b * 2048 + tok) * SWD + 16 * g + ch0) = w; } } while (0)
        SSM_EPI(aA0, ttA, 2 * ctp); SSM_EPI(aA1, ttA, 2 * ctp + 1); SSM_EPI(aB0, ttB, 2 * ctp); SSM_EPI(aB1, ttB, 2 * ctp + 1);
#undef SSM_EPI
    }
    __syncthreads();
}
__device__ __forceinline__ void ssm_sample_wave(const Args& A, LAS unsigned char* lds, int gw  , int ngw, int wave, int lane) {
    LAS float* Cr = (LAS float*)(lds + wave * 8192); LAS float* Ci = Cr + 1024; LAS float* hs = (LAS float*)(lds + 65536 + wave * 2048);
    const bf16* Z = (const bf16*)(A.ws + WS_Z);
    const int tl = lane >> 4, cl = lane & 15;
    for (int g = gw & 63; g < 64; g += 64) {
        {   const f32x4* cre = (const f32x4*)(A.in[I_CRE] + (size_t)g * 1024); const f32x4* cim = (const f32x4*)(A.in[I_CIM] + (size_t)g * 1024);
#pragma unroll
            for (int i = 0; i < 4; ++i) { const int q4 = lane + 64 * i, chp = q4 >> 4, p0 = (q4 & 15) * 4; const f32x4 a = cre[q4], c = cim[q4];
                Cr[(p0 + 0) * 16 + chp] = a.x; Cr[(p0 + 1) * 16 + chp] = a.y; Cr[(p0 + 2) * 16 + chp] = a.z; Cr[(p0 + 3) * 16 + chp] = a.w;
                Ci[(p0 + 0) * 16 + chp] = c.x; Ci[(p0 + 1) * 16 + chp] = c.y; Ci[(p0 + 2) * 16 + chp] = c.z; Ci[(p0 + 3) * 16 + chp] = c.w; } }
        const float2 lam = ((const float2*)(A.ws + WS_LAM))[g * 64 + lane];
        float2 bb[16];
#pragma unroll
        for (int ch = 0; ch < 16; ++ch) bb[ch] = ((const float2*)(A.ws + WS_BBAR))[(g * 16 + ch) * 64 + lane];
        const float dsk = A.in[I_D][16 * g + cl];
        for (int n = gw >> 6; n < 128; n += ngw >> 6) {
            float hr = A.in[I_SR][(size_t)(n * 64 + g) * 64 + lane], hm = A.in[I_SI][(size_t)(n * 64 + g) * 64 + lane];
            const unsigned short ub = Z[(size_t)(MP + 4 * n + tl) * PW + 1536 + 16 * g + cl];
            const float uval = __uint_as_float((unsigned)ub << 16);
#pragma unroll
            for (int t = 0; t < 4; ++t) {
                float br = 0.f, bi = 0.f;
#pragma unroll
                for (int ch = 0; ch < 16; ++ch) { const float u = __shfl(uval, t * 16 + ch); br += bb[ch].x * u; bi += bb[ch].y * u; }
                const float nr = lam.x * hr - lam.y * hm + br, ni = lam.x * hm + lam.y * hr + bi; hr = nr; hm = ni;
                hs[(t * 2 + 0) * 64 + lane] = hr; hs[(t * 2 + 1) * 64 + lane] = hm;
            }
            A.out[O_RS + (size_t)(n * 64 + g) * 64 + lane] = hr; A.out[O_IS + (size_t)(n * 64 + g) * 64 + lane] = hm;
            float y = 0.f;
#pragma unroll 4
            for (int p = 0; p < 64; p += 4) { const f32x4 h4 = *(const LAS f32x4*)(hs + (tl * 2 + 0) * 64 + p), g4 = *(const LAS f32x4*)(hs + (tl * 2 + 1) * 64 + p);
                y += (Cr[(p + 0) * 16 + cl] * h4.x - Ci[(p + 0) * 16 + cl] * g4.x) + (Cr[(p + 1) * 16 + cl] * h4.y - Ci[(p + 1) * 16 + cl] * g4.y)
                   + (Cr[(p + 2) * 16 + cl] * h4.z - Ci[(p + 2) * 16 + cl] * g4.z) + (Cr[(p + 3) * 16 + cl] * h4.w - Ci[(p + 3) * 16 + cl] * g4.w); }
            y += dsk * uval;
            ((bf16*)(A.ws + WS_G))[(size_t)(MP + 4 * n + tl) * SWD + 16 * g + cl] = (bf16)f2bf(gelu_tanh(y));
        }
    }
}

__device__ __forceinline__ void convert_two(const float* W1, int K1, int N1, bf16* T1, const float* W2, int K2, int N2, bf16* T2, LAS unsigned char* lds, int w, int nw, int wave, int lane, const float* g0 = nullptr, const float* g1 = nullptr) {
    LAS float* scr = (LAS float*)(lds + wave * 8448);
    const int i1 = (K1 / 64) * (N1 / 32), i2 = (K2 / 64) * (N2 / 32);
    for (int it = w * NWAVES + wave; it < i1 + i2; it += nw * NWAVES) {
        if (it < i1) p0_transpose_item(W1, K1, N1, T1, scr, it, lane); else p0_transpose_item(W2, K2, N2, T2, scr, it - i1, lane, g0, g1);
    }
}
#define XB_TMO      128
#define XB_XCNT(j)  (256  + 64 * (j))
#define XB_XSUB(j)  (1280 + 64 * (j))
#define XB_XGEN(j)  (2304 + 64 * (j))
#define XB_TOP      3328
#define XB_TOPGEN   3392
#define XCD_BAR_WORDS 3456
#define XB_SPIN_CAP (1u << 18)

__device__ __forceinline__ unsigned xb_ld(unsigned* p)              { return __hip_atomic_load(p, __ATOMIC_RELAXED, __HIP_MEMORY_SCOPE_AGENT); }
__device__ __forceinline__ unsigned xb_add(unsigned* p, unsigned v) { return __hip_atomic_fetch_add(p, v, __ATOMIC_RELAXED, __HIP_MEMORY_SCOPE_AGENT); }
__device__ __forceinline__ unsigned xb_xcc_id() { return (unsigned)__builtin_amdgcn_s_getreg((3 << 11) | 20) & 0xFu; }
#define XB_SPIN(cond, bar) do { unsigned _sp = 0; while (cond) { __builtin_amdgcn_s_sleep(1); \
    if ((++_sp & 255u) == 0u) { if (xb_ld(&(bar)[XB_TMO])) break; if (_sp > XB_SPIN_CAP) { atomicAdd(&(bar)[XB_TMO], 1u); break; } } } } while (0)

struct XcdBarrier {
    unsigned* bar; unsigned x;
    volatile LAS unsigned* st;
};

__device__ __forceinline__ XcdBarrier xcd_barrier_post(unsigned* bar, volatile LAS unsigned* st) {
    XcdBarrier b; b.bar = bar; b.x = xb_xcc_id(); b.st = st;
    if (threadIdx.x == 0) (void)xb_add(&bar[XB_XCNT(b.x)], 1u);
    return b;
}
__device__ __forceinline__ void xcd_barrier_complete(unsigned* bar, unsigned x, unsigned& nloc, unsigned& nx) {
    const unsigned G = gridDim.x * gridDim.y * gridDim.z;
    unsigned sum, cnt, mine, sp = 0u;
    for (;;) {
        sum = 0u; cnt = 0u; mine = 0u;
#pragma unroll
        for (unsigned j = 0; j < 16; ++j) { const unsigned c = xb_ld(&bar[XB_XCNT(j)]); sum += c; cnt += (c > 0u) ? 1u : 0u; mine = (j == x) ? c : mine; }
        if (sum == G) break;
        __builtin_amdgcn_s_sleep(1);
        if ((++sp & 255u) == 0u) { if (xb_ld(&bar[XB_TMO])) break; if (sp > XB_SPIN_CAP) { atomicAdd(&bar[XB_TMO], 1u); break; } }
    }
    nloc = mine > 0u ? mine : 1u; nx = cnt > 0u ? cnt : 1u;
}

__device__ __forceinline__ void xcd_barrier(const XcdBarrier& b) {
    asm volatile("s_waitcnt vmcnt(0)" ::: "memory");
    __syncthreads();
    if (threadIdx.x == 0) {
        unsigned* bar = b.bar;
        __builtin_amdgcn_s_waitcnt(0);
        unsigned nloc = b.st[0], nx = b.st[1];
        if (nloc == 0u) { xcd_barrier_complete(bar, b.x, nloc, nx); b.st[0] = nloc; b.st[1] = nx; }
        const unsigned old = xb_add(&bar[XB_XSUB(b.x)], 1u);
        const unsigned gen = old / nloc;
        if (old + 1u == (gen + 1u) * nloc) {
            __builtin_amdgcn_fence(__ATOMIC_RELEASE, "agent");
            asm volatile("s_waitcnt vmcnt(0)" ::: "memory");
            const unsigned og = xb_add(&bar[XB_TOP], 1u);
            const unsigned tg = og / nx;
            if (og + 1u == (tg + 1u) * nx) xb_add(&bar[XB_TOPGEN], 1u);
            else XB_SPIN(xb_ld(&bar[XB_TOPGEN]) == tg, bar);
            __builtin_amdgcn_fence(__ATOMIC_ACQUIRE, "agent");
            xb_add(&bar[XB_XGEN(b.x)], 1u);
            asm volatile("s_waitcnt vmcnt(0)" ::: "memory");
        } else {
            XB_SPIN(xb_ld(&bar[XB_XGEN(b.x)]) == gen, bar);
            __builtin_amdgcn_fence(__ATOMIC_ACQUIRE, "agent");
            asm volatile("s_waitcnt vmcnt(0)" ::: "memory");
        }
    }
    __syncthreads();
}

template <int LO, int HI> __device__ __forceinline__ void fwd_body(const Args& A) {
    extern __shared__ __attribute__((aligned(16))) unsigned char lds_raw[];
    LAS unsigned char* lds = (LAS unsigned char*)lds_raw;
    const int tid = threadIdx.x, lane = tid & 63, wave = __builtin_amdgcn_readfirstlane(tid >> 6);
    const int G = gridDim.x, bx = blockIdx.x, vcu = (G % 8 == 0) ? (bx % 8) * (G / 8) + bx / 8 : bx;
    unsigned char* ws = A.ws;
#define IN(k) (LO <= (k) && (k) < HI)
    volatile LAS unsigned* bst = (volatile LAS unsigned*)(lds + LDS_PHASE);
    if (tid == 0) { bst[0] = 0u; bst[1] = 0u; }
    __syncthreads();
    XcdBarrier bar; bar.bar = (unsigned*)(ws + WS_BAR); bar.x = 0; bar.st = bst;
    if (HI - LO > 1) bar = xcd_barrier_post((unsigned*)(ws + WS_BAR), bst);
#define SEAM(k) do { if (IN(k) && IN((k) + 1)) { xcd_barrier(bar); } } while (0)
    if (HI - LO > 1) cg::this_grid().sync();
    using namespace pg8;
#ifdef PROBE_P0
    if (IN(0)) { const int nrep = A.ph_hi > 100 ? 1 : 2; for (int rep = 0; rep < nrep; ++rep) { p0_prologue(A, lds, vcu, G, tid, wave, lane); __syncthreads(); if (rep + 1 < nrep) xcd_barrier(bar); } }
#else
    if (IN(0)) { p0_prologue(A, lds, vcu, G, tid, wave, lane); __syncthreads(); }
#endif
    SEAM(0);
    if (IN(1)) { Gemm g{(const bf16_t*)(ws + WS_XN), (const bf16_t*)(ws + WS_WIN), MT, PW, DM}; StaticOrder S; S.init(MT, PW, G, bx, DM);
        EpiStoreBf16<0> E{(bf16_t*)(ws + WS_Z), PW};
        gemm_phase<EpiStoreBf16<0>, StaticOrder, true, true>(lds, g, S, E);
        { const int nfull = (MT / 256) * (PW / 256) - 2 * G;
          if (G == 256 && bx >= nfull) convert_two(A.in[I_WGLU], SWD, SWD, (bf16*)(ws + WS_WGLU), A.in[I_WOUT], DM, DM, (bf16*)(ws + WS_WOUT), lds, bx - nfull, G - nfull, wave, lane, A.in[I_AOG], A.in[I_SOG]);
          else if (G != 256) convert_two(A.in[I_WGLU], SWD, SWD, (bf16*)(ws + WS_WGLU), A.in[I_WOUT], DM, DM, (bf16*)(ws + WS_WOUT), lds, bx, G, wave, lane, A.in[I_AOG], A.in[I_SOG]); } }
    SEAM(1);
    if (IN(2)) {
#ifdef PROBE_P2
      const int nrep2 = A.ph_hi > 100 ? 1 : 2;
      for (int rep = 0; rep < nrep2; ++rep) {
        if (rep) xcd_barrier(bar);
#else
      {
#endif
#ifndef SKIP_AP
        for (int u = vcu; u < 512; u += G) { int t_ = threadIdx.x; asm volatile("" : "+v"(t_)); const int l_ = t_ & 63, w_ = __builtin_amdgcn_readfirstlane(t_ >> 6); attn_prompt_unit(A, lds, u >> 6, (u >> 4) & 3, u & 15, t_, w_, l_); }
#endif
#ifdef DUP_AP
        __syncthreads();
        for (int u = vcu; u < 512; u += G) { int t_ = threadIdx.x; asm volatile("" : "+v"(t_)); const int l_ = t_ & 63, w_ = __builtin_amdgcn_readfirstlane(t_ >> 6); attn_prompt_unit(A, lds, u >> 6, (u >> 4) & 3, u & 15, t_, w_, l_); }
#endif
#ifndef SKIP_SP
        for (int u = vcu; u < 512; u += G) { int t_ = threadIdx.x; asm volatile("" : "+v"(t_)); const int l_ = t_ & 63, w_ = __builtin_amdgcn_readfirstlane(t_ >> 6); ssm_prompt_unit(A, lds, u >> 6, u & 63, t_, w_, l_); }
#endif
#ifdef DUP_SP
        __syncthreads();
        for (int u = vcu; u < 512; u += G) { int t_ = threadIdx.x; asm volatile("" : "+v"(t_)); const int l_ = t_ & 63, w_ = __builtin_amdgcn_readfirstlane(t_ >> 6); ssm_prompt_unit(A, lds, u >> 6, u & 63, t_, w_, l_); }
#endif
#ifndef SKIP_AS
        for (int u = vcu; u < 512; u += G) { int t_ = threadIdx.x; asm volatile("" : "+v"(t_)); const int l_ = t_ & 63, w_ = __builtin_amdgcn_readfirstlane(t_ >> 6); attn_sample_unit(A, lds, u >> 2, u & 3, t_, w_, l_); }
#endif
#ifdef DUP_AS
        __syncthreads();
        for (int u = vcu; u < 512; u += G) { int t_ = threadIdx.x; asm volatile("" : "+v"(t_)); const int l_ = t_ & 63, w_ = __builtin_amdgcn_readfirstlane(t_ >> 6); attn_sample_unit(A, lds, u >> 2, u & 3, t_, w_, l_); }
#endif
#ifndef SKIP_SS
        { int t_ = threadIdx.x; asm volatile("" : "+v"(t_)); const int l_ = t_ & 63, w_ = __builtin_amdgcn_readfirstlane(t_ >> 6);
          if ((G * NWAVES) % 64 == 0) ssm_sample_wave(A, lds, vcu * NWAVES + w_, G * NWAVES, w_, l_); }
#endif
#ifdef DUP_SS
        __syncthreads();
        { int t_ = threadIdx.x; asm volatile("" : "+v"(t_)); const int l_ = t_ & 63, w_ = __builtin_amdgcn_readfirstlane(t_ >> 6);
          if ((G * NWAVES) % 64 == 0) ssm_sample_wave(A, lds, vcu * NWAVES + w_, G * NWAVES, w_, l_); }
#endif
        __syncthreads();
      }
    }
    SEAM(2);
    if (IN(3)) { Gemm g{(const bf16_t*)(ws + WS_G), (const bf16_t*)(ws + WS_WGLU), MT, SWD, SWD}; StaticOrder S; S.init(MT, SWD, G, bx, SWD);
        EpiGlu E{(const bf16_t*)(ws + WS_G), (bf16_t*)(ws + WS_MIX), A.in[I_BGLU], (float*)(ws + WS_SSS)};
        gemm_phase<EpiGlu, StaticOrder, true, true>(lds, g, S, E); }
    SEAM(3);
    if (IN(5)) { Gemm g{(const bf16_t*)(ws + WS_MIX), (const bf16_t*)(ws + WS_WOUT), MT, DM, DM}; StaticOrder S; S.init(MT, DM, G, bx, DM);
        EpiHres E{(const bf16_t*)(ws + WS_XN), (const float*)(ws + WS_XR), A.in[I_ANG], (bf16_t*)(ws + WS_HG), A.in[I_MNG], (float*)(ws + WS_CTL), (const float*)(ws + WS_SSA), (const float*)(ws + WS_SSS)};
        gemm_phase<EpiHres, StaticOrder, true, true>(lds, g, S, E);
        { const int nfull = (MT / 256) * (DM / 256) - 2 * G;
          if (G == 256 && bx >= nfull) convert_two(A.in[I_WUP], DM, FF, (bf16*)(ws + WS_WUP), A.in[I_WDN], FF, DM, (bf16*)(ws + WS_WDN), lds, bx - nfull, G - nfull, wave, lane);
          else if (G != 256) convert_two(A.in[I_WUP], DM, FF, (bf16*)(ws + WS_WUP), A.in[I_WDN], FF, DM, (bf16*)(ws + WS_WDN), lds, bx, G, wave, lane); } }
    SEAM(5);
    if (IN(6)) { Gemm g{(const bf16_t*)(ws + WS_HG), (const bf16_t*)(ws + WS_WUP), MT, FF, DM}; StaticOrder S; S.init(MT, FF, G, bx, DM);
        EpiStoreBf16<2> E{(bf16_t*)(ws + WS_ACT), FF};
        gemm_phase<EpiStoreBf16<2>, StaticOrder, true, true>(lds, g, S, E); }
    SEAM(6);
    if (IN(7)) { Gemm g{(const bf16_t*)(ws + WS_ACT), (const bf16_t*)(ws + WS_WDN), MT, DM, FF};
        { StaticOrder S; S.init(MP, DM, G, bx, FF); EpiDown E{A.out + O_Y, (const float*)(ws + WS_CTL), (const bf16_t*)(ws + WS_HG), A.in[I_MNG]};
          gemm_phase<EpiDown, StaticOrder, true, true>(lds, g, S, E); }
        { SampleSplitOrder<8, 16, 128> S; S.init(G, bx); EpiPartial E{(float*)(ws + WS_PART), 512};
          gemm_phase<EpiPartial, SampleSplitOrder<8, 16, 128>, true, true>(lds, g, S, E); } }
    SEAM(7);
    if (IN(8)) {
        const float* P = (const float*)(ws + WS_PART); const float* rowss = (const float*)(ws + WS_CTL); float* Y = A.out + O_Y + (size_t)MP * DM;
        const bf16* HGs = (const bf16*)(ws + WS_HG) + (size_t)MP * DM;
        for (int idx = vcu * NTHR + tid; idx < 512 * 512; idx += G * NTHR) {
            const int row = idx >> 9, c4 = idx & 511;
            f32x4 s = f32x4{0.f, 0.f, 0.f, 0.f};
#pragma unroll
            for (int k = 0; k < 16; ++k) s += ((const f32x4*)(P + (size_t)k * (512 * 2048)))[idx];
            const float ssr = __hip_atomic_load(rowss + MP + row, __ATOMIC_RELAXED, __HIP_MEMORY_SCOPE_AGENT);
            const float r2 = 1.0f / (ssr * (1.0f / 2048.0f) + 1e-6f);
            const v2u hw = *(const v2u*)(HGs + (size_t)row * DM + 4 * c4); const f32x4 gv = *(const f32x4*)(A.in[I_MNG] + 4 * c4);
            const f32x4 h = f32x4{bflo(hw.x) / gv.x, bfhi(hw.x) / gv.y, bflo(hw.y) / gv.z, bfhi(hw.y) / gv.w};
            ((f32x4*)(Y + (size_t)row * DM))[c4] = h + s * r2;
        }
    }
#undef IN
#undef SEAM
}
template <int LO, int HI> __global__ void __launch_bounds__(NTHR, 2) fwd_t(Args A) { fwd_body<LO, HI>(A); }

extern "C" void kernel_launch(void* const* d_in, const int* in_sizes, int n_in, void* d_out, int out_size, void* d_ws, size_t ws_size, hipStream_t stream) {
    static int grid = 0;
    if (grid == 0) {
        if (n_in != 27 || out_size != (int)O_END || ws_size < WS_END) { fprintf(stderr, "kernel_launch: unexpected shapes: n_in %d out %d ws %zu (need %zu)\n", n_in, out_size, ws_size, (size_t)WS_END); grid = -1; return; }
        int dev = 0, cus = 0, per_cu = 0;
        if (hipGetDevice(&dev) != hipSuccess || hipDeviceGetAttribute(&cus, hipDeviceAttributeMultiprocessorCount, dev) != hipSuccess) { grid = -1; return; }
#if MK_PER_PHASE
        const void* fns[NPHASE] = {(const void*)fwd_t<0, 1>, (const void*)fwd_t<1, 2>, (const void*)fwd_t<2, 3>, (const void*)fwd_t<3, 4>, (const void*)fwd_t<4, 5>, (const void*)fwd_t<5, 6>, (const void*)fwd_t<6, 7>, (const void*)fwd_t<7, 8>, (const void*)fwd_t<8, 9>};
        for (int i = 0; i < NPHASE; ++i) if (hipFuncSetAttribute(fns[i], hipFuncAttributeMaxDynamicSharedMemorySize, LDS_BYTES) != hipSuccess) { fprintf(stderr, "kernel_launch: hipFuncSetAttribute failed\n"); grid = -1; return; }
#else
        if (hipFuncSetAttribute((const void*)fwd_t<0, NPHASE>, hipFuncAttributeMaxDynamicSharedMemorySize, LDS_BYTES) != hipSuccess) { fprintf(stderr, "kernel_launch: hipFuncSetAttribute failed\n"); grid = -1; return; }
        if (hipOccupancyMaxActiveBlocksPerMultiprocessor(&per_cu, (const void*)fwd_t<0, NPHASE>, NTHR, LDS_BYTES) != hipSuccess || per_cu < 1) { fprintf(stderr, "kernel_launch: occupancy query says %d\n", per_cu); per_cu = 1; }
#endif
        (void)hipGetLastError();
        grid = cus;
    }
    if (grid < 0) return;
    (void)hipMemsetAsync((char*)d_ws + WS_CTL, 0, CTL_ZERO_BYTES, stream);
    Args a{};
    for (int i = 0; i < 27; ++i) a.in[i] = (const float*)d_in[i];
    a.out = (float*)d_out; a.ws = (unsigned char*)d_ws;
#if MK_PER_PHASE
    hipLaunchKernelGGL((fwd_t<0, 1>), dim3(grid), dim3(NTHR), LDS_BYTES, stream, a);
#if defined(DUP_PHASE)
    if (DUP_PHASE == 0) hipLaunchKernelGGL((fwd_t<0, 1>), dim3(grid), dim3(NTHR), LDS_BYTES, stream, a);
#endif
    hipLaunchKernelGGL((fwd_t<1, 2>), dim3(grid), dim3(NTHR), LDS_BYTES, stream, a);
#if defined(DUP_PHASE)
    if (DUP_PHASE == 1) hipLaunchKernelGGL((fwd_t<1, 2>), dim3(grid), dim3(NTHR), LDS_BYTES, stream, a);
#endif
    hipLaunchKernelGGL((fwd_t<2, 3>), dim3(grid), dim3(NTHR), LDS_BYTES, stream, a);
#if defined(DUP_PHASE)
    if (DUP_PHASE == 2) hipLaunchKernelGGL((fwd_t<2, 3>), dim3(grid), dim3(NTHR), LDS_BYTES, stream, a);
#endif
    hipLaunchKernelGGL((fwd_t<3, 4>), dim3(grid), dim3(NTHR), LDS_BYTES, stream, a);
#if defined(DUP_PHASE)
    if (DUP_PHASE == 3) hipLaunchKernelGGL((fwd_t<3, 4>), dim3(grid), dim3(NTHR), LDS_BYTES, stream, a);
#endif
    hipLaunchKernelGGL((fwd_t<4, 5>), dim3(grid), dim3(NTHR), LDS_BYTES, stream, a);
#if defined(DUP_PHASE)
    if (DUP_PHASE == 4) hipLaunchKernelGGL((fwd_t<4, 5>), dim3(grid), dim3(NTHR), LDS_BYTES, stream, a);
#endif
    hipLaunchKernelGGL((fwd_t<5, 6>), dim3(grid), dim3(NTHR), LDS_BYTES, stream, a);
#if defined(DUP_PHASE)
    if (DUP_PHASE == 5) hipLaunchKernelGGL((fwd_t<5, 6>), dim3(grid), dim3(NTHR), LDS_BYTES, stream, a);
#endif
    hipLaunchKernelGGL((fwd_t<6, 7>), dim3(grid), dim3(NTHR), LDS_BYTES, stream, a);
#if defined(DUP_PHASE)
    if (DUP_PHASE == 6) hipLaunchKernelGGL((fwd_t<6, 7>), dim3(grid), dim3(NTHR), LDS_BYTES, stream, a);
#endif
    hipLaunchKernelGGL((fwd_t<7, 8>), dim3(grid), dim3(NTHR), LDS_BYTES, stream, a);
#if defined(DUP_PHASE)
    if (DUP_PHASE == 7) hipLaunchKernelGGL((fwd_t<7, 8>), dim3(grid), dim3(NTHR), LDS_BYTES, stream, a);
#endif
    hipLaunchKernelGGL((fwd_t<8, 9>), dim3(grid), dim3(NTHR), LDS_BYTES, stream, a);
#if defined(DUP_PHASE)
    if (DUP_PHASE == 8) hipLaunchKernelGGL((fwd_t<8, 9>), dim3(grid), dim3(NTHR), LDS_BYTES, stream, a);
#endif
#else
    a.ph_lo = 0; a.ph_hi = NPHASE;
    void* kargs[] = {&a};
    hipError_t e = hipLaunchCooperativeKernel((const void*)fwd_t<0, NPHASE>, dim3(grid), dim3(NTHR), kargs, LDS_BYTES, stream);
    if (e != hipSuccess) fprintf(stderr, "cooperative launch failed: %s (grid %d)\n", hipGetErrorString(e), grid);
#endif
}
```

```cpp
#ifndef MK_PER_PHASE
#define MK_PER_PHASE 0
#endif
#include <hip/hip_runtime.h>
#include <hip/hip_cooperative_groups.h>
#include <cstdio>
#include <cstdint>
namespace cg = cooperative_groups;
namespace pg8 {
#define PG8_LAS __attribute__((address_space(3)))
typedef unsigned short bf16_t;
typedef short bf16x8 __attribute__((ext_vector_type(8)));
typedef float f32x4 __attribute__((ext_vector_type(4)));
typedef unsigned u32x4 __attribute__((ext_vector_type(4)));
constexpr int BM = 256, BK = 64, HALF = 128, HTB = HALF * BK * 2  , STAGE_BYTES = 8 * HTB, NXCD = 8, WGM = 8;

__host__ __device__ __forceinline__ int lds_byte(int r, int c) { const int st = (r >> 4) * 2 + (c >> 5), rr = r & 15, cc = c & 31, ob = rr * 64 + cc * 2; return st * 1024 + (ob ^ (((ob >> 9) & 1) << 5)); }
__host__ __device__ __forceinline__ void stage_rc(int b, int& R, int& C) { const int st = b / 1024, sb = b % 1024, swz = sb ^ (((sb >> 9) & 1) << 5); R = (st >> 1) * 16 + swz / 64; C = (st & 1) * 32 + (swz % 64) / 2; }
__host__ __device__ __forceinline__ int perm32(int rho) { const int n = rho >> 4, i = rho & 15; return 8 * (i >> 2) + 4 * n + (i & 3); }

struct Unit { int pm, pn, k0, nt, cont; };
struct Gemm { const bf16_t* A; const bf16_t* Bt; int M, N, K; };

struct StaticOrder {
    int nM, nN, nwg, G, c, ntk;
    __host__ __device__ void init(int M, int N, int G_, int c_, int K) { nM = M / BM; nN = N / BM; nwg = nM * nN; G = G_; c = c_; ntk = K / BK; }
    __host__ __device__ bool next(int i, Unit& u) const {
        const long L = (long)i * G + c; if (L >= nwg) return false;
        int wgid = (int)L; { const int q = nwg / NXCD, r = nwg % NXCD, xcd = wgid % NXCD, off = wgid / NXCD; wgid = (xcd < r ? xcd * (q + 1) : r * (q + 1) + (xcd - r) * q) + off; }
        const int nig = WGM * nN, gid = wgid / nig, fm = gid * WGM, gsz = (nM - fm) < WGM ? (nM - fm) : WGM;
        u.pm = fm + ((wgid % nig) % gsz); u.pn = (wgid % nig) / gsz; u.k0 = 0; u.nt = ntk; u.cont = 0; return true;
    }
    __device__ __forceinline__ void a_ready(const Unit&) const {}
    __device__ __forceinline__ void done(const Unit&) const {}
};

__device__ __forceinline__ unsigned cvt_pk_bf16(float lo, float hi) { unsigned r; asm volatile("v_cvt_pk_bf16_f32 %0, %1, %2" : "=v"(r) : "v"(lo), "v"(hi)); return r; }
typedef float f32x2 __attribute__((ext_vector_type(2)));
__device__ __forceinline__ float bf_lo(unsigned w) { return __uint_as_float(w << 16); }
__device__ __forceinline__ float bf_hi(unsigned w) { return __uint_as_float(w & 0xffff0000u); }
template <int ACT> struct EpiStoreBf16 {
    static constexpr bool PERM = true, AFTER_DRAIN = false, MIDK = false;
    bf16_t* O; int ldc;
    __device__ __forceinline__ void operator()(const f32x4 (&acc)[2][2][4][2], const Unit& u, int wr, int wc, int fr, int fq) const {
        const int row0 = u.pm * BM + wr * 64 + fr; const int col0 = u.pn * BM + wc * 32 + 8 * fq;
#pragma unroll
        for (int ai = 0; ai < 2; ++ai)
#pragma unroll
            for (int m = 0; m < 4; ++m) { bf16_t* rowp = O + (size_t)(row0 + ai * HALF + m * 16) * ldc + col0;
#pragma unroll
                for (int bj = 0; bj < 2; ++bj) { f32x4 v0 = acc[ai][bj][m][0], v1 = acc[ai][bj][m][1];
                    if (ACT == 2) {
#pragma unroll
                        for (int i = 0; i < 4; ++i) { const float a = fmaxf(v0[i], 0.f), b = fmaxf(v1[i], 0.f); v0[i] = a * a; v1[i] = b * b; } }
                    u32x4 w; w.x = cvt_pk_bf16(v0[0], v0[1]); w.y = cvt_pk_bf16(v0[2], v0[3]); w.z = cvt_pk_bf16(v1[0], v1[1]); w.w = cvt_pk_bf16(v1[2], v1[3]);
                    *(u32x4*)(rowp + bj * HALF) = w; } }
    }
};
struct EpiGlu {
    static constexpr bool PERM = true, AFTER_DRAIN = false, MIDK = false;
    const bf16_t* Gm; bf16_t* O; const float* bias; float* rowss;
    __device__ __forceinline__ void operator()(const f32x4 (&acc)[2][2][4][2], const Unit& u, int wr, int wc, int fr, int fq) const {
        const int row0 = u.pm * BM + wr * 64 + fr; const int col0 = u.pn * BM + wc * 32 + 8 * fq;
        float ssq[8];
#pragma unroll
        for (int i = 0; i < 8; ++i) ssq[i] = 0.f;
#pragma unroll
        for (int bj = 0; bj < 2; ++bj) { const f32x4 b0 = *(const f32x4*)(bias + col0 + bj * HALF), b1 = *(const f32x4*)(bias + col0 + bj * HALF + 4);
#pragma unroll
            for (int ai = 0; ai < 2; ++ai)
#pragma unroll
                for (int m = 0; m < 4; ++m) { const size_t row = (size_t)(row0 + ai * HALF + m * 16); const int col = col0 + bj * HALF;
                    const u32x4 gw = *(const u32x4*)(Gm + row * 1024 + col);
                    const f32x4 a0 = acc[ai][bj][m][0] + b0, a1 = acc[ai][bj][m][1] + b1;
                    float g[8] = {bf_lo(gw.x), bf_hi(gw.x), bf_lo(gw.y), bf_hi(gw.y), bf_lo(gw.z), bf_hi(gw.z), bf_lo(gw.w), bf_hi(gw.w)};
                    float o[8]; float sq = 0.f;
#pragma unroll
                    for (int i = 0; i < 4; ++i) { o[i] = g[i] / (1.f + __expf(-a0[i])); o[4 + i] = g[4 + i] / (1.f + __expf(-a1[i])); }
#pragma unroll
                    for (int i = 0; i < 8; ++i) sq += o[i] * o[i];
                    ssq[ai * 4 + m] += sq;
                    u32x4 w; w.x = cvt_pk_bf16(o[0], o[1]); w.y = cvt_pk_bf16(o[2], o[3]); w.z = cvt_pk_bf16(o[4], o[5]); w.w = cvt_pk_bf16(o[6], o[7]);
                    *(u32x4*)(O + row * 2048 + 1024 + col) = w; } }
#pragma unroll
        for (int ai = 0; ai < 2; ++ai)
#pragma unroll
            for (int m = 0; m < 4; ++m) { float v = ssq[ai * 4 + m]; v += __shfl_xor(v, 16); v += __shfl_xor(v, 32);
                if (fq == 0) unsafeAtomicAdd(rowss + row0 + ai * HALF + m * 16, v); }
    }
};
struct EpiHres {
    static constexpr bool PERM = true, AFTER_DRAIN = false, MIDK = true;
    const bf16_t* XN; const float* xrms; const float* ga; bf16_t* HG; const float* gm; float* rowss; const float* ssa; const float* sss;
    __device__ __forceinline__ float rnorm(const float* p, int row) const { return rsqrtf(__hip_atomic_load(p + row, __ATOMIC_RELAXED, __HIP_MEMORY_SCOPE_AGENT) * (1.0f / 1024.0f) + 1e-6f); }
    __device__ __forceinline__ void midk(f32x4 (&acc)[2][2][4][2], const Unit& u, int wr, int fr) const {
        int br = u.pm * BM + wr * 64 + fr; asm volatile("" : "+v"(br) :: "memory");
        const float* pa = ssa + br; const float* ps = sss + br;
#pragma unroll
        for (int ai = 0; ai < 2; ++ai)
#pragma unroll
            for (int m = 0; m < 4; ++m) { const int o = ai * HALF + m * 16;
                const float va = __hip_atomic_load(pa + o, __ATOMIC_RELAXED, __HIP_MEMORY_SCOPE_AGENT), vs = __hip_atomic_load(ps + o, __ATOMIC_RELAXED, __HIP_MEMORY_SCOPE_AGENT);
                const float ratio = rsqrtf(va * (1.0f / 1024.0f) + 1e-6f) * sqrtf(vs * (1.0f / 1024.0f) + 1e-6f);
#pragma unroll
                for (int bj = 0; bj < 2; ++bj)
#pragma unroll
                    for (int n = 0; n < 2; ++n) acc[ai][bj][m][n] *= ratio; }
    }
    __device__ __forceinline__ void operator()(const f32x4 (&acc)[2][2][4][2], const Unit& u, int wr, int wc, int fr, int fq) const {
        const int row0 = u.pm * BM + wr * 64 + fr, col0 = u.pn * BM + wc * 32 + 8 * fq;
#pragma unroll
        for (int ai = 0; ai < 2; ++ai)
#pragma unroll
            for (int m = 0; m < 4; ++m) { const int row = row0 + ai * HALF + m * 16;
                const float xr = xrms[row]; const float rs = rnorm(sss, row);
                float ss = 0.f;
#pragma unroll
                for (int bj = 0; bj < 2; ++bj) { const int col = col0 + bj * HALF; const size_t off = (size_t)row * 2048 + col;
                    const u32x4 xw = *(const u32x4*)(XN + off);
                    const f32x4 ga0 = *(const f32x4*)(ga + col), ga1 = *(const f32x4*)(ga + col + 4), gm0 = *(const f32x4*)(gm + col), gm1 = *(const f32x4*)(gm + col + 4);
                    const f32x4 x0 = f32x4{bf_lo(xw.x) * __builtin_amdgcn_rcpf(ga0[0]), bf_hi(xw.x) * __builtin_amdgcn_rcpf(ga0[1]), bf_lo(xw.y) * __builtin_amdgcn_rcpf(ga0[2]), bf_hi(xw.y) * __builtin_amdgcn_rcpf(ga0[3])} * xr;
                    const f32x4 x1 = f32x4{bf_lo(xw.z) * __builtin_amdgcn_rcpf(ga1[0]), bf_hi(xw.z) * __builtin_amdgcn_rcpf(ga1[1]), bf_lo(xw.w) * __builtin_amdgcn_rcpf(ga1[2]), bf_hi(xw.w) * __builtin_amdgcn_rcpf(ga1[3])} * xr;
                    const f32x4 h0 = x0 + acc[ai][bj][m][0] * rs, h1 = x1 + acc[ai][bj][m][1] * rs;
                    ss += ((h0[0] * h0[0] + h0[1] * h0[1]) + (h0[2] * h0[2] + h0[3] * h0[3])) + ((h1[0] * h1[0] + h1[1] * h1[1]) + (h1[2] * h1[2] + h1[3] * h1[3]));
                    u32x4 w; w.x = cvt_pk_bf16(h0[0] * gm0[0], h0[1] * gm0[1]); w.y = cvt_pk_bf16(h0[2] * gm0[2], h0[3] * gm0[3]); w.z = cvt_pk_bf16(h1[0] * gm1[0], h1[1] * gm1[1]); w.w = cvt_pk_bf16(h1[2] * gm1[2], h1[3] * gm1[3]);
                    *(u32x4*)(HG + off) = w; }
                ss += __shfl_xor(ss, 16); ss += __shfl_xor(ss, 32);
                if (fq == 0) unsafeAtomicAdd(rowss + row, ss);
                asm volatile("" ::: "memory"); }
    }
};
struct EpiDown {
    static constexpr bool PERM = true, AFTER_DRAIN = false, MIDK = false;
    float* Y; const float* rowss; const bf16_t* HG; const float* gm;
    __device__ __forceinline__ void operator()(const f32x4 (&acc)[2][2][4][2], const Unit& u, int wr, int wc, int fr, int fq) const {
        const int row0 = u.pm * BM + wr * 64 + fr, col0 = u.pn * BM + wc * 32 + 8 * fq;
        f32x4 gi[2][2];
#pragma unroll
        for (int bj = 0; bj < 2; ++bj)
#pragma unroll
            for (int n = 0; n < 2; ++n) { const f32x4 gv = *(const f32x4*)(gm + col0 + bj * HALF + 4 * n);
                gi[bj][n] = f32x4{__builtin_amdgcn_rcpf(gv[0]), __builtin_amdgcn_rcpf(gv[1]), __builtin_amdgcn_rcpf(gv[2]), __builtin_amdgcn_rcpf(gv[3])}; }
#pragma unroll
        for (int ai = 0; ai < 2; ++ai)
#pragma unroll
            for (int m = 0; m < 4; ++m) { const int row = row0 + ai * HALF + m * 16;
                const float ssr = __hip_atomic_load(rowss + row, __ATOMIC_RELAXED, __HIP_MEMORY_SCOPE_AGENT);
                const float r2 = 1.0f / (ssr * (1.0f / 2048.0f) + 1e-6f);
#pragma unroll
                for (int bj = 0; bj < 2; ++bj) { const size_t off = (size_t)row * 2048 + col0 + bj * HALF;
                    const u32x4 hw = *(const u32x4*)(HG + off);
                    const f32x4 h0 = f32x4{bf_lo(hw.x), bf_hi(hw.x), bf_lo(hw.y), bf_hi(hw.y)} * gi[bj][0], h1 = f32x4{bf_lo(hw.z), bf_hi(hw.z), bf_lo(hw.w), bf_hi(hw.w)} * gi[bj][1];
                    *(f32x4*)(Y + off) = h0 + acc[ai][bj][m][0] * r2; *(f32x4*)(Y + off + 4) = h1 + acc[ai][bj][m][1] * r2; } }
    }
};
struct EpiPartial {
    static constexpr bool PERM = true, AFTER_DRAIN = false, MIDK = false;
    float* P; int kper;
    __device__ __forceinline__ void operator()(const f32x4 (&acc)[2][2][4][2], const Unit& u, int wr, int wc, int fr, int fq) const {
        const int col0 = u.pn * BM + wc * 32 + 8 * fq; float* base = P + (size_t)(u.k0 / kper) * (512 * 2048);
#pragma unroll
        for (int ai = 0; ai < 2; ++ai)
#pragma unroll
            for (int m = 0; m < 4; ++m) { const int row = (u.pm - 64) * BM + ai * HALF + wr * 64 + m * 16 + fr;
#pragma unroll
                for (int bj = 0; bj < 2; ++bj) { float* p = base + (size_t)row * 2048 + col0 + bj * HALF; *(f32x4*)p = acc[ai][bj][m][0]; *(f32x4*)(p + 4) = acc[ai][bj][m][1]; } }
    }
};
template <int NN  , int NS  , int NTK  > struct SampleSplitOrder {
    int G, c;
    __device__ __forceinline__ void init(int G_, int c_) { G = G_; c = c_; }
    __device__ __forceinline__ bool next(int i, Unit& u) const {
        const int item = i * G + c; if (item >= 2 * NN * NS) return false;
        const int t = item / NS, s = item % NS; u.pm = 64 + t / NN; u.pn = t % NN; u.nt = NTK / NS; u.k0 = s * (NTK / NS) * BK; u.cont = 0; return true;
    }
    __device__ __forceinline__ void a_ready(const Unit&) const {}
    __device__ __forceinline__ void done(const Unit&) const {}
};

struct HalfKOrder {
    StaticOrder base;
    __device__ __forceinline__ void init(int M, int N, int G_, int c_, int K) { base.init(M, N, G_, c_, K); }
    __device__ __forceinline__ bool next(int i, Unit& u) const {
        if (!base.next(i >> 1, u)) return false;
        u.nt = base.ntk >> 1; u.k0 = (i & 1) * u.nt * BK; u.cont = (i & 1) ^ 1; return true;
    }
    __device__ __forceinline__ void a_ready(const Unit&) const {}
    __device__ __forceinline__ void done(const Unit&) const {}
};

template <class Epi, class Sched, bool ALIGN_EPI = false, bool SP2 = false>
__device__ __forceinline__ void gemm_phase(PG8_LAS unsigned char* lds, const Gemm g, const Sched& S, const Epi& E) {
    int tid_ = threadIdx.x; asm volatile("" : "+v"(tid_));
    const int tid = tid_, wid = __builtin_amdgcn_readfirstlane(tid >> 6), lane = tid & 63, wr = wid >> 2, wc = wid & 3, fr = lane & 15, fq = lane >> 4;
    const int K = g.K; int nt;
    unsigned voffA[2], voffB[2];
#pragma unroll
    for (int i = 0; i < 2; ++i) { int R, C; stage_rc(tid * 16 + i * 8192, R, C); const int Rb = Epi::PERM ? ((R & ~31) + perm32(R & 31)) : R;
        voffA[i] = (unsigned)(R * K + C) * 2u; voffB[i] = (unsigned)(Rb * K + C) * 2u; }
    const size_t kstep = (size_t)(BK * 2);
    const size_t hstep = (size_t)HALF * K * 2;
    const size_t tstep = 2 * hstep;
    const unsigned ldsw = (unsigned)wid * 1024u;
    const int aoff = lds_byte(wr * 64 + fr, fq * 8), boff = lds_byte(wc * 32 + fr, fq * 8);
#define PG8_SA(b, h) (((b) * 2 + (h)) * HTB)
#define PG8_SB(b, h) ((4 + (b) * 2 + (h)) * HTB)
#define PG8_STAGE(bufoff, gbase, voff) do { _Pragma("unroll") for (int _i = 0; _i < 2; ++_i) \
        __builtin_amdgcn_global_load_lds((const unsigned*)((const char*)(gbase) + (voff)[_i]), (PG8_LAS unsigned*)(lds + (bufoff) + ldsw + _i * 8192), 16, 0, 0); } while (0)
#define PG8_LDA(dst, b, h) do { _Pragma("unroll") for (int m = 0; m < 4; ++m) _Pragma("unroll") for (int k = 0; k < 2; ++k) dst[m][k] = *(const PG8_LAS bf16x8*)(lds + PG8_SA(b, h) + aoff + m * 2048 + k * 1024); } while (0)
#define PG8_LDB(dst, b, h) do { _Pragma("unroll") for (int n = 0; n < 2; ++n) _Pragma("unroll") for (int k = 0; k < 2; ++k) dst[n][k] = *(const PG8_LAS bf16x8*)(lds + PG8_SB(b, h) + boff + n * 2048 + k * 1024); } while (0)
#define PG8_MMA(ai, bj, At, Bt) do { __builtin_amdgcn_s_setprio(1); _Pragma("unroll") for (int m = 0; m < 4; ++m) _Pragma("unroll") for (int n = 0; n < 2; ++n) _Pragma("unroll") for (int k = 0; k < 2; ++k) \
        acc[ai][bj][m][n] = __builtin_amdgcn_mfma_f32_16x16x32_bf16(Bt[n][k], At[m][k], acc[ai][bj][m][n], 0, 0, 0); __builtin_amdgcn_s_setprio(0); } while (0)
#define PG8_WAIT_V(n) asm volatile("s_waitcnt vmcnt(" #n ")" ::: "memory")
#define PG8_WAIT_L(n) asm volatile("s_waitcnt lgkmcnt(" #n ")" ::: "memory")
#define PG8_BAR __builtin_amdgcn_s_barrier()
#define PG8_SCHED __builtin_amdgcn_sched_barrier(0)
    Unit cur, nxt; int ui = 0;
    if (!S.next(0, cur)) return;
    nt = cur.nt;
    f32x4 acc[2][2][4][2];
#pragma unroll
    for (int a = 0; a < 2; ++a)
#pragma unroll
        for (int b = 0; b < 2; ++b)
#pragma unroll
            for (int m = 0; m < 4; ++m)
#pragma unroll
                for (int n = 0; n < 2; ++n) acc[a][b][m][n] = (f32x4){0.f, 0.f, 0.f, 0.f};
    bf16x8 At[4][2], B0[2][2], B1[2][2];
    const char* cA = (const char*)g.A + (size_t)cur.pm * tstep + (size_t)cur.k0 * 2; const char* cB = (const char*)g.Bt + (size_t)cur.pn * tstep + (size_t)cur.k0 * 2;
    S.a_ready(cur);
    if constexpr (SP2) {
        PG8_STAGE(PG8_SB(0, 0), cB, voffB); PG8_STAGE(PG8_SB(0, 1), cB + hstep, voffB); PG8_STAGE(PG8_SA(0, 0), cA, voffA); PG8_STAGE(PG8_SA(0, 1), cA + hstep, voffA);
        if (wr == 1) PG8_BAR;
        PG8_WAIT_V(2); PG8_BAR;
        PG8_STAGE(PG8_SB(1, 0), cB + kstep, voffB); PG8_STAGE(PG8_SA(1, 0), cA + kstep, voffA); PG8_STAGE(PG8_SB(1, 1), cB + hstep + kstep, voffB);
        PG8_WAIT_V(6); PG8_BAR;
    } else {
        PG8_STAGE(PG8_SB(0, 0), cB, voffB); PG8_STAGE(PG8_SA(0, 0), cA, voffA); PG8_STAGE(PG8_SB(0, 1), cB + hstep, voffB); PG8_STAGE(PG8_SA(0, 1), cA + hstep, voffA);
        if (wr == 1) PG8_BAR;
        PG8_WAIT_V(4); PG8_BAR;
        PG8_STAGE(PG8_SB(1, 0), cB + kstep, voffB); PG8_STAGE(PG8_SA(1, 0), cA + kstep, voffA); PG8_STAGE(PG8_SB(1, 1), cB + hstep + kstep, voffB);
        PG8_WAIT_V(6); PG8_BAR;
    }
    for (;;) {
        const bool has_next = S.next(ui + 1, nxt);
        const char* nA = has_next ? (const char*)g.A + (size_t)nxt.pm * tstep + (size_t)nxt.k0 * 2 : cA; const char* nB = has_next ? (const char*)g.Bt + (size_t)nxt.pn * tstep + (size_t)nxt.k0 * 2 : cB;
        for (int t = 0; t < nt; t += 2) {
            if constexpr (Epi::MIDK) { if (t == (nt >> 1)) E.midk(acc, cur, wr, fr); }
            const bool last = (t == nt - 2);
            const char* a1 = cA + (size_t)(t + 1) * kstep;
            const char* a2 = last ? nA : cA + (size_t)(t + 2) * kstep; const char* b2 = last ? nB : cB + (size_t)(t + 2) * kstep;
            const char* a3 = a2 + kstep; const char* b3 = b2 + kstep;
            if (last && has_next) S.a_ready(nxt);
            if constexpr (SP2) {
            PG8_LDB(B0, 0, 0); PG8_LDB(B1, 0, 1); PG8_SCHED; PG8_LDA(At, 0, 0); PG8_STAGE(PG8_SA(1, 1), a1 + hstep, voffA);
            PG8_WAIT_V(8); PG8_WAIT_L(0); PG8_BAR; PG8_MMA(0, 0, At, B0); PG8_MMA(0, 1, At, B1); PG8_BAR; PG8_SCHED;
            PG8_LDA(At, 0, 1); PG8_STAGE(PG8_SB(0, 0), b2, voffB); PG8_STAGE(PG8_SB(0, 1), b2 + hstep, voffB); PG8_STAGE(PG8_SA(0, 0), a2, voffA);
            PG8_WAIT_V(8); PG8_WAIT_L(0); PG8_BAR; PG8_MMA(1, 0, At, B0); PG8_MMA(1, 1, At, B1); PG8_BAR; PG8_SCHED;
            PG8_LDB(B0, 1, 0); PG8_LDB(B1, 1, 1); PG8_SCHED; PG8_LDA(At, 1, 0); PG8_STAGE(PG8_SA(0, 1), a2 + hstep, voffA);
            PG8_WAIT_V(8); PG8_WAIT_L(0); PG8_BAR; PG8_MMA(0, 0, At, B0); PG8_MMA(0, 1, At, B1); PG8_BAR; PG8_SCHED;
            PG8_LDA(At, 1, 1); PG8_STAGE(PG8_SB(1, 0), b3, voffB); PG8_STAGE(PG8_SB(1, 1), b3 + hstep, voffB); PG8_STAGE(PG8_SA(1, 0), a3, voffA);
            PG8_WAIT_V(8); PG8_WAIT_L(0); PG8_BAR; PG8_MMA(1, 0, At, B0); PG8_MMA(1, 1, At, B1); PG8_BAR; PG8_SCHED;
            } else {
            PG8_LDB(B0, 0, 0); PG8_SCHED; PG8_LDA(At, 0, 0); PG8_STAGE(PG8_SA(1, 1), a1 + hstep, voffA);
            PG8_WAIT_L(8); PG8_BAR; PG8_WAIT_L(0); PG8_MMA(0, 0, At, B0); PG8_BAR; PG8_SCHED;
            PG8_LDB(B1, 0, 1); PG8_STAGE(PG8_SB(0, 0), b2, voffB);
            PG8_BAR; PG8_WAIT_L(0); PG8_MMA(0, 1, At, B1); PG8_BAR;
            PG8_LDA(At, 0, 1); PG8_STAGE(PG8_SA(0, 0), a2, voffA);
            PG8_BAR; PG8_WAIT_L(0); PG8_MMA(1, 0, At, B0); PG8_BAR; PG8_SCHED;
            PG8_STAGE(PG8_SB(0, 1), b2 + hstep, voffB);
            PG8_WAIT_V(6); PG8_BAR; PG8_MMA(1, 1, At, B1); PG8_BAR;
            PG8_LDB(B0, 1, 0); PG8_SCHED; PG8_LDA(At, 1, 0); PG8_STAGE(PG8_SA(0, 1), a2 + hstep, voffA);
            PG8_WAIT_L(8); PG8_BAR; PG8_WAIT_L(0); PG8_MMA(0, 0, At, B0); PG8_BAR; PG8_SCHED;
            PG8_LDB(B1, 1, 1); PG8_STAGE(PG8_SB(1, 0), b3, voffB);
            PG8_BAR; PG8_WAIT_L(0); PG8_MMA(0, 1, At, B1); PG8_BAR;
            PG8_LDA(At, 1, 1); PG8_STAGE(PG8_SA(1, 0), a3, voffA);
            PG8_BAR; PG8_WAIT_L(0); PG8_MMA(1, 0, At, B0); PG8_BAR; PG8_SCHED;
            PG8_STAGE(PG8_SB(1, 1), b3 + hstep, voffB);
            PG8_WAIT_V(6); PG8_BAR; PG8_MMA(1, 1, At, B1); PG8_BAR;
            }
        }
        if constexpr (ALIGN_EPI) { if (wr == 0) PG8_BAR; }
        if constexpr (!Epi::AFTER_DRAIN) { E(acc, cur, wr, wc, fr, fq); S.done(cur); }
        if (!has_next) break;
#pragma unroll
        for (int a = 0; a < 2; ++a)
#pragma unroll
            for (int b = 0; b < 2; ++b)
#pragma unroll
                for (int m = 0; m < 4; ++m)
#pragma unroll
                    for (int n = 0; n < 2; ++n) acc[a][b][m][n] = (f32x4){0.f, 0.f, 0.f, 0.f};
        cur = nxt; cA = nA; cB = nB; ++ui; nt = cur.nt;
        if constexpr (ALIGN_EPI) { if (wr == 1) PG8_BAR; }
    }
    PG8_WAIT_V(0);
    if constexpr (!ALIGN_EPI) { if (wr == 0) PG8_BAR; }
    PG8_BAR;
    if constexpr (Epi::AFTER_DRAIN) { E.fused(acc, cur, wr, wc, fr, fq, lds, wid, lane); S.done(cur); }
#undef PG8_SA
#undef PG8_SB
#undef PG8_STAGE
#undef PG8_LDA
#undef PG8_LDB
#undef PG8_MMA
#undef PG8_WAIT_V
#undef PG8_WAIT_L
#undef PG8_BAR
#undef PG8_SCHED
}
}

#define LAS __attribute__((address_space(3)))
typedef unsigned short bf16;
typedef unsigned v4u __attribute__((ext_vector_type(4)));
typedef unsigned v2u __attribute__((ext_vector_type(2)));
typedef float f32x4 __attribute__((ext_vector_type(4)));
typedef float f32x16 __attribute__((ext_vector_type(16)));
typedef float f32x2 __attribute__((ext_vector_type(2)));
typedef short bf16x8 __attribute__((ext_vector_type(8)));

#ifndef MK_PER_PHASE
#define MK_PER_PHASE 0
#endif
constexpr int NPHASE = 9;
constexpr int NWAVES = 8, NTHR = 512;
constexpr int MP = 16384, MS = 512, MT = MP + MS;
constexpr int DM = 2048, PW = 2560, AW = 1024, SWD = 1024, FF = 8192;
constexpr float EPSN = 1e-6f, LOG2E = 1.4426950408889634f;
constexpr int LDS_PHASE = 152576;
constexpr int LDS_BYTES = LDS_PHASE + 64;

constexpr size_t MiB = 1u << 20;
constexpr size_t WS_CTL = 0, CTL_ZERO_BYTES = 272 * 1024, WS_BAR = 96 * 1024, WS_SSA = 128 * 1024, WS_SSS = 200 * 1024, WS_XR = 512 * 1024;
constexpr size_t WS_WIN = 1 * MiB, WS_WGLU = 11 * MiB, WS_WOUT = 13 * MiB, WS_WUP = 21 * MiB, WS_WDN = 53 * MiB;
constexpr size_t WS_WSF = 85 * MiB, WS_WHF = 89 * MiB, WS_TF = 93 * MiB, WS_LAM = 94 * MiB + 512 * 1024, WS_LAM16 = WS_LAM + 32768, WS_BBAR = WS_LAM + 65536;
constexpr size_t WS_HG = 96 * MiB;
constexpr size_t WS_PART = 426 * MiB;
constexpr size_t WS_ACT = 162 * MiB;
constexpr size_t WS_XN = 162 * MiB, WS_Z = 228 * MiB, WS_ATT = 311 * MiB, WS_G = 344 * MiB, WS_SO = 377 * MiB, WS_MIX = 410 * MiB, WS_END = 490 * MiB;

constexpr size_t O_Y = 0, O_KP = (size_t)MT * DM, O_VP = O_KP + 262144, O_RP = O_VP + 262144, O_IP = O_RP + 32768, O_KS = O_IP + 32768,
                 O_VS = O_KS + 4194304, O_RS = O_VS + 4194304, O_IS = O_RS + 524288, O_END = O_IS + 524288;

struct Args { const float* in[27]; float* out; unsigned char* ws; int ph_lo, ph_hi; };
enum { I_XP = 0, I_XS, I_CK, I_CV, I_SR, I_SI, I_ANG, I_WIN, I_QG, I_KG, I_SINK, I_ARE, I_AIM, I_LDT, I_BRE, I_BIM, I_CRE, I_CIM, I_D, I_WGLU, I_BGLU,
       I_AOG, I_SOG, I_WOUT, I_MNG, I_WUP, I_WDN };

__device__ __forceinline__ unsigned pk2(float lo, float hi) { unsigned r; asm("v_cvt_pk_bf16_f32 %0, %1, %2" : "=v"(r) : "v"(lo), "v"(hi)); return r; }
__device__ __forceinline__ unsigned f2bf(float f) { return pk2(f, 0.f) & 0xffffu; }
__device__ __forceinline__ float bflo(unsigned w) { return __uint_as_float(w << 16); }
__device__ __forceinline__ float bfhi(unsigned w) { return __uint_as_float(w & 0xffff0000u); }
__device__ __forceinline__ float wave_sum(float v) {
#pragma unroll
    for (int o = 1; o < 64; o <<= 1) v += __shfl_xor(v, o);
    return v;
}
__device__ __forceinline__ int crow(int r, int hi) { return (r & 3) + 8 * (r >> 2) + 4 * hi; }
__device__ __forceinline__ float gelu_tanh(float y) { const float z = 1.5957691216057308f * (y + 0.044715f * y * y * y); return y / (1.f + __expf(-z)); }

__device__ __forceinline__ void p0_transpose_item(const float* W, int K, int N, bf16* WT, LAS float* scr, int item, int lane, const float* g0 = nullptr, const float* g1 = nullptr) {
    const int nblk = N / 32, kb = item / nblk, nb = item % nblk, k0 = 64 * kb, n0 = 32 * nb;
    f32x4 v[8];
#pragma unroll
    for (int i = 0; i < 8; ++i) v[i] = *(const f32x4*)(W + (size_t)(k0 + 8 * i + (lane >> 3)) * N + n0 + 4 * (lane & 7));
#pragma unroll
    for (int i = 0; i < 8; ++i) { LAS float* d = scr + (8 * i + (lane >> 3)) * 33 + 4 * (lane & 7); float gs = 1.f; if (g0) { const int k = k0 + 8 * i + (lane >> 3); gs = k < (K >> 1) ? g0[k] : g1[k - (K >> 1)]; }
        d[0] = v[i].x * gs; d[1] = v[i].y * gs; d[2] = v[i].z * gs; d[3] = v[i].w * gs; }
    asm volatile("s_waitcnt lgkmcnt(0)" ::: "memory");
    const int c = lane & 7;
#pragma unroll
    for (int j = 0; j < 4; ++j) { const int n = (lane >> 3) + 8 * j; const LAS float* s = scr + (8 * c) * 33 + n;
        v4u o; o.x = pk2(s[0 * 33], s[1 * 33]); o.y = pk2(s[2 * 33], s[3 * 33]); o.z = pk2(s[4 * 33], s[5 * 33]); o.w = pk2(s[6 * 33], s[7 * 33]);
        *(v4u*)(WT + (size_t)(n0 + n) * K + k0 + 8 * c) = o; }
    asm volatile("s_waitcnt lgkmcnt(0)" ::: "memory");
}
struct cpx { float re, im; };
__device__ __forceinline__ cpx cmul(cpx a, cpx b) { return {a.re * b.re - a.im * b.im, a.re * b.im + a.im * b.re}; }
__device__ __forceinline__ cpx lam_pow(float a, float th, int n) { const float e = expf((float)n * a), x = (float)n * th; return {e * cosf(x), e * sinf(x)}; }
__device__ __forceinline__ cpx zoh_coef(float are, float aim, float dt) {
    const float a = dt * are, th = dt * aim, em1 = expm1f(a), s = sinf(th), c = cosf(th), sh = sinf(0.5f * th);
    const float nr = em1 * c - 2.f * sh * sh, ni = (em1 + 1.f) * s, den = are * are + aim * aim;
    return {(nr * are + ni * aim) / den, (ni * are - nr * aim) / den};
}

__device__ __forceinline__ void p0_prologue(const Args& A, LAS unsigned char* lds, int vcu, int G, int tid, int wave, int lane) {
    unsigned char* ws = A.ws;
    LAS float* scr = (LAS float*)(lds + wave * 8448);
    const int gw = vcu * NWAVES + wave, NGW = G * NWAVES;
    constexpr int I_1 = (DM / 64) * (PW / 32);
    for (int it = gw; it < I_1; it += NGW) p0_transpose_item(A.in[I_WIN], DM, PW, (bf16*)(ws + WS_WIN), scr, it, lane);
    {
        f32x4 gv[8];
#pragma unroll
        for (int j = 0; j < 8; ++j) gv[j] = ((const f32x4*)A.in[I_ANG])[lane + 64 * j];
        bf16* XN = (bf16*)(ws + WS_XN);
        for (int m = gw; m < MT; m += NGW) {
            const float* xrow = m < MP ? A.in[I_XP] + (size_t)m * DM : A.in[I_XS] + (size_t)(m - MP) * DM;
            f32x4 v[8]; float s = 0.f;
#pragma unroll
            for (int j = 0; j < 8; ++j) { v[j] = ((const f32x4*)xrow)[lane + 64 * j]; s += (v[j].x * v[j].x + v[j].y * v[j].y) + (v[j].z * v[j].z + v[j].w * v[j].w); }
            const float r = rsqrtf(wave_sum(s) * (1.f / DM) + EPSN);
            if (lane == 0) ((float*)(ws + WS_XR))[m] = 1.0f / r;
            v2u* o8 = (v2u*)(XN + (size_t)m * DM) + lane;
#pragma unroll
            for (int j = 0; j < 8; ++j) { v2u w; w.x = pk2(v[j].x * r * gv[j].x, v[j].y * r * gv[j].y); w.y = pk2(v[j].z * r * gv[j].z, v[j].w * r * gv[j].w); o8[64 * j] = w; }
        }
    }
    const float* Are = A.in[I_ARE]; const float* Aim = A.in[I_AIM]; const float* Ldt = A.in[I_LDT];
    const float* Bre = A.in[I_BRE]; const float* Bim = A.in[I_BIM]; const float* Cre = A.in[I_CRE]; const float* Cim = A.in[I_CIM];
    const int gt = vcu * NTHR + tid, NT = G * NTHR;
    for (int idx = gt; idx < 4096; idx += NT) {
        const int g = idx >> 6, p = idx & 63; const float dt = expf(Ldt[g]), are = Are[idx], aim = Aim[idx];
        const cpx l1 = lam_pow(dt * are, dt * aim, 1), l16 = lam_pow(dt * are, dt * aim, 16), cf = zoh_coef(are, aim, dt);
        ((float2*)(ws + WS_LAM))[idx] = make_float2(l1.re, l1.im); ((float2*)(ws + WS_LAM16))[idx] = make_float2(l16.re, l16.im);
#pragma unroll 4
        for (int ch = 0; ch < 16; ++ch) { const cpx b = cmul(cf, cpx{Bre[idx * 16 + ch], Bim[idx * 16 + ch]}); ((float2*)(ws + WS_BBAR))[(g * 16 + ch) * 64 + p] = make_float2(b.re, b.im); }
    }
    for (int idx = gt; idx < 64 * 4 * 16 * 64; idx += NT) {
        const int l = idx & 63, s = (idx >> 6) & 15, rt = (idx >> 10) & 3, g = idx >> 12, r32 = l & 31, hi = l >> 5;
        const int m = 32 * rt + r32, p = m & 63, part = m >> 6, gp = g * 64 + p; const float dt = expf(Ldt[g]), are = Are[gp], aim = Aim[gp];
        const cpx w = cmul(lam_pow(dt * are, dt * aim, 15 - s), zoh_coef(are, aim, dt));
        float v[8];
#pragma unroll
        for (int j = 0; j < 8; ++j) { const int ch = 8 * hi + j; const float br = Bre[gp * 16 + ch], bi = Bim[gp * 16 + ch]; v[j] = part ? (w.re * bi + w.im * br) : (w.re * br - w.im * bi); }
        v4u o; o.x = pk2(v[0], v[1]); o.y = pk2(v[2], v[3]); o.z = pk2(v[4], v[5]); o.w = pk2(v[6], v[7]);
        ((v4u*)(ws + WS_WSF))[idx] = o;
    }
    for (int idx = gt; idx < 64 * 8 * 8 * 64; idx += NT) {
        const int l = idx & 63, kb = (idx >> 6) & 7, tt = (idx >> 9) & 7, g = idx >> 12, r32 = l & 31, hi = l >> 5;
        const int ti = r32 >> 4, chp = r32 & 15, tl = 2 * tt + ti; const float dt = expf(Ldt[g]);
        float v[8];
#pragma unroll
        for (int jp = 0; jp < 4; ++jp) { const int p = 8 * kb + 4 * hi + jp, gp = g * 64 + p;
            const cpx w = cmul(cpx{Cre[(g * 16 + chp) * 64 + p], Cim[(g * 16 + chp) * 64 + p]}, lam_pow(dt * Are[gp], dt * Aim[gp], tl + 1));
            v[2 * jp] = w.re; v[2 * jp + 1] = -w.im; }
        v4u o; o.x = pk2(v[0], v[1]); o.y = pk2(v[2], v[3]); o.z = pk2(v[4], v[5]); o.w = pk2(v[6], v[7]);
        ((v4u*)(ws + WS_WHF))[idx] = o;
    }
    __syncthreads();
    for (int g = vcu; g < 64; g += G) {
        LAS f32x2* pw = (LAS f32x2*)lds;
        LAS f32x2* cf = (LAS f32x2*)(lds + 8192);
        LAS float* part = (LAS float*)(lds + 16384);
        { const int p = tid & 63, gp = g * 64 + p; const float dt = expf(Ldt[g]), are = Are[gp], aim = Aim[gp];
          const cpx w0 = lam_pow(dt * are, dt * aim, tid >> 6), w1 = lam_pow(dt * are, dt * aim, (tid >> 6) + 8);
          pw[(tid >> 6) * 64 + p] = f32x2{w0.re, w0.im}; pw[((tid >> 6) + 8) * 64 + p] = f32x2{w1.re, w1.im};
          if (tid < 64) { const cpx c1 = zoh_coef(are, aim, dt); cf[p] = f32x2{c1.re, c1.im}; } }
        __syncthreads();
        const int pair = tid & 255, ph = tid >> 8, chp = pair >> 4, ch = pair & 15;
        {
            float acc[16];
#pragma unroll
            for (int l = 0; l < 16; ++l) acc[l] = 0.f;
            for (int p = 32 * ph; p < 32 * ph + 32; ++p) { const f32x2 c2 = cf[p];
                const cpx q = cmul(cmul(cpx{Cre[(g * 16 + chp) * 64 + p], Cim[(g * 16 + chp) * 64 + p]}, cpx{c2.x, c2.y}), cpx{Bre[(g * 64 + p) * 16 + ch], Bim[(g * 64 + p) * 16 + ch]});
#pragma unroll
                for (int l = 0; l < 16; ++l) { const f32x2 w = pw[l * 64 + p]; acc[l] += q.re * w.x - q.im * w.y; } }
#pragma unroll
            for (int l = 0; l < 16; ++l) part[(ph * 16 + l) * 256 + pair] = acc[l];
        }
        __syncthreads();
        if (tid < 256) {
            bf16* TF = (bf16*)(ws + WS_TF) + (size_t)g * 17 * 512;
            const int hi2 = ch >> 3, j = ch & 7;
#pragma unroll
            for (int l = 0; l < 16; ++l) { const unsigned short v = (unsigned short)f2bf(part[l * 256 + pair] + part[(16 + l) * 256 + pair]);
                TF[(l * 64 + 32 * hi2 + 16 + chp) * 8 + j] = v;
                if (l < 15) TF[((l + 1) * 64 + 32 * hi2 + chp) * 8 + j] = v; }
            TF[(0 * 64 + 32 * hi2 + chp) * 8 + j] = 0;
            TF[(16 * 64 + 32 * hi2 + chp) * 8 + j] = 0; TF[(16 * 64 + 32 * hi2 + 16 + chp) * 8 + j] = 0;
        }
        __syncthreads();
    }
}

constexpr int KLS = 72, VTS = 264;
constexpr int LDS_K = 0, LDS_VT = 256 * KLS * 2;

__device__ __forceinline__ void attn_qtile(const LAS bf16* Kl, const LAS bf16* Vt, int kt0, const bf16x8 (&qf)[4], int iq, float slope2, float sink2, int jmin,
                                           f32x16 (&o)[2], float& inv_denom, int r32, int hi) {
    f32x16 S[5];
#pragma unroll
    for (int t5 = 0; t5 < 5; ++t5) {
        S[t5] = f32x16{};
#pragma unroll
        for (int d0 = 0; d0 < 4; ++d0) { const bf16x8 kf = *(const LAS bf16x8*)(Kl + (32 * (kt0 + t5) + r32) * KLS + 16 * d0 + 8 * hi); S[t5] = __builtin_amdgcn_mfma_f32_32x32x16_bf16(kf, qf[d0], S[t5], 0, 0, 0); }
    }
    float mx = sink2;
#pragma unroll
    for (int t5 = 0; t5 < 5; ++t5)
#pragma unroll
        for (int r = 0; r < 16; ++r) { const int j = 32 * (kt0 + t5) + crow(r, hi), delta = iq + 128 - j; const bool valid = (delta >= 0) && (delta <= 128) && (j >= jmin);
            const float s = valid ? S[t5][r] - slope2 * (float)delta : -1e30f; S[t5][r] = s; mx = fmaxf(mx, s); }
    mx = fmaxf(mx, __shfl_xor(mx, 32));
    float sum = 0.f;
#pragma unroll
    for (int t5 = 0; t5 < 5; ++t5)
#pragma unroll
        for (int r = 0; r < 16; ++r) { const float p = __builtin_amdgcn_exp2f(S[t5][r] - mx); sum += p; S[t5][r] = p; }
    sum += __shfl_xor(sum, 32);
    inv_denom = 1.0f / (sum + __builtin_amdgcn_exp2f(sink2 - mx));
    o[0] = f32x16{}; o[1] = f32x16{};
#pragma unroll
    for (int t5 = 0; t5 < 5; ++t5)
#pragma unroll
        for (int s2 = 0; s2 < 2; ++s2) {
            v4u pw; pw.x = pk2(S[t5][8 * s2 + 0], S[t5][8 * s2 + 1]); pw.y = pk2(S[t5][8 * s2 + 2], S[t5][8 * s2 + 3]); pw.z = pk2(S[t5][8 * s2 + 4], S[t5][8 * s2 + 5]); pw.w = pk2(S[t5][8 * s2 + 6], S[t5][8 * s2 + 7]);
            const bf16x8 pf = __builtin_bit_cast(bf16x8, pw);
#pragma unroll
            for (int dt = 0; dt < 2; ++dt) { const LAS bf16* vr = Vt + (32 * dt + r32) * VTS + 32 * (kt0 + t5) + 16 * s2 + 4 * hi;
                const v2u lo = *(const LAS v2u*)vr, hh = *(const LAS v2u*)(vr + 8); v4u vw; vw.x = lo.x; vw.y = lo.y; vw.z = hh.x; vw.w = hh.y;
                o[dt] = __builtin_amdgcn_mfma_f32_32x32x16_bf16(__builtin_bit_cast(bf16x8, vw), pf, o[dt], 0, 0, 0); }
        }
}
__device__ __forceinline__ void attn_qtile_fast(const LAS bf16* Kl, const LAS bf16* Vt, int kt0, const bf16x8 (&qf)[4], int iq, float slope2, float sink2,
                                                f32x16 (&o)[2], float& inv_denom, int r32, int hi) {
    f32x16 S[5];
    const float sbase = slope2 * (float)(4 * hi);
#pragma unroll
    for (int t5 = 0; t5 < 5; ++t5) {
        S[t5] = f32x16{};
#pragma unroll
        for (int d0 = 0; d0 < 4; ++d0) { const bf16x8 kf = *(const LAS bf16x8*)(Kl + (32 * (kt0 + t5) + r32) * KLS + 16 * d0 + 8 * hi); S[t5] = __builtin_amdgcn_mfma_f32_32x32x16_bf16(kf, qf[d0], S[t5], 0, 0, 0); }
    }
    const int D0 = iq + 128 - 32 * kt0 - 4 * hi, lo = D0 - 128;
    const float sinkp = sink2 + slope2 * (float)(iq + 128 - 32 * kt0);
    float m0 = -1e30f;
#pragma unroll
    for (int t5 = 0; t5 < 5; ++t5)
#pragma unroll
        for (int r = 0; r < 16; ++r) { const int off = 32 * t5 + (r & 3) + 8 * (r >> 2);
            float s = fmaf(slope2, (float)off, S[t5][r]);
            if (t5 == 0) s = (off >= lo) ? s : -1e30f;
            if (t5 == 4) s = (off <= D0) ? s : -1e30f;
            S[t5][r] = s; m0 = fmaxf(m0, s); }
    const float mloc = m0 + sbase;
    const float mx = fmaxf(sinkp, fmaxf(mloc, __shfl_xor(mloc, 32))), mxl = mx - sbase;
    float sum = 0.f;
#pragma unroll
    for (int t5 = 0; t5 < 5; ++t5)
#pragma unroll
        for (int r = 0; r < 16; ++r) { const float p = __builtin_amdgcn_exp2f(S[t5][r] - mxl); sum += p; S[t5][r] = p; }
    sum += __shfl_xor(sum, 32);
    inv_denom = 1.0f / (sum + __builtin_amdgcn_exp2f(sinkp - mx));
    o[0] = f32x16{}; o[1] = f32x16{};
#pragma unroll
    for (int t5 = 0; t5 < 5; ++t5)
#pragma unroll
        for (int s2 = 0; s2 < 2; ++s2) {
            v4u pw; pw.x = pk2(S[t5][8 * s2 + 0], S[t5][8 * s2 + 1]); pw.y = pk2(S[t5][8 * s2 + 2], S[t5][8 * s2 + 3]); pw.z = pk2(S[t5][8 * s2 + 4], S[t5][8 * s2 + 5]); pw.w = pk2(S[t5][8 * s2 + 6], S[t5][8 * s2 + 7]);
            const bf16x8 pf = __builtin_bit_cast(bf16x8, pw);
#pragma unroll
            for (int dt = 0; dt < 2; ++dt) { const LAS bf16* vr = Vt + (32 * dt + r32) * VTS + 32 * (kt0 + t5) + 16 * s2 + 4 * hi;
                const v2u lo2 = *(const LAS v2u*)vr, hh = *(const LAS v2u*)(vr + 8); v4u vw; vw.x = lo2.x; vw.y = lo2.y; vw.z = hh.x; vw.w = hh.y;
                o[dt] = __builtin_amdgcn_mfma_f32_32x32x16_bf16(__builtin_bit_cast(bf16x8, vw), pf, o[dt], 0, 0, 0); }
        }
}
__device__ __forceinline__ void stage_kv_from_z(const bf16* zrow, int kvh, int half, bool valid, LAS bf16* Kl, LAS bf16* Vt, int row, const float* gk, float* outk, float* outv) {
    v4u kw[4], vw[4];
#pragma unroll
    for (int i = 0; i < 4; ++i) { kw[i] = v4u{0u, 0u, 0u, 0u}; vw[i] = v4u{0u, 0u, 0u, 0u}; }
    if (valid) {
#pragma unroll
        for (int i = 0; i < 4; ++i) { kw[i] = *(const v4u*)(zrow + 1024 + kvh * 64 + 32 * half + 8 * i); vw[i] = *(const v4u*)(zrow + 1280 + kvh * 64 + 32 * half + 8 * i); }
    }
    float kf[32]; float ss = 0.f;
#pragma unroll
    for (int i = 0; i < 4; ++i) { kf[8 * i + 0] = bflo(kw[i].x); kf[8 * i + 1] = bfhi(kw[i].x); kf[8 * i + 2] = bflo(kw[i].y); kf[8 * i + 3] = bfhi(kw[i].y);
        kf[8 * i + 4] = bflo(kw[i].z); kf[8 * i + 5] = bfhi(kw[i].z); kf[8 * i + 6] = bflo(kw[i].w); kf[8 * i + 7] = bfhi(kw[i].w); }
#pragma unroll
    for (int i = 0; i < 32; ++i) ss += kf[i] * kf[i];
    ss += __shfl_xor(ss, 1);
    const float rk = rsqrtf(ss * (1.f / 64.f) + EPSN);
#pragma unroll
    for (int i = 0; i < 32; ++i) kf[i] = kf[i] * rk * gk[32 * half + i];
#pragma unroll
    for (int i = 0; i < 4; ++i) { v4u w; w.x = pk2(kf[8 * i], kf[8 * i + 1]); w.y = pk2(kf[8 * i + 2], kf[8 * i + 3]); w.z = pk2(kf[8 * i + 4], kf[8 * i + 5]); w.w = pk2(kf[8 * i + 6], kf[8 * i + 7]);
        *(LAS v4u*)(Kl + row * KLS + 32 * half + 8 * i) = w; }
#pragma unroll
    for (int i = 0; i < 4; ++i) { const unsigned ww[4] = {vw[i].x, vw[i].y, vw[i].z, vw[i].w};
#pragma unroll
        for (int q = 0; q < 4; ++q) { Vt[(32 * half + 8 * i + 2 * q) * VTS + row] = (bf16)(ww[q] & 0xffffu); Vt[(32 * half + 8 * i + 2 * q + 1) * VTS + row] = (bf16)(ww[q] >> 16); } }
    if (outk) {
#pragma unroll
        for (int i = 0; i < 8; ++i) ((f32x4*)(outk + 32 * half))[i] = f32x4{kf[4 * i], kf[4 * i + 1], kf[4 * i + 2], kf[4 * i + 3]};
#pragma unroll
        for (int i = 0; i < 4; ++i) { ((f32x4*)(outv + 32 * half))[2 * i] = f32x4{bflo(vw[i].x), bfhi(vw[i].x), bflo(vw[i].y), bfhi(vw[i].y)};
            ((f32x4*)(outv + 32 * half))[2 * i + 1] = f32x4{bflo(vw[i].z), bfhi(vw[i].z), bflo(vw[i].w), bfhi(vw[i].w)}; }
    }
}
__device__ __forceinline__ void load_q_raw(const bf16* zrow, int h, int hi, v4u (&qw)[4]) {
#pragma unroll
    for (int d0 = 0; d0 < 4; ++d0) qw[d0] = *(const v4u*)(zrow + h * 64 + 16 * d0 + 8 * hi);
}
__device__ __forceinline__ void finish_qfrags(const v4u (&qw)[4], const float* gq, bf16x8 (&qf)[4], int hi) {
    float ss = 0.f;
#pragma unroll
    for (int d0 = 0; d0 < 4; ++d0) {
        const float a0 = bflo(qw[d0].x), a1 = bfhi(qw[d0].x), a2 = bflo(qw[d0].y), a3 = bfhi(qw[d0].y), a4 = bflo(qw[d0].z), a5 = bfhi(qw[d0].z), a6 = bflo(qw[d0].w), a7 = bfhi(qw[d0].w);
        ss += (a0 * a0 + a1 * a1) + (a2 * a2 + a3 * a3) + (a4 * a4 + a5 * a5) + (a6 * a6 + a7 * a7); }
    ss += __shfl_xor(ss, 32);
    const float rq = rsqrtf(ss * (1.f / 64.f) + EPSN) * (0.125f * LOG2E);
#pragma unroll
    for (int d0 = 0; d0 < 4; ++d0) { const float* g = gq + 16 * d0 + 8 * hi; v4u w;
        w.x = pk2(bflo(qw[d0].x) * rq * g[0], bfhi(qw[d0].x) * rq * g[1]); w.y = pk2(bflo(qw[d0].y) * rq * g[2], bfhi(qw[d0].y) * rq * g[3]);
        w.z = pk2(bflo(qw[d0].z) * rq * g[4], bfhi(qw[d0].z) * rq * g[5]); w.w = pk2(bflo(qw[d0].w) * rq * g[6], bfhi(qw[d0].w) * rq * g[7]);
        qf[d0] = __builtin_bit_cast(bf16x8, w); }
}
__device__ __forceinline__ void load_qfrags(const bf16* zrow, int h, const float* gq, bf16x8 (&qf)[4], int hi) { v4u qw[4]; load_q_raw(zrow, h, hi, qw); finish_qfrags(qw, gq, qf, hi); }
__device__ __forceinline__ void store_attn_out(bf16* orow  , float* ssrow  , bool active, const f32x16 (&o)[2], float inv, int hi) {
    float ss = 0.f;
#pragma unroll
    for (int dt = 0; dt < 2; ++dt)
#pragma unroll
        for (int r4 = 0; r4 < 4; ++r4) { const float a = o[dt][4 * r4] * inv, b = o[dt][4 * r4 + 1] * inv, c = o[dt][4 * r4 + 2] * inv, d = o[dt][4 * r4 + 3] * inv;
            ss += (a * a + b * b) + (c * c + d * d);
            v2u w; w.x = pk2(a, b); w.y = pk2(c, d);
            if (active) *(v2u*)(orow + 32 * dt + 8 * r4 + 4 * hi) = w; }
    ss += __shfl_xor(ss, 32);
    if (active && hi == 0) unsafeAtomicAdd(ssrow, ss);
}
__device__ __forceinline__ void attn_prompt_unit(const Args& A, LAS unsigned char* lds, int b, int kvh, int qb, int tid, int wave, int lane) {
    LAS bf16* Kl = (LAS bf16*)(lds + LDS_K); LAS bf16* Vt = (LAS bf16*)(lds + LDS_VT);
    const bf16* Z = (const bf16*)(A.ws + WS_Z); bf16* ATT = (bf16*)(A.ws + WS_MIX); float* SSA = (float*)(A.ws + WS_SSA);
    const int r32 = lane & 31, hi = lane >> 5;
    const int h = kvh * 4 + (wave >> 1);
    const int tok0 = b * 2048 + qb * 128 + 64 * (wave & 1) + r32;
    v4u qw0[4], qw1[4];
    load_q_raw(Z + (size_t)tok0 * PW, h, hi, qw0); load_q_raw(Z + (size_t)(tok0 + 32) * PW, h, hi, qw1);
    {
        const int row = tid >> 1, half = tid & 1, tok = (qb - 1) * 128 + row; const bool valid = tok >= 0;
        const bf16* zrow = Z + (size_t)(b * 2048 + (valid ? tok : 0)) * PW;
        float* outk = nullptr; float* outv = nullptr;
        if (qb == 15 && row >= 128) { const size_t o = ((size_t)(b * 128 + row - 128) * 4 + kvh) * 64; outk = A.out + O_KP + o; outv = A.out + O_VP + o; }
        stage_kv_from_z(zrow, kvh, half, valid, Kl, Vt, row, A.in[I_KG], outk, outv);
    }
    __syncthreads();
    const float slope2 = exp2f(-0.5f * (float)(h + 1)) * LOG2E, sink2 = A.in[I_SINK][h] * LOG2E;
#pragma unroll 1
    for (int jj = 0; jj < 2; ++jj) {
        const int jq = 2 * (wave & 1) + jj, tok = tok0 + 32 * jj;
        v4u qs[4];
#pragma unroll
        for (int d0 = 0; d0 < 4; ++d0) qs[d0] = jj ? qw1[d0] : qw0[d0];
        bf16x8 qf[4]; finish_qfrags(qs, A.in[I_QG], qf, hi);
        f32x16 o[2]; float inv;
        if (qb == 0) attn_qtile(Kl, Vt, jq, qf, 32 * jq + r32, slope2, sink2, 128, o, inv, r32, hi);
        else attn_qtile_fast(Kl, Vt, jq, qf, 32 * jq + r32, slope2, sink2, o, inv, r32, hi);
        store_attn_out(ATT + (size_t)tok * DM + h * 64, SSA + tok, true, o, inv, hi);
    }
    __syncthreads();
}
__device__ __forceinline__ void attn_sample_unit(const Args& A, LAS unsigned char* lds, int n, int kvh, int tid, int wave, int lane) {
    LAS bf16* Kl = (LAS bf16*)(lds + LDS_K); LAS bf16* Vt = (LAS bf16*)(lds + LDS_VT);
    const bf16* Z = (const bf16*)(A.ws + WS_Z); bf16* ATT = (bf16*)(A.ws + WS_MIX); float* SSA = (float*)(A.ws + WS_SSA);
    const int r32 = lane & 31, hi = lane >> 5;
    {
        const int row = tid >> 2, qt = tid & 3; const size_t src = ((size_t)(n * 128 + row) * 4 + kvh) * 64 + 16 * qt;
        f32x4 kv[4], vv[4];
#pragma unroll
        for (int i = 0; i < 4; ++i) { kv[i] = ((const f32x4*)(A.in[I_CK] + src))[i]; vv[i] = ((const f32x4*)(A.in[I_CV] + src))[i]; }
#pragma unroll
        for (int i = 0; i < 2; ++i) { v4u w; w.x = pk2(kv[2 * i].x, kv[2 * i].y); w.y = pk2(kv[2 * i].z, kv[2 * i].w); w.z = pk2(kv[2 * i + 1].x, kv[2 * i + 1].y); w.w = pk2(kv[2 * i + 1].z, kv[2 * i + 1].w);
            *(LAS v4u*)(Kl + row * KLS + 16 * qt + 8 * i) = w; }
#pragma unroll
        for (int i = 0; i < 4; ++i) { Vt[(16 * qt + 4 * i + 0) * VTS + row] = (bf16)f2bf(vv[i].x); Vt[(16 * qt + 4 * i + 1) * VTS + row] = (bf16)f2bf(vv[i].y);
            Vt[(16 * qt + 4 * i + 2) * VTS + row] = (bf16)f2bf(vv[i].z); Vt[(16 * qt + 4 * i + 3) * VTS + row] = (bf16)f2bf(vv[i].w); }
        if (row >= 4) { const size_t dst = ((size_t)(n * 128 + row - 4) * 4 + kvh) * 64 + 16 * qt;
#pragma unroll
            for (int i = 0; i < 4; ++i) { ((f32x4*)(A.out + O_KS + dst))[i] = kv[i]; ((f32x4*)(A.out + O_VS + dst))[i] = vv[i]; } }
        for (int idx = tid; idx < 28 * 64; idx += NTHR) { const int r = 132 + (idx >> 6), c = idx & 63; Kl[r * KLS + c] = 0; Vt[c * VTS + r] = 0; }
        if (tid < 8) {
            const int t = tid >> 1, half = tid & 1; const size_t o = ((size_t)(n * 128 + 124 + t) * 4 + kvh) * 64;
            stage_kv_from_z(Z + (size_t)(MP + 4 * n + t) * PW, kvh, half, true, Kl, Vt, 128 + t, A.in[I_KG], A.out + O_KS + o, A.out + O_VS + o);
        }
    }
    __syncthreads();
    if (wave == 0) {
        const int t = r32 & 3, rr = (r32 >> 2) & 3, h = kvh * 4 + rr, tok = MP + 4 * n + t;
        const float slope2 = exp2f(-0.5f * (float)(h + 1)) * LOG2E, sink2 = A.in[I_SINK][h] * LOG2E;
        bf16x8 qf[4]; load_qfrags(Z + (size_t)tok * PW, h, A.in[I_QG], qf, hi);
        f32x16 o[2]; float inv;
        attn_qtile_fast(Kl, Vt, 0, qf, t, slope2, sink2, o, inv, r32, hi);
        store_attn_out(ATT + (size_t)tok * DM + h * 64, SSA + tok, r32 < 16, o, inv, hi);
    }
    __syncthreads();
}

constexpr int US = 264, ES = 132;
constexpr int LDS_U = 0, LDS_E = 128 * US * 2, LDS_TF = LDS_E + 128 * ES * 4, LDS_SSM_END = LDS_TF + 17 * 1024;
__device__ __forceinline__ void ssm_prompt_unit(const Args& A, LAS unsigned char* lds, int b, int g, int tid, int wave, int lane) {
    LAS bf16* U = (LAS bf16*)(lds + LDS_U); LAS float* E = (LAS float*)(lds + LDS_E); LAS unsigned char* TFl = lds + LDS_TF;
    const int r32 = lane & 31, hi = lane >> 5, w4 = wave & 3, ctp = wave >> 2;
    const bf16* Zu = (const bf16*)(A.ws + WS_Z) + (size_t)(b * 2048) * PW + 1536 + 16 * g;
    {
        v4u uv[8], tv[3];
#pragma unroll
        for (int i = 0; i < 8; ++i) { const int q = tid + 512 * i, t = q >> 1, h = q & 1; uv[i] = *(const v4u*)(Zu + (size_t)t * PW + 8 * h); }
        const v4u* tfg = (const v4u*)(A.ws + WS_TF) + (size_t)g * 17 * 64;
#pragma unroll
        for (int i = 0; i < 3; ++i) { const int q = tid + 512 * i; tv[i] = q < 17 * 64 ? tfg[q] : v4u{0u, 0u, 0u, 0u}; }
#pragma unroll
        for (int i = 0; i < 8; ++i) { const int q = tid + 512 * i, t = q >> 1, h = q & 1; *(LAS v4u*)(U + (t >> 4) * US + (t & 15) * 16 + 8 * h) = uv[i]; }
#pragma unroll
        for (int i = 0; i < 3; ++i) { const int q = tid + 512 * i; if (q < 17 * 64) *(LAS v4u*)(TFl + q * 16) = tv[i]; }
    }
    bf16x8 wf[16];
    {   const bf16x8* wsf = (const bf16x8*)(A.ws + WS_WSF) + (size_t)((g * 4 + w4) * 16) * 64 + lane;
#pragma unroll
        for (int s = 0; s < 16; ++s) wf[s] = wsf[s * 64]; }
    __syncthreads();
    const LAS bf16* u0p = U + (32 * (2 * ctp) + r32) * US + 8 * hi; const LAS bf16* u1p = U + (32 * (2 * ctp + 1) + r32) * US + 8 * hi;
    {
        f32x16 e0 = f32x16{}, e1 = f32x16{};
#pragma unroll
        for (int s = 0; s < 16; ++s) { const bf16x8 u0 = *(const LAS bf16x8*)(u0p + s * 16), u1 = *(const LAS bf16x8*)(u1p + s * 16);
            e0 = __builtin_amdgcn_mfma_f32_32x32x16_bf16(wf[s], u0, e0, 0, 0, 0); e1 = __builtin_amdgcn_mfma_f32_32x32x16_bf16(wf[s], u1, e1, 0, 0, 0); }
#pragma unroll
        for (int r = 0; r < 16; ++r) { const int m = 32 * w4 + crow(r, hi); E[(32 * (2 * ctp) + r32) * ES + m] = e0[r]; E[(32 * (2 * ctp + 1) + r32) * ES + m] = e1[r]; }
    }
    const int ttA = w4, ttB = 7 - w4;
    asm volatile("" ::: "memory");
    bf16x8 whA[8], whB[8];
    {   const bf16x8* pa = (const bf16x8*)(A.ws + WS_WHF) + (size_t)((g * 8 + ttA) * 8) * 64 + lane; const bf16x8* pb = (const bf16x8*)(A.ws + WS_WHF) + (size_t)((g * 8 + ttB) * 8) * 64 + lane;
#pragma unroll
        for (int kb = 0; kb < 8; ++kb) { whA[kb] = pa[kb * 64]; whB[kb] = pb[kb * 64]; } }
    __syncthreads();
    if (wave == 0) {
        const float2 l16 = ((const float2*)(A.ws + WS_LAM16))[g * 64 + lane];
        float hr = 0.f, hm = 0.f;
#pragma unroll 8
        for (int c = 0; c < 128; ++c) { const float er = E[c * ES + lane], ei = E[c * ES + 64 + lane];
            E[c * ES + lane] = __uint_as_float(pk2(hr, hm));
            const float nr = l16.x * hr - l16.y * hm + er, ni = l16.x * hm + l16.y * hr + ei; hr = nr; hm = ni; }
        A.out[O_RP + (size_t)(b * 64 + g) * 64 + lane] = hr; A.out[O_IP + (size_t)(b * 64 + g) * 64 + lane] = hm;
    }
    __syncthreads();
    {
        f32x16 aA0 = f32x16{}, aA1 = f32x16{}, aB0 = f32x16{}, aB1 = f32x16{};
        const LAS unsigned char* tfl = TFl + lane * 16;
#pragma unroll 4
        for (int s = 0; s < 16; ++s) {
            if (s <= 2 * ttB + 1) {
                const bf16x8 u0 = *(const LAS bf16x8*)(u0p + s * 16), u1 = *(const LAS bf16x8*)(u1p + s * 16);
                const bf16x8 tB = *(const LAS bf16x8*)(tfl + (2 * ttB - s + 1) * 1024);
                aB0 = __builtin_amdgcn_mfma_f32_32x32x16_bf16(tB, u0, aB0, 0, 0, 0); aB1 = __builtin_amdgcn_mfma_f32_32x32x16_bf16(tB, u1, aB1, 0, 0, 0);
                if (s <= 2 * ttA + 1) { const bf16x8 tA = *(const LAS bf16x8*)(tfl + (2 * ttA - s + 1) * 1024);
                    aA0 = __builtin_amdgcn_mfma_f32_32x32x16_bf16(tA, u0, aA0, 0, 0, 0); aA1 = __builtin_amdgcn_mfma_f32_32x32x16_bf16(tA, u1, aA1, 0, 0, 0); }
            }
        }
        const LAS bf16* h0p = (const LAS bf16*)(E + (32 * (2 * ctp) + r32) * ES) + 8 * hi; const LAS bf16* h1p = (const LAS bf16*)(E + (32 * (2 * ctp + 1) + r32) * ES) + 8 * hi;
#pragma unroll
        for (int kb = 0; kb < 8; ++kb) {
            const bf16x8 h0 = *(const LAS bf16x8*)(h0p + 16 * kb), h1 = *(const LAS bf16x8*)(h1p + 16 * kb);
            aA0 = __builtin_amdgcn_mfma_f32_32x32x16_bf16(whA[kb], h0, aA0, 0, 0, 0); aA1 = __builtin_amdgcn_mfma_f32_32x32x16_bf16(whA[kb], h1, aA1, 0, 0, 0);
            aB0 = __builtin_amdgcn_mfma_f32_32x32x16_bf16(whB[kb], h0, aB0, 0, 0, 0); aB1 = __builtin_amdgcn_mfma_f32_32x32x16_bf16(whB[kb], h1, aB1, 0, 0, 0);
        }
        bf16* Gm = (bf16*)(A.ws + WS_G);
        const float* Dk = A.in[I_D] + 16 * g;
#define SSM_EPI(acc, tt, ct) do { _Pragma("unroll") for (int r4 = 0; r4 < 4; ++r4) { const int ti = r4 >> 1, ch0 = 8 * (r4 & 1) + 4 * hi, cc = 32 * (ct) + r32, tok = 16 * cc + 2 * (tt) + ti; \
            const v2u uw = *(const LAS v2u*)(U + cc * US + (2 * (tt) + ti) * 16 + ch0); const f32x4 dv = *(const f32x4*)(Dk + ch0); \
            const float y0 = acc[4 * r4 + 0] + dv.x * bflo(uw.x), y1 = acc[4 * r4 + 1] + dv.y * bfhi(uw.x), y2 = acc[4 * r4 + 2] + dv.z * bflo(uw.y), y3 = acc[4 * r4 + 3] + dv.w * bfhi(uw.y); \
            v2u w; w.x = pk2(gelu_tanh(y0), gelu_tanh(y1)); w.y = pk2(gelu_tanh(y2), gelu_tanh(y3)); \
            *(v2u*)(Gm + (size_t)(b * 2048 + tok) * SWD + 16 * g + ch0) = w; } } while (0)
        SSM_EPI(aA0, ttA, 2 * ctp); SSM_EPI(aA1, ttA, 2 * ctp + 1); SSM_EPI(aB0, ttB, 2 * ctp); SSM_EPI(aB1, ttB, 2 * ctp + 1);
#undef SSM_EPI
    }
    __syncthreads();
}
__device__ __forceinline__ void ssm_sample_wave(const Args& A, LAS unsigned char* lds, int gw  , int ngw, int wave, int lane) {
    LAS float* Cr = (LAS float*)(lds + wave * 8192); LAS float* Ci = Cr + 1024; LAS float* hs = (LAS float*)(lds + 65536 + wave * 2048);
    const bf16* Z = (const bf16*)(A.ws + WS_Z);
    const int tl = lane >> 4, cl = lane & 15;
    for (int g = gw & 63; g < 64; g += 64) {
        {   const f32x4* cre = (const f32x4*)(A.in[I_CRE] + (size_t)g * 1024); const f32x4* cim = (const f32x4*)(A.in[I_CIM] + (size_t)g * 1024);
#pragma unroll
            for (int i = 0; i < 4; ++i) { const int q4 = lane + 64 * i, chp = q4 >> 4, p0 = (q4 & 15) * 4; const f32x4 a = cre[q4], c = cim[q4];
                Cr[(p0 + 0) * 16 + chp] = a.x; Cr[(p0 + 1) * 16 + chp] = a.y; Cr[(p0 + 2) * 16 + chp] = a.z; Cr[(p0 + 3) * 16 + chp] = a.w;
                Ci[(p0 + 0) * 16 + chp] = c.x; Ci[(p0 + 1) * 16 + chp] = c.y; Ci[(p0 + 2) * 16 + chp] = c.z; Ci[(p0 + 3) * 16 + chp] = c.w; } }
        const float2 lam = ((const float2*)(A.ws + WS_LAM))[g * 64 + lane];
        float2 bb[16];
#pragma unroll
        for (int ch = 0; ch < 16; ++ch) bb[ch] = ((const float2*)(A.ws + WS_BBAR))[(g * 16 + ch) * 64 + lane];
        const float dsk = A.in[I_D][16 * g + cl];
        for (int n = gw >> 6; n < 128; n += ngw >> 6) {
            float hr = A.in[I_SR][(size_t)(n * 64 + g) * 64 + lane], hm = A.in[I_SI][(size_t)(n * 64 + g) * 64 + lane];
            const unsigned short ub = Z[(size_t)(MP + 4 * n + tl) * PW + 1536 + 16 * g + cl];
            const float uval = __uint_as_float((unsigned)ub << 16);
#pragma unroll
            for (int t = 0; t < 4; ++t) {
                float br = 0.f, bi = 0.f;
#pragma unroll
                for (int ch = 0; ch < 16; ++ch) { const float u = __shfl(uval, t * 16 + ch); br += bb[ch].x * u; bi += bb[ch].y * u; }
                const float nr = lam.x * hr - lam.y * hm + br, ni = lam.x * hm + lam.y * hr + bi; hr = nr; hm = ni;
                hs[(t * 2 + 0) * 64 + lane] = hr; hs[(t * 2 + 1) * 64 + lane] = hm;
            }
            A.out[O_RS + (size_t)(n * 64 + g) * 64 + lane] = hr; A.out[O_IS + (size_t)(n * 64 + g) * 64 + lane] = hm;
            float y = 0.f;
#pragma unroll 4
            for (int p = 0; p < 64; p += 4) { const f32x4 h4 = *(const LAS f32x4*)(hs + (tl * 2 + 0) * 64 + p), g4 = *(const LAS f32x4*)(hs + (tl * 2 + 1) * 64 + p);
                y += (Cr[(p + 0) * 16 + cl] * h4.x - Ci[(p + 0) * 16 + cl] * g4.x) + (Cr[(p + 1) * 16 + cl] * h4.y - Ci[(p + 1) * 16 + cl] * g4.y)
                   + (Cr[(p + 2) * 16 + cl] * h4.z - Ci[(p + 2) * 16 + cl] * g4.z) + (Cr[(p + 3) * 16 + cl] * h4.w - Ci[(p + 3) * 16 + cl] * g4.w); }
            y += dsk * uval;
            ((bf16*)(A.ws + WS_G))[(size_t)(MP + 4 * n + tl) * SWD + 16 * g + cl] = (bf16)f2bf(gelu_tanh(y));
        }
    }
}

__device__ __forceinline__ void convert_two(const float* W1, int K1, int N1, bf16* T1, const float* W2, int K2, int N2, bf16* T2, LAS unsigned char* lds, int w, int nw, int wave, int lane, const float* g0 = nullptr, const float* g1 = nullptr) {
    LAS float* scr = (LAS float*)(lds + wave * 8448);
    const int i1 = (K1 / 64) * (N1 / 32), i2 = (K2 / 64) * (N2 / 32);
    for (int it = w * NWAVES + wave; it < i1 + i2; it += nw * NWAVES) {
        if (it < i1) p0_transpose_item(W1, K1, N1, T1, scr, it, lane); else p0_transpose_item(W2, K2, N2, T2, scr, it - i1, lane, g0, g1);
    }
}
#define XB_TMO      128
#define XB_XCNT(j)  (256  + 64 * (j))
#define XB_XSUB(j)  (1280 + 64 * (j))
#define XB_XGEN(j)  (2304 + 64 * (j))
#define XB_TOP      3328
#define XB_TOPGEN   3392
#define XCD_BAR_WORDS 3456
#define XB_SPIN_CAP (1u << 18)

__device__ __forceinline__ unsigned xb_ld(unsigned* p)              { return __hip_atomic_load(p, __ATOMIC_RELAXED, __HIP_MEMORY_SCOPE_AGENT); }
__device__ __forceinline__ unsigned xb_add(unsigned* p, unsigned v) { return __hip_atomic_fetch_add(p, v, __ATOMIC_RELAXED, __HIP_MEMORY_SCOPE_AGENT); }
__device__ __forceinline__ unsigned xb_xcc_id() { return (unsigned)__builtin_amdgcn_s_getreg((3 << 11) | 20) & 0xFu; }
#define XB_SPIN(cond, bar) do { unsigned _sp = 0; while (cond) { __builtin_amdgcn_s_sleep(1); \
    if ((++_sp & 255u) == 0u) { if (xb_ld(&(bar)[XB_TMO])) break; if (_sp > XB_SPIN_CAP) { atomicAdd(&(bar)[XB_TMO], 1u); break; } } } } while (0)

struct XcdBarrier {
    unsigned* bar; unsigned x;
    volatile LAS unsigned* st;
};

__device__ __forceinline__ XcdBarrier xcd_barrier_post(unsigned* bar, volatile LAS unsigned* st) {
    XcdBarrier b; b.bar = bar; b.x = xb_xcc_id(); b.st = st;
    if (threadIdx.x == 0) (void)xb_add(&bar[XB_XCNT(b.x)], 1u);
    return b;
}
__device__ __forceinline__ void xcd_barrier_complete(unsigned* bar, unsigned x, unsigned& nloc, unsigned& nx) {
    const unsigned G = gridDim.x * gridDim.y * gridDim.z;
    unsigned sum, cnt, mine, sp = 0u;
    for (;;) {
        sum = 0u; cnt = 0u; mine = 0u;
#pragma unroll
        for (unsigned j = 0; j < 16; ++j) { const unsigned c = xb_ld(&bar[XB_XCNT(j)]); sum += c; cnt += (c > 0u) ? 1u : 0u; mine = (j == x) ? c : mine; }
        if (sum == G) break;
        __builtin_amdgcn_s_sleep(1);
        if ((++sp & 255u) == 0u) { if (xb_ld(&bar[XB_TMO])) break; if (sp > XB_SPIN_CAP) { atomicAdd(&bar[XB_TMO], 1u); break; } }
    }
    nloc = mine > 0u ? mine : 1u; nx = cnt > 0u ? cnt : 1u;
}

__device__ __forceinline__ void xcd_barrier(const XcdBarrier& b) {
    asm volatile("s_waitcnt vmcnt(0)" ::: "memory");
    __syncthreads();
    if (threadIdx.x == 0) {
        unsigned* bar = b.bar;
        __builtin_amdgcn_s_waitcnt(0);
        unsigned nloc = b.st[0], nx = b.st[1];
        if (nloc == 0u) { xcd_barrier_complete(bar, b.x, nloc, nx); b.st[0] = nloc; b.st[1] = nx; }
        const unsigned old = xb_add(&bar[XB_XSUB(b.x)], 1u);
        const unsigned gen = old / nloc;
        if (old + 1u == (gen + 1u) * nloc) {
            __builtin_amdgcn_fence(__ATOMIC_RELEASE, "agent");
            asm volatile("s_waitcnt vmcnt(0)" ::: "memory");
            const unsigned og = xb_add(&bar[XB_TOP], 1u);
            const unsigned tg = og / nx;
            if (og + 1u == (tg + 1u) * nx) xb_add(&bar[XB_TOPGEN], 1u);
            else XB_SPIN(xb_ld(&bar[XB_TOPGEN]) == tg, bar);
            __builtin_amdgcn_fence(__ATOMIC_ACQUIRE, "agent");
            xb_add(&bar[XB_XGEN(b.x)], 1u);
            asm volatile("s_waitcnt vmcnt(0)" ::: "memory");
        } else {
            XB_SPIN(xb_ld(&bar[XB_XGEN(b.x)]) == gen, bar);
            __builtin_amdgcn_fence(__ATOMIC_ACQUIRE, "agent");
            asm volatile("s_waitcnt vmcnt(0)" ::: "memory");
        }
    }
    __syncthreads();
}

template <int LO, int HI> __device__ __forceinline__ void fwd_body(const Args& A) {
    extern __shared__ __attribute__((aligned(16))) unsigned char lds_raw[];
    LAS unsigned char* lds = (LAS unsigned char*)lds_raw;
    const int tid = threadIdx.x, lane = tid & 63, wave = __builtin_amdgcn_readfirstlane(tid >> 6);
    const int G = gridDim.x, bx = blockIdx.x, vcu = (G % 8 == 0) ? (bx % 8) * (G / 8) + bx / 8 : bx;
    unsigned char* ws = A.ws;
#define IN(k) (LO <= (k) && (k) < HI)
    volatile LAS unsigned* bst = (volatile LAS unsigned*)(lds + LDS_PHASE);
    if (tid == 0) { bst[0] = 0u; bst[1] = 0u; }
    __syncthreads();
    XcdBarrier bar; bar.bar = (unsigned*)(ws + WS_BAR); bar.x = 0; bar.st = bst;
    if (HI - LO > 1) bar = xcd_barrier_post((unsigned*)(ws + WS_BAR), bst);
#define SEAM(k) do { if (IN(k) && IN((k) + 1)) { xcd_barrier(bar); } } while (0)
    if (HI - LO > 1) cg::this_grid().sync();
    using namespace pg8;
#ifdef PROBE_P0
    if (IN(0)) { const int nrep = A.ph_hi > 100 ? 1 : 2; for (int rep = 0; rep < nrep; ++rep) { p0_prologue(A, lds, vcu, G, tid, wave, lane); __syncthreads(); if (rep + 1 < nrep) xcd_barrier(bar); } }
#else
    if (IN(0)) { p0_prologue(A, lds, vcu, G, tid, wave, lane); __syncthreads(); }
#endif
    SEAM(0);
    if (IN(1)) { Gemm g{(const bf16_t*)(ws + WS_XN), (const bf16_t*)(ws + WS_WIN), MT, PW, DM}; StaticOrder S; S.init(MT, PW, G, bx, DM);
        EpiStoreBf16<0> E{(bf16_t*)(ws + WS_Z), PW};
        gemm_phase<EpiStoreBf16<0>, StaticOrder, true, true>(lds, g, S, E);
        { const int nfull = (MT / 256) * (PW / 256) - 2 * G;
          if (G == 256 && bx >= nfull) convert_two(A.in[I_WGLU], SWD, SWD, (bf16*)(ws + WS_WGLU), A.in[I_WOUT], DM, DM, (bf16*)(ws + WS_WOUT), lds, bx - nfull, G - nfull, wave, lane, A.in[I_AOG], A.in[I_SOG]);
          else if (G != 256) convert_two(A.in[I_WGLU], SWD, SWD, (bf16*)(ws + WS_WGLU), A.in[I_WOUT], DM, DM, (bf16*)(ws + WS_WOUT), lds, bx, G, wave, lane, A.in[I_AOG], A.in[I_SOG]); } }
    SEAM(1);
    if (IN(2)) {
#ifdef PROBE_P2
      const int nrep2 = A.ph_hi > 100 ? 1 : 2;
      for (int rep = 0; rep < nrep2; ++rep) {
        if (rep) xcd_barrier(bar);
#else
      {
#endif
#ifndef SKIP_AP
        for (int u = vcu; u < 512; u += G) { int t_ = threadIdx.x; asm volatile("" : "+v"(t_)); const int l_ = t_ & 63, w_ = __builtin_amdgcn_readfirstlane(t_ >> 6); attn_prompt_unit(A, lds, u >> 6, (u >> 4) & 3, u & 15, t_, w_, l_); }
#endif
#ifdef DUP_AP
        __syncthreads();
        for (int u = vcu; u < 512; u += G) { int t_ = threadIdx.x; asm volatile("" : "+v"(t_)); const int l_ = t_ & 63, w_ = __builtin_amdgcn_readfirstlane(t_ >> 6); attn_prompt_unit(A, lds, u >> 6, (u >> 4) & 3, u & 15, t_, w_, l_); }
#endif
#ifndef SKIP_SP
        for (int u = vcu; u < 512; u += G) { int t_ = threadIdx.x; asm volatile("" : "+v"(t_)); const int l_ = t_ & 63, w_ = __builtin_amdgcn_readfirstlane(t_ >> 6); ssm_prompt_unit(A, lds, u >> 6, u & 63, t_, w_, l_); }
#endif
#ifdef DUP_SP
        __syncthreads();
        for (int u = vcu; u < 512; u += G) { int t_ = threadIdx.x; asm volatile("" : "+v"(t_)); const int l_ = t_ & 63, w_ = __builtin_amdgcn_readfirstlane(t_ >> 6); ssm_prompt_unit(A, lds, u >> 6, u & 63, t_, w_, l_); }
#endif
#ifndef SKIP_AS
        for (int u = vcu; u < 512; u += G) { int t_ = threadIdx.x; asm volatile("" : "+v"(t_)); const int l_ = t_ & 63, w_ = __builtin_amdgcn_readfirstlane(t_ >> 6); attn_sample_unit(A, lds, u >> 2, u & 3, t_, w_, l_); }
#endif
#ifdef DUP_AS
        __syncthreads();
        for (int u = vcu; u < 512; u += G) { int t_ = threadIdx.x; asm volatile("" : "+v"(t_)); const int l_ = t_ & 63, w_ = __builtin_amdgcn_readfirstlane(t_ >> 6); attn_sample_unit(A, lds, u >> 2, u & 3, t_, w_, l_); }
#endif
#ifndef SKIP_SS
        { int t_ = threadIdx.x; asm volatile("" : "+v"(t_)); const int l_ = t_ & 63, w_ = __builtin_amdgcn_readfirstlane(t_ >> 6);
          if ((G * NWAVES) % 64 == 0) ssm_sample_wave(A, lds, vcu * NWAVES + w_, G * NWAVES, w_, l_); }
#endif
#ifdef DUP_SS
        __syncthreads();
        { int t_ = threadIdx.x; asm volatile("" : "+v"(t_)); const int l_ = t_ & 63, w_ = __builtin_amdgcn_readfirstlane(t_ >> 6);
          if ((G * NWAVES) % 64 == 0) ssm_sample_wave(A, lds, vcu * NWAVES + w_, G * NWAVES, w_, l_); }
#endif
        __syncthreads();
      }
    }
    SEAM(2);
    if (IN(3)) { Gemm g{(const bf16_t*)(ws + WS_G), (const bf16_t*)(ws + WS_WGLU), MT, SWD, SWD}; StaticOrder S; S.init(MT, SWD, G, bx, SWD);
        EpiGlu E{(const bf16_t*)(ws + WS_G), (bf16_t*)(ws + WS_MIX), A.in[I_BGLU], (float*)(ws + WS_SSS)};
        gemm_phase<EpiGlu, StaticOrder, true, true>(lds, g, S, E); }
    SEAM(3);
    if (IN(5)) { Gemm g{(const bf16_t*)(ws + WS_MIX), (const bf16_t*)(ws + WS_WOUT), MT, DM, DM}; StaticOrder S; S.init(MT, DM, G, bx, DM);
        EpiHres E{(const bf16_t*)(ws + WS_XN), (const float*)(ws + WS_XR), A.in[I_ANG], (bf16_t*)(ws + WS_HG), A.in[I_MNG], (float*)(ws + WS_CTL), (const float*)(ws + WS_SSA), (const float*)(ws + WS_SSS)};
        gemm_phase<EpiHres, StaticOrder, true, true>(lds, g, S, E);
        { const int nfull = (MT / 256) * (DM / 256) - 2 * G;
          if (G == 256 && bx >= nfull) convert_two(A.in[I_WUP], DM, FF, (bf16*)(ws + WS_WUP), A.in[I_WDN], FF, DM, (bf16*)(ws + WS_WDN), lds, bx - nfull, G - nfull, wave, lane);
          else if (G != 256) convert_two(A.in[I_WUP], DM, FF, (bf16*)(ws + WS_WUP), A.in[I_WDN], FF, DM, (bf16*)(ws + WS_WDN), lds, bx, G, wave, lane); } }
    SEAM(5);
    if (IN(6)) { Gemm g{(const bf16_t*)(ws + WS_HG), (const bf16_t*)(ws + WS_WUP), MT, FF, DM}; StaticOrder S; S.init(MT, FF, G, bx, DM);
        EpiStoreBf16<2> E{(bf16_t*)(ws + WS_ACT), FF};
        gemm_phase<EpiStoreBf16<2>, StaticOrder, true, true>(lds, g, S, E); }
    SEAM(6);
    if (IN(7)) { Gemm g{(const bf16_t*)(ws + WS_ACT), (const bf16_t*)(ws + WS_WDN), MT, DM, FF};
        { StaticOrder S; S.init(MP, DM, G, bx, FF); EpiDown E{A.out + O_Y, (const float*)(ws + WS_CTL), (const bf16_t*)(ws + WS_HG), A.in[I_MNG]};
          gemm_phase<EpiDown, StaticOrder, true, true>(lds, g, S, E); }
        { SampleSplitOrder<8, 16, 128> S; S.init(G, bx); EpiPartial E{(float*)(ws + WS_PART), 512};
          gemm_phase<EpiPartial, SampleSplitOrder<8, 16, 128>, true, true>(lds, g, S, E); } }
    SEAM(7);
    if (IN(8)) {
        const float* P = (const float*)(ws + WS_PART); const float* rowss = (const float*)(ws + WS_CTL); float* Y = A.out + O_Y + (size_t)MP * DM;
        const bf16* HGs = (const bf16*)(ws + WS_HG) + (size_t)MP * DM;
        for (int idx = vcu * NTHR + tid; idx < 512 * 512; idx += G * NTHR) {
            const int row = idx >> 9, c4 = idx & 511;
            f32x4 s = f32x4{0.f, 0.f, 0.f, 0.f};
#pragma unroll
            for (int k = 0; k < 16; ++k) s += ((const f32x4*)(P + (size_t)k * (512 * 2048)))[idx];
            const float ssr = __hip_atomic_load(rowss + MP + row, __ATOMIC_RELAXED, __HIP_MEMORY_SCOPE_AGENT);
            const float r2 = 1.0f / (ssr * (1.0f / 2048.0f) + 1e-6f);
            const v2u hw = *(const v2u*)(HGs + (size_t)row * DM + 4 * c4); const f32x4 gv = *(const f32x4*)(A.in[I_MNG] + 4 * c4);
            const f32x4 h = f32x4{bflo(hw.x) / gv.x, bfhi(hw.x) / gv.y, bflo(hw.y) / gv.z, bfhi(hw.y) / gv.w};
            ((f32x4*)(Y + (size_t)row * DM))[c4] = h + s * r2;
        }
    }
#undef IN
#undef SEAM
}
template <int LO, int HI> __global__ void __launch_bounds__(NTHR, 2) fwd_t(Args A) { fwd_body<LO, HI>(A); }

extern "C" void kernel_launch(void* const* d_in, const int* in_sizes, int n_in, void* d_out, int out_size, void* d_ws, size_t ws_size, hipStream_t stream) {
    static int grid = 0;
    if (grid == 0) {
        if (n_in != 27 || out_size != (int)O_END || ws_size < WS_END) { fprintf(stderr, "kernel_launch: unexpected shapes: n_in %d out %d ws %zu (need %zu)\n", n_in, out_size, ws_size, (size_t)WS_END); grid = -1; return; }
        int dev = 0, cus = 0, per_cu = 0;
        if (hipGetDevice(&dev) != hipSuccess || hipDeviceGetAttribute(&cus, hipDeviceAttributeMultiprocessorCount, dev) != hipSuccess) { grid = -1; return; }
#if MK_PER_PHASE
        const void* fns[NPHASE] = {(const void*)fwd_t<0, 1>, (const void*)fwd_t<1, 2>, (const void*)fwd_t<2, 3>, (const void*)fwd_t<3, 4>, (const void*)fwd_t<4, 5>, (const void*)fwd_t<5, 6>, (const void*)fwd_t<6, 7>, (const void*)fwd_t<7, 8>, (const void*)fwd_t<8, 9>};
        for (int i = 0; i < NPHASE; ++i) if (hipFuncSetAttribute(fns[i], hipFuncAttributeMaxDynamicSharedMemorySize, LDS_BYTES) != hipSuccess) { fprintf(stderr, "kernel_launch: hipFuncSetAttribute failed\n"); grid = -1; return; }
#else
        if (hipFuncSetAttribute((const void*)fwd_t<0, NPHASE>, hipFuncAttributeMaxDynamicSharedMemorySize, LDS_BYTES) != hipSuccess) { fprintf(stderr, "kernel_launch: hipFuncSetAttribute failed\n"); grid = -1; return; }
        if (hipOccupancyMaxActiveBlocksPerMultiprocessor(&per_cu, (const void*)fwd_t<0, NPHASE>, NTHR, LDS_BYTES) != hipSuccess || per_cu < 1) { fprintf(stderr, "kernel_launch: occupancy query says %d\n", per_cu); per_cu = 1; }
#endif
        (void)hipGetLastError();
        grid = cus;
    }
    if (grid < 0) return;
    (void)hipMemsetAsync((char*)d_ws + WS_CTL, 0, CTL_ZERO_BYTES, stream);
    Args a{};
    for (int i = 0; i < 27; ++i) a.in[i] = (const float*)d_in[i];
    a.out = (float*)d_out; a.ws = (unsigned char*)d_ws;
#if MK_PER_PHASE
    hipLaunchKernelGGL((fwd_t<0, 1>), dim3(grid), dim3(NTHR), LDS_BYTES, stream, a);
#if defined(DUP_PHASE)
    if (DUP_PHASE == 0) hipLaunchKernelGGL((fwd_t<0, 1>), dim3(grid), dim3(NTHR), LDS_BYTES, stream, a);
#endif
    hipLaunchKernelGGL((fwd_t<1, 2>), dim3(grid), dim3(NTHR), LDS_BYTES, stream, a);
#if defined(DUP_PHASE)
    if (DUP_PHASE == 1) hipLaunchKernelGGL((fwd_t<1, 2>), dim3(grid), dim3(NTHR), LDS_BYTES, stream, a);
#endif
    hipLaunchKernelGGL((fwd_t<2, 3>), dim3(grid), dim3(NTHR), LDS_BYTES, stream, a);
#if defined(DUP_PHASE)
    if (DUP_PHASE == 2) hipLaunchKernelGGL((fwd_t<2, 3>), dim3(grid), dim3(NTHR), LDS_BYTES, stream, a);
#endif
    hipLaunchKernelGGL((fwd_t<3, 4>), dim3(grid), dim3(NTHR), LDS_BYTES, stream, a);
#if defined(DUP_PHASE)
    if (DUP_PHASE == 3) hipLaunchKernelGGL((fwd_t<3, 4>), dim3(grid), dim3(NTHR), LDS_BYTES, stream, a);
#endif
    hipLaunchKernelGGL((fwd_t<4, 5>), dim3(grid), dim3(NTHR), LDS_BYTES, stream, a);
#if defined(DUP_PHASE)
    if (DUP_PHASE == 4) hipLaunchKernelGGL((fwd_t<4, 5>), dim3(grid), dim3(NTHR), LDS_BYTES, stream, a);
#endif
    hipLaunchKernelGGL((fwd_t<5, 6>), dim3(grid), dim3(NTHR), LDS_BYTES, stream, a);
#if defined(DUP_PHASE)
    if (DUP_PHASE == 5) hipLaunchKernelGGL((fwd_t<5, 6>), dim3(grid), dim3(NTHR), LDS_BYTES, stream, a);
#endif
    hipLaunchKernelGGL((fwd_t<6, 7>), dim3(grid), dim3(NTHR), LDS_BYTES, stream, a);
#if defined(DUP_PHASE)
    if (DUP_PHASE == 6) hipLaunchKernelGGL((fwd_t<6, 7>), dim3(grid), dim3(NTHR), LDS_BYTES, stream, a);
#endif
    hipLaunchKernelGGL((fwd_t<7, 8>), dim3(grid), dim3(NTHR), LDS_BYTES, stream, a);
#if defined(DUP_PHASE)
    if (DUP_PHASE == 7) hipLaunchKernelGGL((fwd_t<7, 8>), dim3(grid), dim3(NTHR), LDS_BYTES, stream, a);
#endif
    hipLaunchKernelGGL((fwd_t<8, 9>), dim3(grid), dim3(NTHR), LDS_BYTES, stream, a);
#if defined(DUP_PHASE)
    if (DUP_PHASE == 8) hipLaunchKernelGGL((fwd_t<8, 9>), dim3(grid), dim3(NTHR), LDS_BYTES, stream, a);
#endif
#else
    a.ph_lo = 0; a.ph_hi = NPHASE;
    void* kargs[] = {&a};
    hipError_t e = hipLaunchCooperativeKernel((const void*)fwd_t<0, NPHASE>, dim3(grid), dim3(NTHR), kargs, LDS_BYTES, stream);
    if (e != hipSuccess) fprintf(stderr, "cooperative launch failed: %s (grid %d)\n", hipGetErrorString(e), grid);
#endif
}
```
